# Optimizing an MI355X kernel written in HIP

```python
import math
import jax, jax.numpy as jnp
from jax import lax
import numpy as np

D_MODEL = 2048
BATCH = 2
SEQ = 4096
DEPTH = 2

CHUNK = 64
D_MIX = D_MODEL
D_POOL = D_MIX // 2
POOL_WINDOWS = (2, 4, 8, 16)
N_POOL_GROUPS = len(POOL_WINDOWS)
POOL_GROUP = D_POOL // N_POOL_GROUPS
D_ATTN = D_MIX - D_POOL
HEAD_DIM = 64
N_Q_HEADS = D_ATTN // HEAD_DIM
N_KV_HEADS = 2
Q_PER_KV = N_Q_HEADS // N_KV_HEADS
WINDOW = 128
WINDOW_CHUNKS = WINDOW // CHUNK
BAND_CHUNKS = WINDOW_CHUNKS + 1
BAND = BAND_CHUNKS * CHUNK
N_BUCKETS = 32
MAX_DISTANCE = 128
D_IN = D_POOL + (N_Q_HEADS + 2 * N_KV_HEADS) * HEAD_DIM
PEER_HEADS = 8
N_KEYS = 128
N_EXPERTS = N_KEYS * N_KEYS
PEER_TOPK = 16
D_QUERY = 256
D_HALF = D_QUERY // 2
PEER_TOKEN_BLOCK = 128
EPS = 1e-6

kernel_name = 'hymba_pool_swa_peer_block'


def rms_norm(x, gain):
    xf = x.astype(jnp.float32)
    y = xf * lax.rsqrt(jnp.mean(xf * xf, axis=-1, keepdims=True) + EPS)
    return (y * gain.astype(jnp.float32)).astype(x.dtype)


def t5_bucket(rel):
    nb = N_BUCKETS // 2
    max_exact = nb // 2
    ret = jnp.where(rel > 0, nb, 0)
    n = jnp.abs(rel)
    nf = jnp.maximum(n, 1).astype(jnp.float32)
    large = max_exact + (jnp.log(nf / max_exact) / math.log(MAX_DISTANCE / max_exact) * (nb - max_exact)).astype(jnp.int32)
    large = jnp.minimum(large, nb - 1)
    return ret + jnp.where(n < max_exact, n, large)


def pool_mixer(p, w_pool, pool_scale):
    B, S, _ = p.shape
    pf = p.astype(jnp.float32).reshape(B, S, N_POOL_GROUPS, POOL_GROUP)
    cs = jnp.cumsum(pf, axis=1)
    t = jnp.arange(S)
    means = []
    for g, w in enumerate(POOL_WINDOWS):
        c_g = cs[:, :, g]
        prev = jnp.pad(c_g, ((0, 0), (w, 0), (0, 0)))[:, :S]
        cnt = jnp.minimum(t + 1, w).astype(jnp.float32)[None, :, None]
        means.append((c_g - prev) / cnt)
    pooled = (jnp.stack(means, axis=2) - pf).astype(p.dtype)
    y = jnp.einsum('bsgc,gcd->bsgd', pooled, w_pool)
    return y.reshape(B, S, D_POOL) * pool_scale


def swa_sink_attention(q, k, v, q_gain, k_gain, sinks, rel_bias):
    B, S = q.shape[:2]
    NC = S // CHUNK
    q = rms_norm(q, q_gain)
    k = rms_norm(k, k_gain)
    qc = q.reshape(B, NC, CHUNK, N_KV_HEADS, Q_PER_KV, HEAD_DIM)

    def band(t):
        tc = t.reshape(B, NC, CHUNK, N_KV_HEADS, HEAD_DIM)
        tp = jnp.pad(tc, ((0, 0), (WINDOW_CHUNKS, 0), (0, 0), (0, 0), (0, 0)))
        return jnp.concatenate([tp[:, j:j + NC] for j in range(BAND_CHUNKS)], axis=2)

    kb = band(k)
    vb = band(v)
    scores = jnp.einsum('bnqhgd,bnkhd->bnhgqk', qc, kb, preferred_element_type=jnp.float32) * (1.0 / math.sqrt(HEAD_DIM))
    a = jnp.arange(CHUNK)[:, None]
    bk = jnp.arange(BAND)[None, :]
    rel = bk - WINDOW_CHUNKS * CHUNK - a
    bias = rel_bias.astype(jnp.float32)[t5_bucket(rel)]
    bias = bias.transpose(2, 0, 1).reshape(N_KV_HEADS, Q_PER_KV, CHUNK, BAND)
    key_chunk = jnp.arange(NC)[:, None] - WINDOW_CHUNKS + bk // CHUNK
    valid = key_chunk >= 0
    scores = jnp.where(valid[None, :, None, None, None, :], scores + bias, -jnp.inf)
    sink = jnp.broadcast_to(sinks.astype(jnp.float32).reshape(N_KV_HEADS, Q_PER_KV, 1, 1), scores.shape[:-1] + (1,))
    probs = jax.nn.softmax(jnp.concatenate([scores, sink], axis=-1), axis=-1)[..., :-1]
    out = jnp.einsum('bnhgqk,bnkhd->bnqhgd', probs.astype(v.dtype), vb)
    return out.reshape(B, S, D_ATTN)


def hybrid_mixer(h, w_in, q_gain, k_gain, sinks, rel_bias, w_pool, pool_scale, w_out):
    B, S, _ = h.shape
    z = h @ w_in
    p = z[..., :D_POOL]
    o = D_POOL
    q = z[..., o:o + D_ATTN].reshape(B, S, N_Q_HEADS, HEAD_DIM)
    o += D_ATTN
    k = z[..., o:o + N_KV_HEADS * HEAD_DIM].reshape(B, S, N_KV_HEADS, HEAD_DIM)
    o += N_KV_HEADS * HEAD_DIM
    v = z[..., o:o + N_KV_HEADS * HEAD_DIM].reshape(B, S, N_KV_HEADS, HEAD_DIM)
    y_pool = pool_mixer(p, w_pool, pool_scale)
    y_attn = swa_sink_attention(q, k, v, q_gain, k_gain, sinks, rel_bias)
    return jnp.concatenate([y_pool, y_attn], axis=-1) @ w_out


def peer_ffn(h, w_query, sub_keys, expert_u, expert_v):
    B, S, D = h.shape
    q = (h @ w_query).reshape(B, S, PEER_HEADS, 2, D_HALF)
    s = jnp.einsum('bshpd,pnd->bshpn', q, sub_keys).astype(jnp.float32)
    s1, i1 = lax.top_k(s[..., 0, :], PEER_TOPK)
    s2, i2 = lax.top_k(s[..., 1, :], PEER_TOPK)
    cand = (s1[..., :, None] + s2[..., None, :]).reshape(B, S, PEER_HEADS, PEER_TOPK * PEER_TOPK)
    cand_idx = (i1[..., :, None] * N_KEYS + i2[..., None, :]).reshape(B, S, PEER_HEADS, PEER_TOPK * PEER_TOPK)
    top_s, pos = lax.top_k(cand, PEER_TOPK)
    idx = jnp.take_along_axis(cand_idx, pos, axis=-1)
    gate = jax.nn.softmax(top_s, axis=-1)
    n_blk = (B * S) // PEER_TOKEN_BLOCK
    hb = h.reshape(n_blk, PEER_TOKEN_BLOCK, D)
    ib = idx.reshape(n_blk, PEER_TOKEN_BLOCK, PEER_HEADS, PEER_TOPK)
    gb = gate.reshape(n_blk, PEER_TOKEN_BLOCK, PEER_HEADS, PEER_TOPK)

    def block(args):
        hx, ix, gx = args
        u = expert_u[ix]
        act = jnp.einsum('thkd,td->thk', u, hx, preferred_element_type=jnp.float32)
        act = (jax.nn.gelu(act, approximate=False) * gx).astype(hx.dtype)
        vv = expert_v[ix]
        return jnp.einsum('thk,thkd->td', act, vv)

    out = lax.map(block, (hb, ib, gb))
    return out.reshape(B, S, D)


def setup_inputs(seed: int = 0) -> dict:
    key = jax.random.key(seed)
    ks = jax.random.split(key, 18)
    f32 = jnp.float32

    def nrm(k, shape, s):
        return jax.random.normal(k, shape, f32) * s

    return {
        'x': nrm(ks[0], (BATCH, SEQ, D_MODEL), 1.0),
        'c': nrm(ks[1], (BATCH, D_MODEL), 1.0),
        'rel_bias': nrm(ks[2], (N_BUCKETS, N_Q_HEADS), 0.5),
        'ada_w': nrm(ks[3], (DEPTH, D_MODEL, 6 * D_MODEL), 0.5 * D_MODEL ** -0.5),
        'ada_b': nrm(ks[4], (DEPTH, 6 * D_MODEL), 0.02),
        'norm1_gain': 1.0 + nrm(ks[5], (DEPTH, D_MODEL), 0.1),
        'w_in': nrm(ks[6], (DEPTH, D_MODEL, D_IN), D_MODEL ** -0.5),
        'q_gain': 1.0 + nrm(ks[7], (DEPTH, HEAD_DIM), 0.1),
        'k_gain': 1.0 + nrm(ks[8], (DEPTH, HEAD_DIM), 0.1),
        'sinks': nrm(ks[9], (DEPTH, N_Q_HEADS), 0.5),
        'w_pool': nrm(ks[10], (DEPTH, N_POOL_GROUPS, POOL_GROUP, POOL_GROUP), POOL_GROUP ** -0.5),
        'pool_scale': 1.0 + nrm(ks[11], (DEPTH, D_POOL), 0.1),
        'w_out': nrm(ks[12], (DEPTH, D_MIX, D_MODEL), D_MIX ** -0.5),
        'norm2_gain': 1.0 + nrm(ks[13], (DEPTH, D_MODEL), 0.1),
        'peer_w_query': nrm(ks[14], (DEPTH, D_MODEL, PEER_HEADS * D_QUERY), D_MODEL ** -0.5),
        'peer_sub_keys': nrm(ks[15], (DEPTH, 2, N_KEYS, D_HALF), D_HALF ** -0.5),
        'peer_u': nrm(ks[16], (DEPTH, N_EXPERTS, D_MODEL), D_MODEL ** -0.5),
        'peer_v': nrm(ks[17], (DEPTH, N_EXPERTS, D_MODEL), 1.0),
    }


def reference(x, c, rel_bias, ada_w, ada_b, norm1_gain, w_in, q_gain, k_gain, sinks, w_pool, pool_scale,
              w_out, norm2_gain, peer_w_query, peer_sub_keys, peer_u, peer_v):
    cond = jax.nn.silu(c)
    for l in range(DEPTH):
        mod = cond @ ada_w[l] + ada_b[l]
        sh1, sc1, g1, sh2, sc2, g2 = [m[:, None, :] for m in jnp.split(mod, 6, axis=-1)]
        h = rms_norm(x, norm1_gain[l]) * (1 + sc1) + sh1
        x = x + g1 * hybrid_mixer(h, w_in[l], q_gain[l], k_gain[l], sinks[l], rel_bias,
                                  w_pool[l], pool_scale[l], w_out[l])
        h = rms_norm(x, norm2_gain[l]) * (1 + sc2) + sh2
        x = x + g2 * peer_ffn(h, peer_w_query[l], peer_sub_keys[l], peer_u[l], peer_v[l])
    return x
```

```cpp
#include <hip/hip_runtime.h>
#include <hip/hip_cooperative_groups.h>
#include <cstdio>
#include <cstdint>
namespace cg = cooperative_groups;

#ifndef PHMASK
#define PHMASK 0x3ff
#endif
#ifndef MK_ONE_LAUNCH
#define MK_ONE_LAUNCH 0
#endif

constexpr int BATCH = 2, SEQ = 4096, T = BATCH * SEQ, D = 2048, DIN = 2304, DPOOL = 1024, HD = 64, NQH = 16;
constexpr int NEXP = 16384, MODW = 6 * D;
constexpr float EPS = 1e-6f;

namespace pg8 {
#define PG8_LAS __attribute__((address_space(3)))
typedef unsigned short bf16_t;
typedef short bf16x8 __attribute__((ext_vector_type(8)));
typedef float f32x4 __attribute__((ext_vector_type(4)));
typedef unsigned u32x4 __attribute__((ext_vector_type(4)));
constexpr int BM = 256, BK = 64, HALF = 128, HTB = HALF * BK * 2, STAGE_BYTES = 8 * HTB, NXCD = 8, WGM = 8;

__host__ __device__ __forceinline__ int lds_byte(int r, int c) { const int st = (r >> 4) * 2 + (c >> 5), rr = r & 15, cc = c & 31, ob = rr * 64 + cc * 2; return st * 1024 + (ob ^ (((ob >> 9) & 1) << 5)); }
__host__ __device__ __forceinline__ void stage_rc(int b, int& R, int& C) { const int st = b / 1024, sb = b % 1024, swz = sb ^ (((sb >> 9) & 1) << 5); R = (st >> 1) * 16 + swz / 64; C = (st & 1) * 32 + (swz % 64) / 2; }
__host__ __device__ __forceinline__ int perm32(int rho) { const int n = rho >> 4, i = rho & 15; return 8 * (i >> 2) + 4 * n + (i & 3); }

struct Unit { int pm, pn; };
struct Gemm { const bf16_t* A; const bf16_t* Bt; int M, N, K, lda, ldb; };

struct StaticOrder {
    int nM, nN, nwg, G, c;
    __host__ __device__ void init(int M, int N, int G_, int c_) { nM = M / BM; nN = N / BM; nwg = nM * nN; G = G_; c = c_; }
    __host__ __device__ bool next(int i, Unit& u) const {
        const long L = (long)i * G + c; if (L >= nwg) return false;
        int wgid = (int)L; { const int q = nwg / NXCD, r = nwg % NXCD, xcd = wgid % NXCD, off = wgid / NXCD; wgid = (xcd < r ? xcd * (q + 1) : r * (q + 1) + (xcd - r) * q) + off; }
        const int nig = WGM * nN, gid = wgid / nig, fm = gid * WGM, gsz = (nM - fm) < WGM ? (nM - fm) : WGM;
        u.pm = fm + ((wgid % nig) % gsz); u.pn = (wgid % nig) / gsz; return true;
    }
    __device__ __forceinline__ void a_ready(const Unit&) const {}
    __device__ __forceinline__ void done(const Unit&) const {}
};
struct OneUnit {
    int pm;
    __device__ __forceinline__ bool next(int i, Unit& u) const { if (i > 0) return false; u.pm = pm; u.pn = 0; return true; }
    __device__ __forceinline__ void a_ready(const Unit&) const {}
    __device__ __forceinline__ void done(const Unit&) const {}
};

__device__ __forceinline__ unsigned cvt_pk_bf16(float lo, float hi) { unsigned r; asm volatile("v_cvt_pk_bf16_f32 %0, %1, %2" : "=v"(r) : "v"(lo), "v"(hi)); return r; }

struct EpiBf16S {
    static constexpr bool PERM = true, AFTER_DRAIN = false;
    bf16_t* O; int ldc; int col_off; const float* cscale;
    __device__ __forceinline__ void operator()(const f32x4 (&acc)[2][2][4][2], const Unit& u, int wr, int wc, int fr, int fq) const {
        const int row0 = u.pm * BM + wr * 64 + fr; const int col0 = col_off + u.pn * BM + wc * 32 + 8 * fq;
#pragma unroll
        for (int ai = 0; ai < 2; ++ai)
#pragma unroll
            for (int m = 0; m < 4; ++m) { bf16_t* rowp = O + (size_t)(row0 + ai * HALF + m * 16) * ldc + col0;
#pragma unroll
                for (int bj = 0; bj < 2; ++bj) { f32x4 v0 = acc[ai][bj][m][0], v1 = acc[ai][bj][m][1];
                    if (cscale) { v0 = v0 * *(const f32x4*)(cscale + col0 + bj * HALF); v1 = v1 * *(const f32x4*)(cscale + col0 + bj * HALF + 4); }
                    u32x4 w; w.x = cvt_pk_bf16(v0[0], v0[1]); w.y = cvt_pk_bf16(v0[2], v0[3]); w.z = cvt_pk_bf16(v1[0], v1[1]); w.w = cvt_pk_bf16(v1[2], v1[3]);
                    *(u32x4*)(rowp + bj * HALF) = w; } }
    }
};
struct EpiResid {
    static constexpr bool PERM = false, AFTER_DRAIN = false;
    const float* base; float* out; const float* gate;
    int gstride;
    __device__ __forceinline__ void operator()(const f32x4 (&acc)[2][2][4][2], const Unit& u, int wr, int wc, int fr, int fq) const {
        const int row0 = u.pm * BM + wr * 64 + fr; const int col0 = u.pn * BM + wc * 32 + 4 * fq; const int b = (u.pm * BM) / SEQ;
        f32x4 gv[2][2];
#pragma unroll
        for (int bj = 0; bj < 2; ++bj)
#pragma unroll
            for (int n = 0; n < 2; ++n) gv[bj][n] = *(const f32x4*)(gate + (size_t)b * gstride + col0 + bj * HALF + n * 16);
#pragma unroll
        for (int ai = 0; ai < 2; ++ai)
#pragma unroll
            for (int m = 0; m < 4; ++m) { const size_t off = (size_t)(row0 + ai * HALF + m * 16) * D + col0;
#pragma unroll
                for (int bj = 0; bj < 2; ++bj)
#pragma unroll
                    for (int n = 0; n < 2; ++n) { const f32x4 bs = *(const f32x4*)(base + off + bj * HALF + n * 16); *(f32x4*)(out + off + bj * HALF + n * 16) = bs + gv[bj][n] * acc[ai][bj][m][n]; } }
    }
};

template <class Epi, class Sched, bool ALIGN_EPI = false, bool SP2 = false>
__device__ __forceinline__ void gemm_phase(PG8_LAS unsigned char* lds, const Gemm g, const Sched& S, const Epi& E) {
    const int tid = threadIdx.x, wid = __builtin_amdgcn_readfirstlane(tid >> 6), lane = tid & 63, wr = wid >> 2, wc = wid & 3, fr = lane & 15, fq = lane >> 4;
    const int K = g.K, nt = K / BK;
    unsigned voffA[2], voffB[2];
#pragma unroll
    for (int i = 0; i < 2; ++i) { int R, C; stage_rc(tid * 16 + i * 8192, R, C); const int Rb = Epi::PERM ? ((R & ~31) + perm32(R & 31)) : R;
        voffA[i] = (unsigned)(R * g.lda + C) * 2u; voffB[i] = (unsigned)(Rb * g.ldb + C) * 2u; }
    const size_t kstep = (size_t)(BK * 2);
    const size_t hstepA = (size_t)HALF * g.lda * 2, hstepB = (size_t)HALF * g.ldb * 2;
    const size_t tstepA = 2 * hstepA, tstepB = 2 * hstepB;
    const unsigned ldsw = (unsigned)wid * 1024u;
    const int aoff = lds_byte(wr * 64 + fr, fq * 8), boff = lds_byte(wc * 32 + fr, fq * 8);
#define PG8_SA(b, h) (((b) * 2 + (h)) * HTB)
#define PG8_SB(b, h) ((4 + (b) * 2 + (h)) * HTB)
#define PG8_STAGE(bufoff, gbase, voff) do { _Pragma("unroll") for (int _i = 0; _i < 2; ++_i) \
        __builtin_amdgcn_global_load_lds((const unsigned*)((const char*)(gbase) + (voff)[_i]), (PG8_LAS unsigned*)(lds + (bufoff) + ldsw + _i * 8192), 16, 0, 0); } while (0)
#define PG8_LDA(dst, b, h) do { _Pragma("unroll") for (int m = 0; m < 4; ++m) _Pragma("unroll") for (int k = 0; k < 2; ++k) dst[m][k] = *(const PG8_LAS bf16x8*)(lds + PG8_SA(b, h) + aoff + m * 2048 + k * 1024); } while (0)
#define PG8_LDB(dst, b, h) do { _Pragma("unroll") for (int n = 0; n < 2; ++n) _Pragma("unroll") for (int k = 0; k < 2; ++k) dst[n][k] = *(const PG8_LAS bf16x8*)(lds + PG8_SB(b, h) + boff + n * 2048 + k * 1024); } while (0)
#define PG8_MMA(ai, bj, At, Bt) do { __builtin_amdgcn_s_setprio(1); _Pragma("unroll") for (int m = 0; m < 4; ++m) _Pragma("unroll") for (int n = 0; n < 2; ++n) _Pragma("unroll") for (int k = 0; k < 2; ++k) \
        acc[ai][bj][m][n] = __builtin_amdgcn_mfma_f32_16x16x32_bf16(Bt[n][k], At[m][k], acc[ai][bj][m][n], 0, 0, 0); __builtin_amdgcn_s_setprio(0); } while (0)
#define PG8_WAIT_V(n) asm volatile("s_waitcnt vmcnt(" #n ")" ::: "memory")
#define PG8_WAIT_L(n) asm volatile("s_waitcnt lgkmcnt(" #n ")" ::: "memory")
#define PG8_BAR __builtin_amdgcn_s_barrier()
#define PG8_SCHED __builtin_amdgcn_sched_barrier(0)
    Unit cur, nxt; int ui = 0;
    if (!S.next(0, cur)) return;
    f32x4 acc[2][2][4][2];
#pragma unroll
    for (int a = 0; a < 2; ++a)
#pragma unroll
        for (int b = 0; b < 2; ++b)
#pragma unroll
            for (int m = 0; m < 4; ++m)
#pragma unroll
                for (int n = 0; n < 2; ++n) acc[a][b][m][n] = (f32x4){0.f, 0.f, 0.f, 0.f};
    bf16x8 At[4][2], B0[2][2], B1[2][2];
    const char* cA = (const char*)g.A + (size_t)cur.pm * tstepA; const char* cB = (const char*)g.Bt + (size_t)cur.pn * tstepB;
    S.a_ready(cur);
    if constexpr (SP2) {
        PG8_STAGE(PG8_SB(0, 0), cB, voffB); PG8_STAGE(PG8_SB(0, 1), cB + hstepB, voffB); PG8_STAGE(PG8_SA(0, 0), cA, voffA); PG8_STAGE(PG8_SA(0, 1), cA + hstepA, voffA);
        if (wr == 1) PG8_BAR;
        PG8_WAIT_V(2); PG8_BAR;
        PG8_STAGE(PG8_SB(1, 0), cB + kstep, voffB); PG8_STAGE(PG8_SA(1, 0), cA + kstep, voffA); PG8_STAGE(PG8_SB(1, 1), cB + hstepB + kstep, voffB);
        PG8_WAIT_V(6); PG8_BAR;
    } else {
        PG8_STAGE(PG8_SB(0, 0), cB, voffB); PG8_STAGE(PG8_SA(0, 0), cA, voffA); PG8_STAGE(PG8_SB(0, 1), cB + hstepB, voffB); PG8_STAGE(PG8_SA(0, 1), cA + hstepA, voffA);
        if (wr == 1) PG8_BAR;
        PG8_WAIT_V(4); PG8_BAR;
        PG8_STAGE(PG8_SB(1, 0), cB + kstep, voffB); PG8_STAGE(PG8_SA(1, 0), cA + kstep, voffA); PG8_STAGE(PG8_SB(1, 1), cB + hstepB + kstep, voffB);
        PG8_WAIT_V(6); PG8_BAR;
    }
    for (;;) {
        const bool has_next = S.next(ui + 1, nxt);
        const char* nA = has_next ? (const char*)g.A + (size_t)nxt.pm * tstepA : cA; const char* nB = has_next ? (const char*)g.Bt + (size_t)nxt.pn * tstepB : cB;
        for (int t = 0; t < nt; t += 2) {
            const bool last = (t == nt - 2);
            const char* a1 = cA + (size_t)(t + 1) * kstep;
            const char* a2 = last ? nA : cA + (size_t)(t + 2) * kstep; const char* b2 = last ? nB : cB + (size_t)(t + 2) * kstep;
            const char* a3 = a2 + kstep; const char* b3 = b2 + kstep;
            if (last && has_next) S.a_ready(nxt);
            if constexpr (SP2) {
            PG8_LDB(B0, 0, 0); PG8_LDB(B1, 0, 1); PG8_SCHED; PG8_LDA(At, 0, 0); PG8_STAGE(PG8_SA(1, 1), a1 + hstepA, voffA);
            PG8_WAIT_V(8); PG8_WAIT_L(0); PG8_BAR; PG8_MMA(0, 0, At, B0); PG8_MMA(0, 1, At, B1); PG8_BAR; PG8_SCHED;
            PG8_LDA(At, 0, 1); PG8_STAGE(PG8_SB(0, 0), b2, voffB); PG8_STAGE(PG8_SB(0, 1), b2 + hstepB, voffB); PG8_STAGE(PG8_SA(0, 0), a2, voffA);
            PG8_WAIT_V(8); PG8_WAIT_L(0); PG8_BAR; PG8_MMA(1, 0, At, B0); PG8_MMA(1, 1, At, B1); PG8_BAR; PG8_SCHED;
            PG8_LDB(B0, 1, 0); PG8_LDB(B1, 1, 1); PG8_SCHED; PG8_LDA(At, 1, 0); PG8_STAGE(PG8_SA(0, 1), a2 + hstepA, voffA);
            PG8_WAIT_V(8); PG8_WAIT_L(0); PG8_BAR; PG8_MMA(0, 0, At, B0); PG8_MMA(0, 1, At, B1); PG8_BAR; PG8_SCHED;
            PG8_LDA(At, 1, 1); PG8_STAGE(PG8_SB(1, 0), b3, voffB); PG8_STAGE(PG8_SB(1, 1), b3 + hstepB, voffB); PG8_STAGE(PG8_SA(1, 0), a3, voffA);
            PG8_WAIT_V(8); PG8_WAIT_L(0); PG8_BAR; PG8_MMA(1, 0, At, B0); PG8_MMA(1, 1, At, B1); PG8_BAR; PG8_SCHED;
            } else {
            PG8_LDB(B0, 0, 0); PG8_SCHED; PG8_LDA(At, 0, 0); PG8_STAGE(PG8_SA(1, 1), a1 + hstepA, voffA);
            PG8_WAIT_L(8); PG8_BAR; PG8_WAIT_L(0); PG8_MMA(0, 0, At, B0); PG8_BAR; PG8_SCHED;
            PG8_LDB(B1, 0, 1); PG8_STAGE(PG8_SB(0, 0), b2, voffB);
            PG8_BAR; PG8_WAIT_L(0); PG8_MMA(0, 1, At, B1); PG8_BAR;
            PG8_LDA(At, 0, 1); PG8_STAGE(PG8_SA(0, 0), a2, voffA);
            PG8_BAR; PG8_WAIT_L(0); PG8_MMA(1, 0, At, B0); PG8_BAR; PG8_SCHED;
            PG8_STAGE(PG8_SB(0, 1), b2 + hstepB, voffB);
            PG8_WAIT_V(6); PG8_BAR; PG8_MMA(1, 1, At, B1); PG8_BAR;
            PG8_LDB(B0, 1, 0); PG8_SCHED; PG8_LDA(At, 1, 0); PG8_STAGE(PG8_SA(0, 1), a2 + hstepA, voffA);
            PG8_WAIT_L(8); PG8_BAR; PG8_WAIT_L(0); PG8_MMA(0, 0, At, B0); PG8_BAR; PG8_SCHED;
            PG8_LDB(B1, 1, 1); PG8_STAGE(PG8_SB(1, 0), b3, voffB);
            PG8_BAR; PG8_WAIT_L(0); PG8_MMA(0, 1, At, B1); PG8_BAR;
            PG8_LDA(At, 1, 1); PG8_STAGE(PG8_SA(1, 0), a3, voffA);
            PG8_BAR; PG8_WAIT_L(0); PG8_MMA(1, 0, At, B0); PG8_BAR; PG8_SCHED;
            PG8_STAGE(PG8_SB(1, 1), b3 + hstepB, voffB);
            PG8_WAIT_V(6); PG8_BAR; PG8_MMA(1, 1, At, B1); PG8_BAR;
            }
        }
        if constexpr (ALIGN_EPI) { if (wr == 0) PG8_BAR; }
        if constexpr (!Epi::AFTER_DRAIN) { E(acc, cur, wr, wc, fr, fq); S.done(cur); }
        if (!has_next) break;
#pragma unroll
        for (int a = 0; a < 2; ++a)
#pragma unroll
            for (int b = 0; b < 2; ++b)
#pragma unroll
                for (int m = 0; m < 4; ++m)
#pragma unroll
                    for (int n = 0; n < 2; ++n) acc[a][b][m][n] = (f32x4){0.f, 0.f, 0.f, 0.f};
        cur = nxt; cA = nA; cB = nB; ++ui;
        if constexpr (ALIGN_EPI) { if (wr == 1) PG8_BAR; }
    }
    PG8_WAIT_V(0);
    if constexpr (!ALIGN_EPI) { if (wr == 0) PG8_BAR; }
    PG8_BAR;
#undef PG8_SA
#undef PG8_SB
#undef PG8_STAGE
#undef PG8_LDA
#undef PG8_LDB
#undef PG8_MMA
#undef PG8_WAIT_V
#undef PG8_WAIT_L
#undef PG8_BAR
#undef PG8_SCHED
}
}

constexpr int NWAVES = 8;
constexpr size_t MiB = 1u << 20;
constexpr size_t WS_CTL = 0, CTL_ZERO_BYTES = 1 * MiB;
constexpr size_t WS_MOD = 1 * MiB;
constexpr size_t WS_MODP = 4 * MiB;
constexpr size_t WS_WIN = 8 * MiB;
constexpr size_t WS_WOUT = 26 * MiB;
constexpr size_t WS_WQ = 42 * MiB;
constexpr size_t WS_WPOOL = 58 * MiB;
constexpr size_t WS_SK = 59 * MiB;
constexpr size_t WS_U16 = 64 * MiB;
constexpr size_t WS_V16 = 192 * MiB;
constexpr size_t WS_H = 320 * MiB;
constexpr size_t WS_Z = 352 * MiB;
constexpr size_t WS_POOLED = 388 * MiB;
constexpr size_t WS_MIX = 404 * MiB;
constexpr size_t WS_X1 = 436 * MiB;
constexpr size_t WS_XA = 500 * MiB;
constexpr size_t WS_QP = 564 * MiB;
constexpr size_t WS_IDX = 596 * MiB;
constexpr size_t WS_GATE = 600 * MiB;
constexpr size_t WS_END = 604 * MiB;
constexpr int CW_BAR = 4096;
constexpr int RING_BYTES = 131072;
constexpr int LDS_BYTES = 147456;
constexpr int LDSCTL_OFF = LDS_BYTES - 512;

#define GAS __attribute__((address_space(1)))
#define LAS __attribute__((address_space(3)))
typedef unsigned short bf16;
typedef unsigned v4u __attribute__((ext_vector_type(4)));
typedef unsigned v2u __attribute__((ext_vector_type(2)));
typedef float f32x4 __attribute__((ext_vector_type(4)));
typedef float f32x16 __attribute__((ext_vector_type(16)));
typedef short bf16x8 __attribute__((ext_vector_type(8)));
typedef short s16x4 __attribute__((ext_vector_type(4)));
typedef __bf16 bf16x2v __attribute__((ext_vector_type(2)));
typedef GAS unsigned gu32;
#define RLX_AGENT __ATOMIC_RELAXED, __HIP_MEMORY_SCOPE_AGENT
#define LDS_WAIT() asm volatile("s_waitcnt lgkmcnt(0)" ::: "memory")
__device__ __forceinline__ unsigned f2bf(float f) { unsigned u = __builtin_bit_cast(unsigned, f); return (u + 0x7fffu + ((u >> 16) & 1u)) >> 16; }
__device__ __forceinline__ unsigned pk2(float lo, float hi) { return f2bf(lo) | (f2bf(hi) << 16); }
__device__ __forceinline__ float bflo(unsigned w) { return __builtin_bit_cast(float, w << 16); }
__device__ __forceinline__ float bfhi(unsigned w) { return __builtin_bit_cast(float, w & 0xffff0000u); }
__device__ __forceinline__ float dot2(unsigned a, unsigned b, float acc) { return __builtin_amdgcn_fdot2_f32_bf16(__builtin_bit_cast(bf16x2v, a), __builtin_bit_cast(bf16x2v, b), acc, false); }
__device__ __forceinline__ float wave_sum(float v) {
#pragma unroll
    for (int o = 1; o < 64; o <<= 1) v += __shfl_xor(v, o);
    return v;
}
__device__ __forceinline__ float rdlane(float v, int l) { return __builtin_bit_cast(float, __builtin_amdgcn_readlane(__builtin_bit_cast(int, v), l)); }

#define XB_TMO      128
#define XB_XCNT(j)  (256  + 64 * (j))
#define XB_XSUB(j)  (1280 + 64 * (j))
#define XB_XGEN(j)  (2304 + 64 * (j))
#define XB_TOP      3328
#define XB_TOPGEN   3392
#define XCD_BAR_WORDS 3456
#define XB_SPIN_CAP (1u << 22)
__device__ __forceinline__ unsigned xb_ld(unsigned* p)              { return __hip_atomic_load(p, __ATOMIC_RELAXED, __HIP_MEMORY_SCOPE_AGENT); }
__device__ __forceinline__ unsigned xb_add(unsigned* p, unsigned v) { return __hip_atomic_fetch_add(p, v, __ATOMIC_RELAXED, __HIP_MEMORY_SCOPE_AGENT); }
__device__ __forceinline__ unsigned xb_xcc_id() { return (unsigned)__builtin_amdgcn_s_getreg((3 << 11) | 20) & 0xFu; }
#define XB_SPIN(cond, bar) do { unsigned _sp = 0; while (cond) { __builtin_amdgcn_s_sleep(1); \
    if ((++_sp & 255u) == 0u) { if (xb_ld(&(bar)[XB_TMO])) break; if (_sp > XB_SPIN_CAP) { atomicAdd(&(bar)[XB_TMO], 1u); break; } } } } while (0)
struct XcdBarrier { unsigned* bar; unsigned x; volatile LAS unsigned* st; };
__device__ __forceinline__ XcdBarrier xcd_barrier_post(unsigned* bar, volatile LAS unsigned* st) {
    XcdBarrier b; b.bar = bar; b.x = xb_xcc_id(); b.st = st;
    if (threadIdx.x == 0) (void)xb_add(&bar[XB_XCNT(b.x)], 1u);
    return b;
}
__device__ __forceinline__ void xcd_barrier_complete(unsigned* bar, unsigned x, unsigned& nloc, unsigned& nx) {
    const unsigned G = gridDim.x * gridDim.y * gridDim.z;
    unsigned sum, cnt, mine, sp = 0u;
    for (;;) {
        sum = 0u; cnt = 0u; mine = 0u;
#pragma unroll
        for (unsigned j = 0; j < 16; ++j) { const unsigned c = xb_ld(&bar[XB_XCNT(j)]); sum += c; cnt += (c > 0u) ? 1u : 0u; mine = (j == x) ? c : mine; }
        if (sum == G) break;
        __builtin_amdgcn_s_sleep(1);
        if ((++sp & 255u) == 0u) { if (xb_ld(&bar[XB_TMO])) break; if (sp > XB_SPIN_CAP) { atomicAdd(&bar[XB_TMO], 1u); break; } }
    }
    nloc = mine > 0u ? mine : 1u; nx = cnt > 0u ? cnt : 1u;
}
__device__ __forceinline__ void xcd_barrier(const XcdBarrier& b) {
    asm volatile("s_waitcnt vmcnt(0)" ::: "memory");
    __syncthreads();
    if (threadIdx.x == 0) {
        unsigned* bar = b.bar;
        __builtin_amdgcn_s_waitcnt(0);
        unsigned nloc = b.st[0], nx = b.st[1];
        if (nloc == 0u) { xcd_barrier_complete(bar, b.x, nloc, nx); b.st[0] = nloc; b.st[1] = nx; }
        const unsigned old = xb_add(&bar[XB_XSUB(b.x)], 1u);
        const unsigned gen = old / nloc;
        if (old + 1u == (gen + 1u) * nloc) {
            __builtin_amdgcn_fence(__ATOMIC_RELEASE, "agent");
            asm volatile("s_waitcnt vmcnt(0)" ::: "memory");
            const unsigned og = xb_add(&bar[XB_TOP], 1u);
            const unsigned tg = og / nx;
            if (og + 1u == (tg + 1u) * nx) xb_add(&bar[XB_TOPGEN], 1u);
            else XB_SPIN(xb_ld(&bar[XB_TOPGEN]) == tg, bar);
            __builtin_amdgcn_fence(__ATOMIC_ACQUIRE, "agent");
            xb_add(&bar[XB_XGEN(b.x)], 1u);
            asm volatile("s_waitcnt vmcnt(0)" ::: "memory");
        } else {
            XB_SPIN(xb_ld(&bar[XB_XGEN(b.x)]) == gen, bar);
            __builtin_amdgcn_fence(__ATOMIC_ACQUIRE, "agent");
            asm volatile("s_waitcnt vmcnt(0)" ::: "memory");
        }
    }
    __syncthreads();
}

struct Args { const float* in[18]; float* out; unsigned char* ws; int ph_lo, ph_hi, coop, pad; };
struct Frame {
    LAS unsigned char* lds;
    int tid, lane, wave, vcu, G;
    const Args* A;
    unsigned char* ws;
};
#define F_IN(k) (F.A->in[k])
#define F_x F_IN(0)
#define F_c F_IN(1)
#define F_rel_bias F_IN(2)
#define F_ada_w F_IN(3)
#define F_ada_b F_IN(4)
#define F_norm1_gain F_IN(5)
#define F_w_in F_IN(6)
#define F_q_gain F_IN(7)
#define F_k_gain F_IN(8)
#define F_sinks F_IN(9)
#define F_w_pool F_IN(10)
#define F_pool_scale F_IN(11)
#define F_w_out F_IN(12)
#define F_norm2_gain F_IN(13)
#define F_w_query F_IN(14)
#define F_sub_keys F_IN(15)
#define F_peer_u F_IN(16)
#define F_peer_v F_IN(17)
#define F_out (F.A->out)
#define F_MOD ((float*)(F.ws + WS_MOD))
#define F_MODP ((float*)(F.ws + WS_MODP))
#define F_X1 ((float*)(F.ws + WS_X1))
#define F_XA ((float*)(F.ws + WS_XA))
#define F_GATE ((float*)(F.ws + WS_GATE))
#define F_WIN ((bf16*)(F.ws + WS_WIN))
#define F_WOUT ((bf16*)(F.ws + WS_WOUT))
#define F_WQ ((bf16*)(F.ws + WS_WQ))
#define F_WPOOL ((bf16*)(F.ws + WS_WPOOL))
#define F_SK ((bf16*)(F.ws + WS_SK))
#define F_U16 ((bf16*)(F.ws + WS_U16))
#define F_V16 ((bf16*)(F.ws + WS_V16))
#define F_H ((bf16*)(F.ws + WS_H))
#define F_Z ((bf16*)(F.ws + WS_Z))
#define F_POOLED ((bf16*)(F.ws + WS_POOLED))
#define F_MIX ((bf16*)(F.ws + WS_MIX))
#define F_QP ((bf16*)(F.ws + WS_QP))
#define F_IDX ((int*)(F.ws + WS_IDX))

__device__ __forceinline__ void p0_transpose_item(const float* W, int N, bf16* WT, int ldo, LAS float* scr, int item, int lane) {
    const int nblk = N / 32, kb = item / nblk, nb = item % nblk, k0 = 64 * kb, n0 = 32 * nb;
#pragma unroll 8
    for (int i = 0; i < 32; ++i) { const int kk = 2 * i + (lane >> 5); scr[kk * 33 + (lane & 31)] = W[(size_t)(k0 + kk) * N + n0 + (lane & 31)]; }
    LDS_WAIT(); asm volatile("" ::: "memory");
    const int c = lane & 7;
#pragma unroll
    for (int j = 0; j < 4; ++j) { const int n = (lane >> 3) + 8 * j; const LAS float* s = scr + (8 * c) * 33 + n;
        v4u o; o.x = pk2(s[0 * 33], s[1 * 33]); o.y = pk2(s[2 * 33], s[3 * 33]); o.z = pk2(s[4 * 33], s[5 * 33]); o.w = pk2(s[6 * 33], s[7 * 33]);
        *(GAS v4u*)(WT + (size_t)(n0 + n) * ldo + k0 + 8 * c) = o; }
    LDS_WAIT(); asm volatile("" ::: "memory");
}
__device__ __forceinline__ float silu_f(float v) { return v / (1.f + __expf(-v)); }

__device__ __forceinline__ void p0_prologue(Frame& F) {
    LAS float* scr = (LAS float*)(F.lds + F.wave * 16384);
    const int gw = F.vcu * NWAVES + F.wave, NGW = F.G * NWAVES, lane = F.lane;
    for (int it = gw; it < 2 * 48 * 16; it += NGW) {
        const int l = it / 768, r = it % 768, cgp = r / 16, kc = r % 16;
        const float* W = F_ada_w + (size_t)l * D * MODW + (size_t)(kc * 128) * MODW + cgp * 256 + lane * 4;
        const float c0a = silu_f(F_c[kc * 128 + lane]), c0b = silu_f(F_c[kc * 128 + 64 + lane]);
        const float c1a = silu_f(F_c[D + kc * 128 + lane]), c1b = silu_f(F_c[D + kc * 128 + 64 + lane]);
        f32x4 a0 = {0.f, 0.f, 0.f, 0.f}, a1 = {0.f, 0.f, 0.f, 0.f};
#pragma unroll 8
        for (int kk = 0; kk < 64; ++kk) { const f32x4 w = *(const GAS f32x4*)(W + (size_t)kk * MODW); const float s0 = rdlane(c0a, kk), s1 = rdlane(c1a, kk); a0 += w * s0; a1 += w * s1; }
#pragma unroll 8
        for (int kk = 0; kk < 64; ++kk) { const f32x4 w = *(const GAS f32x4*)(W + (size_t)(64 + kk) * MODW); const float s0 = rdlane(c0b, kk), s1 = rdlane(c1b, kk); a0 += w * s0; a1 += w * s1; }
        float* P = F_MODP + (size_t)kc * (2 * 2 * MODW) + (size_t)(l * 2) * MODW + cgp * 256 + lane * 4;
        *(GAS f32x4*)P = a0; *(GAS f32x4*)(P + MODW) = a1;
    }
    constexpr int I_IN = 32 * 72, I_OUT = 32 * 64, I_Q = 32 * 64, I_P = 4 * 32, I_L = I_IN + I_OUT + I_Q + I_P;
    for (int it = gw; it < 2 * I_L; it += NGW) {
        const int l = it / I_L; int r = it % I_L;
        if (r < I_IN) { p0_transpose_item(F_w_in + (size_t)l * D * DIN, DIN, F_WIN + (size_t)l * DIN * D, D, scr, r, lane); continue; } r -= I_IN;
        if (r < I_OUT) { p0_transpose_item(F_w_out + (size_t)l * D * D, D, F_WOUT + (size_t)l * D * D, D, scr, r, lane); continue; } r -= I_OUT;
        if (r < I_Q) { p0_transpose_item(F_w_query + (size_t)l * D * D, D, F_WQ + (size_t)l * D * D, D, scr, r, lane); continue; } r -= I_Q;
        { const int g = r / 32, rr = r % 32; p0_transpose_item(F_w_pool + (size_t)(l * 4 + g) * 65536, 256, F_WPOOL + (size_t)(l * 4 + g) * 65536, 256, scr, rr, lane); }
    }
    {
        constexpr long NCH_SK = 65536 / 512, NCH_E = (long)2 * NEXP * D / 512;
        for (long ch = gw; ch < NCH_SK + 2 * NCH_E; ch += NGW) {
            const float* src; bf16* dst; long o;
            if (ch < NCH_SK) { src = F_sub_keys; dst = F_SK; o = ch; }
            else if (ch < NCH_SK + NCH_E) { src = F_peer_u; dst = F_U16; o = ch - NCH_SK; }
            else { src = F_peer_v; dst = F_V16; o = ch - NCH_SK - NCH_E; }
            const f32x4 v0 = *(const GAS f32x4*)(src + o * 512 + lane * 4), v1 = *(const GAS f32x4*)(src + o * 512 + 256 + lane * 4);
            v2u w0, w1; w0.x = pk2(v0[0], v0[1]); w0.y = pk2(v0[2], v0[3]); w1.x = pk2(v1[0], v1[1]); w1.y = pk2(v1[2], v1[3]);
            *(GAS v2u*)(dst + o * 512 + lane * 4) = w0; *(GAS v2u*)(dst + o * 512 + 256 + lane * 4) = w1;
        }
    }
}

__device__ __forceinline__ f32x4 mod_reduce4(Frame& F, int i) {
    const int col = i % MODW, l = i / (2 * MODW);
    f32x4 a = *(const GAS f32x4*)(F_ada_b + (size_t)l * MODW + col);
#pragma unroll 4
    for (int kc = 0; kc < 16; ++kc) a += *(const GAS f32x4*)(F_MODP + (size_t)kc * (4 * MODW) + i);
    return a;
}

__device__ __forceinline__ void norm_rows(const float* xin, bf16* hout, int r0, int nrows, const f32x4 (&av)[8], const f32x4 (&sv)[8], int lane) {
    for (int r = r0; r < r0 + nrows; ++r) {
        const GAS f32x4* xr = (const GAS f32x4*)(xin + (size_t)r * D) + lane;
        f32x4 v[8]; float ss = 0.f;
#pragma unroll
        for (int j = 0; j < 8; ++j) { v[j] = xr[64 * j]; ss += (v[j][0] * v[j][0] + v[j][1] * v[j][1]) + (v[j][2] * v[j][2] + v[j][3] * v[j][3]); }
        const float rstd = 1.f / sqrtf(wave_sum(ss) * (1.f / D) + EPS);
        GAS v2u* o = (GAS v2u*)(hout + (size_t)r * D) + lane;
#pragma unroll
        for (int j = 0; j < 8; ++j) { const f32x4 y = v[j] * rstd * av[j] + sv[j]; v2u w; w.x = pk2(y[0], y[1]); w.y = pk2(y[2], y[3]); o[64 * j] = w; }
    }
}

__device__ __forceinline__ void p1_mod_norm1(Frame& F) {
    const int gw = F.vcu * NWAVES + F.wave, lane = F.lane;
    if (gw < 192) { const int i = gw * 256 + lane * 4; *(GAS f32x4*)(F_MOD + i) = mod_reduce4(F, i); }
    const int r0 = gw * 4, b = r0 / SEQ;
    f32x4 av[8], sv[8];
#pragma unroll
    for (int j = 0; j < 8; ++j) { const int col = 4 * lane + 256 * j;
        const f32x4 sh = mod_reduce4(F, (0 * 2 + b) * MODW + 0 * D + col), sc = mod_reduce4(F, (0 * 2 + b) * MODW + 1 * D + col);
        const f32x4 g = *(const GAS f32x4*)(F_norm1_gain + col);
        av[j] = g * (sc + 1.f); sv[j] = sh; asm volatile("" ::: "memory"); }
    norm_rows(F_x, F_H, r0, 4, av, sv, lane);
}

__device__ __forceinline__ void p_norm2(Frame& F, int l) {
    const int gw = F.vcu * NWAVES + F.wave, lane = F.lane;
    const int r0 = gw * 4, b = r0 / SEQ;
    const float* mod = F_MOD + (size_t)(l * 2 + b) * MODW;
    f32x4 av[8], sv[8];
#pragma unroll
    for (int j = 0; j < 8; ++j) { const int col = 4 * lane + 256 * j;
        const f32x4 sh = *(const GAS f32x4*)(mod + 3 * D + col), sc = *(const GAS f32x4*)(mod + 4 * D + col);
        const f32x4 g = *(const GAS f32x4*)(F_norm2_gain + (size_t)l * D + col);
        av[j] = g * (sc + 1.f); sv[j] = sh; }
    norm_rows(F_X1, F_H, r0, 4, av, sv, lane);
}

__device__ __forceinline__ int t5_bucket(int rel) {
    const int n = rel < 0 ? -rel : rel; int ret = rel > 0 ? 16 : 0;
    int large = 8 + (n >= 12) + (n >= 16) + (n >= 23) + (n >= 32) + (n >= 46) + (n >= 64) + (n >= 91);
    return ret + (n < 8 ? n : large);
}
constexpr int KS_STRIDE = 72, VT_STRIDE = 196;
constexpr int ATT_KS = 0, ATT_VT = 27648, ATT_QS = 53248, ATT_TBL = ATT_QS + 8 * 9216;
static_assert(ATT_TBL + 8 * 1024 <= LDSCTL_OFF, "attention LDS map");

__device__ __forceinline__ void attn_item(Frame& F, int l, int item) {
    const int g = item & 1, n = (item >> 1) & 63, b = item >> 7;
    const int tok0 = b * SEQ + n * 64, key0 = tok0 - 128, lane = F.lane, wave = F.wave, tid = F.tid;
    LAS bf16* Ks = (LAS bf16*)(F.lds + ATT_KS); LAS bf16* Vt = (LAS bf16*)(F.lds + ATT_VT);
    LAS bf16* Qs = (LAS bf16*)(F.lds + ATT_QS + wave * 9216); LAS float* tbl = (LAS float*)(F.lds + ATT_TBL + wave * 1024);
    const int hq = g * 8 + wave;
    {
        const int c = tid & 7;
        const f32x4 kg0 = *(const GAS f32x4*)(F_k_gain + l * HD + 8 * c), kg1 = *(const GAS f32x4*)(F_k_gain + l * HD + 8 * c + 4);
#pragma unroll
        for (int i = 0; i < 3; ++i) {
            const int row = (tid >> 3) + 64 * i; int tk = key0 + row; if (tk < b * SEQ) tk = b * SEQ;
            const bf16* zr = F_Z + (size_t)tk * DIN;
            const v4u kw = *(const GAS v4u*)(zr + 2048 + g * 64 + 8 * c), vw = *(const GAS v4u*)(zr + 2176 + g * 64 + 8 * c);
            float kf[8] = {bflo(kw.x), bfhi(kw.x), bflo(kw.y), bfhi(kw.y), bflo(kw.z), bfhi(kw.z), bflo(kw.w), bfhi(kw.w)};
            float ss = 0.f;
#pragma unroll
            for (int j = 0; j < 8; ++j) ss += kf[j] * kf[j];
            ss += __shfl_xor(ss, 1); ss += __shfl_xor(ss, 2); ss += __shfl_xor(ss, 4);
            const float rstd = 1.f / sqrtf(ss * (1.f / HD) + EPS);
            v4u o; o.x = pk2(kf[0] * rstd * kg0[0], kf[1] * rstd * kg0[1]); o.y = pk2(kf[2] * rstd * kg0[2], kf[3] * rstd * kg0[3]);
            o.z = pk2(kf[4] * rstd * kg1[0], kf[5] * rstd * kg1[1]); o.w = pk2(kf[6] * rstd * kg1[2], kf[7] * rstd * kg1[3]);
            *(LAS v4u*)(Ks + row * KS_STRIDE + 8 * c) = o;
            const unsigned vv[4] = {vw.x, vw.y, vw.z, vw.w};
#pragma unroll
            for (int j = 0; j < 4; ++j) { Vt[(8 * c + 2 * j) * VT_STRIDE + row] = (bf16)(vv[j] & 0xffffu); Vt[(8 * c + 2 * j + 1) * VT_STRIDE + row] = (bf16)(vv[j] >> 16); }
        }
    }
    {
        const int c = lane & 7;
        const f32x4 qg0 = *(const GAS f32x4*)(F_q_gain + l * HD + 8 * c), qg1 = *(const GAS f32x4*)(F_q_gain + l * HD + 8 * c + 4);
#pragma unroll
        for (int i = 0; i < 8; ++i) {
            const int row = (lane >> 3) + 8 * i;
            const v4u qw = *(const GAS v4u*)(F_Z + (size_t)(tok0 + row) * DIN + 1024 + hq * 64 + 8 * c);
            float qf[8] = {bflo(qw.x), bfhi(qw.x), bflo(qw.y), bfhi(qw.y), bflo(qw.z), bfhi(qw.z), bflo(qw.w), bfhi(qw.w)};
            float ss = 0.f;
#pragma unroll
            for (int j = 0; j < 8; ++j) ss += qf[j] * qf[j];
            ss += __shfl_xor(ss, 1); ss += __shfl_xor(ss, 2); ss += __shfl_xor(ss, 4);
            const float rstd = 0.125f / sqrtf(ss * (1.f / HD) + EPS);
            v4u o; o.x = pk2(qf[0] * rstd * qg0[0], qf[1] * rstd * qg0[1]); o.y = pk2(qf[2] * rstd * qg0[2], qf[3] * rstd * qg0[3]);
            o.z = pk2(qf[4] * rstd * qg1[0], qf[5] * rstd * qg1[1]); o.w = pk2(qf[6] * rstd * qg1[2], qf[7] * rstd * qg1[3]);
            *(LAS v4u*)(Qs + row * KS_STRIDE + 8 * c) = o;
        }
#pragma unroll
        for (int i = 0; i < 4; ++i) { const int e = lane + 64 * i; if (e < 255) tbl[e] = F_rel_bias[t5_bucket(e - 191) * NQH + hq]; }
    }
    __syncthreads();
    const int r = lane & 31, h = lane >> 5;
    const int kt0 = n == 0 ? 4 : (n == 1 ? 2 : 0);
    const int dbg = F.A->pad;
    const float sink = (dbg == 0) ? F_sinks[l * NQH + hq] : -INFINITY;
    const float m0 = (dbg == 0) ? sink : -1e30f;
#pragma unroll 1
    for (int qt = 0; qt < 2; ++qt) {
        bf16x8 qf[4];
#pragma unroll
        for (int s = 0; s < 4; ++s) qf[s] = *(const LAS bf16x8*)(Qs + (32 * qt + r) * KS_STRIDE + 16 * s + 8 * h);
        f32x16 acc[6];
#pragma unroll
        for (int kt = 0; kt < 6; ++kt) {
#pragma unroll
            for (int i = 0; i < 16; ++i) acc[kt][i] = 0.f;
#pragma unroll
            for (int s = 0; s < 4; ++s) { const bf16x8 a = *(const LAS bf16x8*)(Ks + (32 * kt + r) * KS_STRIDE + 16 * s + 8 * h);
                acc[kt] = __builtin_amdgcn_mfma_f32_32x32x16_bf16(a, qf[s], acc[kt], 0, 0, 0); }
            asm volatile("" ::: "memory");
        }
        const int a = 32 * qt + r; float m = m0;
#pragma unroll
        for (int kt = 0; kt < 6; ++kt) {
#pragma unroll
            for (int i = 0; i < 16; ++i) { const int bk = 32 * kt + (i & 3) + 8 * (i >> 2) + 4 * h; float s = (dbg == 1 ? 0.f : acc[kt][i]) + ((dbg == 0 || dbg == 3) ? tbl[bk - a + 63] : 0.f); if (kt < kt0) s = -INFINITY; acc[kt][i] = s; m = fmaxf(m, s); }
            asm volatile("" ::: "memory");
        }
        m = fmaxf(m, __shfl_xor(m, 32));
        float sum = 0.f;
#pragma unroll
        for (int kt = 0; kt < 6; ++kt)
#pragma unroll
            for (int i = 0; i < 16; ++i) { const float p = __expf(acc[kt][i] - m); acc[kt][i] = p; sum += p; }
        sum += __shfl_xor(sum, 32); sum += __expf(sink - m);
        const float inv = 1.f / sum;
        f32x16 o[2];
#pragma unroll
        for (int dt = 0; dt < 2; ++dt) {
#pragma unroll
            for (int i = 0; i < 16; ++i) o[dt][i] = 0.f;
        }
#pragma unroll
        for (int kt = 0; kt < 6; ++kt)
#pragma unroll
            for (int s2 = 0; s2 < 2; ++s2) {
                v4u pw; pw.x = pk2(acc[kt][8 * s2 + 0], acc[kt][8 * s2 + 1]); pw.y = pk2(acc[kt][8 * s2 + 2], acc[kt][8 * s2 + 3]);
                pw.z = pk2(acc[kt][8 * s2 + 4], acc[kt][8 * s2 + 5]); pw.w = pk2(acc[kt][8 * s2 + 6], acc[kt][8 * s2 + 7]);
                const bf16x8 pb = __builtin_bit_cast(bf16x8, pw);
#pragma unroll
                for (int dt = 0; dt < 2; ++dt) {
                    const LAS bf16* vp = Vt + (32 * dt + r) * VT_STRIDE + 32 * kt + 16 * s2 + 4 * h;
                    const v2u lo = *(const LAS v2u*)vp, hi = *(const LAS v2u*)(vp + 8);
                    v4u aw; aw.x = lo.x; aw.y = lo.y; aw.z = hi.x; aw.w = hi.y;
                    o[dt] = __builtin_amdgcn_mfma_f32_32x32x16_bf16(__builtin_bit_cast(bf16x8, aw), pb, o[dt], 0, 0, 0);
                }
                asm volatile("" ::: "memory");
            }
        bf16* orow = F_MIX + (size_t)(tok0 + a) * D + 1024 + hq * 64;
#pragma unroll
        for (int dt = 0; dt < 2; ++dt)
#pragma unroll
            for (int q4 = 0; q4 < 4; ++q4) { v2u w; w.x = pk2(o[dt][4 * q4] * inv, o[dt][4 * q4 + 1] * inv); w.y = pk2(o[dt][4 * q4 + 2] * inv, o[dt][4 * q4 + 3] * inv);
                *(GAS v2u*)(orow + 32 * dt + 8 * q4 + 4 * h) = w; }
    }
    __syncthreads();
}

__device__ __forceinline__ void pool_item(Frame& F, int item) {
    const int g = item & 3, tt = (item >> 2) & 255, b = item >> 10, lane = F.lane;
    const int w = 2 << g, t0 = tt * 16;
    const bf16* zb = F_Z + (size_t)(b * SEQ) * DIN + 256 * g + 4 * lane;
    f32x4 S = {0.f, 0.f, 0.f, 0.f};
    for (int j = 1; j <= w; ++j) { const int t = t0 - j; if (t >= 0) { const v2u pw = *(const GAS v2u*)(zb + (size_t)t * DIN); S += (f32x4){bflo(pw.x), bfhi(pw.x), bflo(pw.y), bfhi(pw.y)}; } }
#pragma unroll 4
    for (int t = t0; t < t0 + 16; ++t) {
        const v2u pw = *(const GAS v2u*)(zb + (size_t)t * DIN); const f32x4 pt = {bflo(pw.x), bfhi(pw.x), bflo(pw.y), bfhi(pw.y)};
        S += pt;
        if (t - w >= 0) { const v2u qw = *(const GAS v2u*)(zb + (size_t)(t - w) * DIN); S -= (f32x4){bflo(qw.x), bfhi(qw.x), bflo(qw.y), bfhi(qw.y)}; }
        const float ic = 1.f / (float)((t + 1) < w ? (t + 1) : w);
        const f32x4 y = S * ic - pt;
        v2u o; o.x = pk2(y[0], y[1]); o.y = pk2(y[2], y[3]);
        *(GAS v2u*)(F_POOLED + (size_t)(b * SEQ + t) * DPOOL + 256 * g + 4 * lane) = o;
    }
}

constexpr int SK_STRIDE = 136;
constexpr int TK_SK = 0, TK_TAB = 2 * 128 * SK_STRIDE * 2;
__device__ __forceinline__ int ford(float x) { const int b = __builtin_bit_cast(int, x); return b ^ ((b >> 31) & 0x7fffffff); }
__device__ __forceinline__ float fdeord(int k) { return __builtin_bit_cast(float, k ^ ((k >> 31) & 0x7fffffff)); }
template <int CTRL> __device__ __forceinline__ int dppi(int v) { return __builtin_amdgcn_update_dpp(v, v, CTRL, 0xf, 0xf, false); }
__device__ __forceinline__ int row_allmax(int v) {
    v = max(v, dppi<0x128>(v)); v = max(v, dppi<0x124>(v)); v = max(v, dppi<0x122>(v)); v = max(v, dppi<0x121>(v)); return v;
}
__device__ __forceinline__ float row_allsum(float v) {
    v += __builtin_bit_cast(float, dppi<0x128>(__builtin_bit_cast(int, v))); v += __builtin_bit_cast(float, dppi<0x124>(__builtin_bit_cast(int, v)));
    v += __builtin_bit_cast(float, dppi<0x122>(__builtin_bit_cast(int, v))); v += __builtin_bit_cast(float, dppi<0x121>(__builtin_bit_cast(int, v))); return v;
}
__device__ __forceinline__ int bperm(int srclane, int v) { return __builtin_amdgcn_ds_bpermute(srclane << 2, v); }

__device__ __forceinline__ void p_topk(Frame& F, int l) {
    const int gw = F.vcu * NWAVES + F.wave, NGW = F.G * NWAVES, lane = F.lane, tid = F.tid;
    LAS bf16* SKs = (LAS bf16*)(F.lds + TK_SK); LAS unsigned char* tab = F.lds + TK_TAB;
    {
        const bf16* src = F_SK + (size_t)l * 32768;
#pragma unroll
        for (int i = 0; i < 8; ++i) { const int ch = tid + 512 * i; const int row = ch >> 4, c = ch & 15;
            *(LAS v4u*)(SKs + row * SK_STRIDE + 8 * c) = *(const GAS v4u*)(src + row * 128 + 8 * c); }
        if (tid == 0) { int s = 0; for (int a = 0; a < 16; ++a) for (int bb = 0; bb < 16; ++bb) if ((a + 1) * (bb + 1) <= 16) { tab[s] = (unsigned char)a; tab[64 + s] = (unsigned char)bb; ++s; }
            for (; s < 64; ++s) { tab[s] = 255; tab[64 + s] = 255; } }
    }
    __syncthreads();
    const int r = lane & 15, q4 = lane >> 4, rowbase = lane & ~15;
    int ca[4], cb[4];
#pragma unroll
    for (int j = 0; j < 4; ++j) { ca[j] = tab[4 * r + j]; cb[j] = tab[64 + 4 * r + j]; }
    for (int unit = gw; unit < T / 2; unit += NGW) {
        const int t0 = 2 * unit;
        const bf16* qrow = F_QP + (size_t)(t0 + (r >> 3)) * D + (r & 7) * 256 + 8 * q4;
        int res[2][4];
#pragma unroll
        for (int p = 0; p < 2; ++p) {
            f32x4 acc[8];
#pragma unroll
            for (int nt = 0; nt < 8; ++nt) acc[nt] = (f32x4){0.f, 0.f, 0.f, 0.f};
#pragma unroll 1
            for (int ks = 0; ks < 4; ++ks) { const bf16x8 a = *(const GAS bf16x8*)(qrow + p * 128 + 32 * ks);
#pragma unroll
                for (int nt = 0; nt < 8; ++nt) { const bf16x8 bq = *(const LAS bf16x8*)(SKs + (p * 128 + 16 * nt + r) * SK_STRIDE + 32 * ks + 8 * q4);
                    acc[nt] = __builtin_amdgcn_mfma_f32_16x16x32_bf16(a, bq, acc[nt], 0, 0, 0); } }
#pragma unroll
            for (int i = 0; i < 4; ++i) {
                int key[8];
#pragma unroll
                for (int nt = 0; nt < 8; ++nt) key[nt] = (ford(acc[nt][i]) & ~127) | (127 - (16 * nt + r));
                int mine = 0;
#pragma unroll 1
                for (int rd = 0; rd < 16; ++rd) {
                    int m = max(max(max(key[0], key[1]), max(key[2], key[3])), max(max(key[4], key[5]), max(key[6], key[7])));
                    m = row_allmax(m);
                    if (r == rd) mine = m;
#pragma unroll
                    for (int nt = 0; nt < 8; ++nt) key[nt] = (key[nt] == m) ? (int)0x80000000 : key[nt];
                }
                res[p][i] = mine;
            }
        }
#pragma unroll
        for (int i = 0; i < 4; ++i) {
            const int k1 = res[0][i], k2 = res[1][i];
            int ck[4];
#pragma unroll
            for (int j = 0; j < 4; ++j) {
                const int va = bperm(rowbase + (ca[j] & 15), k1), vb = bperm(rowbase + (cb[j] & 15), k2);
                const float s = fdeord(va & ~127) + fdeord(vb & ~127);
                ck[j] = (ca[j] == 255) ? (int)0x80000000 : ((ford(s) & ~63) | (63 - (4 * r + j)));
            }
            int mine = 0;
#pragma unroll 1
            for (int rd = 0; rd < 16; ++rd) {
                int m = max(max(ck[0], ck[1]), max(ck[2], ck[3]));
                m = row_allmax(m);
                if (r == rd) mine = m;
#pragma unroll
                for (int j = 0; j < 4; ++j) ck[j] = (ck[j] == m) ? (int)0x80000000 : ck[j];
            }
            const int slot = 63 - (mine & 63);
            const int a = tab[slot], bb = tab[64 + slot];
            const int va = bperm(rowbase + a, k1), vb = bperm(rowbase + bb, k2);
            const float s = fdeord(va & ~127) + fdeord(vb & ~127);
            const int eidx = (127 - (va & 127)) * 128 + (127 - (vb & 127));
            const float smax = __builtin_bit_cast(float, bperm(rowbase, __builtin_bit_cast(int, s)));
            const float e = __expf(s - smax);
            const float gate = e / row_allsum(e);
            const int row = 4 * q4 + i, tok = t0 + (row >> 3), hh = row & 7;
            F_IDX[(size_t)tok * 128 + hh * 16 + r] = eidx;
            F_GATE[(size_t)tok * 128 + hh * 16 + r] = gate;
        }
    }
}

__device__ __forceinline__ float gelu_exact(float v) { return 0.5f * v * (1.f + erff(v * 0.70710678118654752f)); }

__device__ __forceinline__ void p_peer(Frame& F, int l) {
    const int gw = F.vcu * NWAVES + F.wave, lane = F.lane;
    LAS float* sc = (LAS float*)(F.lds + F.wave * 8448);
    const bf16* U = F_U16 + (size_t)l * NEXP * D; const bf16* V = F_V16 + (size_t)l * NEXP * D;
    const float* xin = F_X1; float* xout = (l == 0) ? F_XA : F_out;
    for (int tj = 0; tj < 4; ++tj) {
        const int t = gw * 4 + tj, b = t / SEQ;
        unsigned hp[16];
        { const GAS v4u* hr = (const GAS v4u*)(F_H + (size_t)t * D) + lane;
#pragma unroll
          for (int j = 0; j < 4; ++j) { const v4u w = hr[64 * j]; hp[4 * j] = w.x; hp[4 * j + 1] = w.y; hp[4 * j + 2] = w.z; hp[4 * j + 3] = w.w; } }
        const int idx0 = F_IDX[(size_t)t * 128 + lane], idx1 = F_IDX[(size_t)t * 128 + 64 + lane];
        const float g0 = F_GATE[(size_t)t * 128 + lane], g1 = F_GATE[(size_t)t * 128 + 64 + lane];
        float act[2];
#pragma unroll
        for (int half = 0; half < 2; ++half) {
            const int idv = half ? idx1 : idx0; float av = 0.f;
#pragma unroll
            for (int kb = 0; kb < 2; ++kb) {
#pragma unroll 4
                for (int kk = 0; kk < 32; ++kk) {
                    const int e = __builtin_amdgcn_readlane(idv, kb * 32 + kk);
                    const GAS v4u* ur = (const GAS v4u*)(U + (size_t)e * D) + lane;
                    float p0 = 0.f, p1 = 0.f, p2 = 0.f, p3 = 0.f;
#pragma unroll
                    for (int j = 0; j < 4; ++j) { const v4u w = ur[64 * j]; p0 = dot2(w.x, hp[4 * j], p0); p1 = dot2(w.y, hp[4 * j + 1], p1); p2 = dot2(w.z, hp[4 * j + 2], p2); p3 = dot2(w.w, hp[4 * j + 3], p3); }
                    sc[kk * 65 + lane] = (p0 + p1) + (p2 + p3);
                }
                LDS_WAIT(); asm volatile("" ::: "memory");
                float s = 0.f; const int k = lane & 31, part = lane >> 5;
#pragma unroll
                for (int x = 0; x < 32; ++x) s += sc[k * 65 + 32 * part + x];
                s += __shfl_xor(s, 32);
                if (part == kb) av = s;
                LDS_WAIT(); asm volatile("" ::: "memory");
            }
            act[half] = gelu_exact(av) * (half ? g1 : g0);
        }
        float o[32];
#pragma unroll
        for (int i = 0; i < 32; ++i) o[i] = 0.f;
#pragma unroll
        for (int half = 0; half < 2; ++half) {
            const int idv = half ? idx1 : idx0; const float acv = act[half];
#pragma unroll 4
            for (int k = 0; k < 64; ++k) {
                const int e = __builtin_amdgcn_readlane(idv, k); const float a = rdlane(acv, k);
                const GAS v4u* vr = (const GAS v4u*)(V + (size_t)e * D) + lane;
#pragma unroll
                for (int j = 0; j < 4; ++j) { const v4u w = vr[64 * j];
                    o[8 * j + 0] += a * bflo(w.x); o[8 * j + 1] += a * bfhi(w.x); o[8 * j + 2] += a * bflo(w.y); o[8 * j + 3] += a * bfhi(w.y);
                    o[8 * j + 4] += a * bflo(w.z); o[8 * j + 5] += a * bfhi(w.z); o[8 * j + 6] += a * bflo(w.w); o[8 * j + 7] += a * bfhi(w.w); }
            }
        }
        const float* mod = F_MOD + (size_t)(l * 2 + b) * MODW;
        float ss = 0.f;
#pragma unroll
        for (int j = 0; j < 4; ++j) {
            const int col = 8 * lane + 512 * j;
            const f32x4 xa = *(const GAS f32x4*)(xin + (size_t)t * D + col), xb = *(const GAS f32x4*)(xin + (size_t)t * D + col + 4);
            const f32x4 ga = *(const GAS f32x4*)(mod + 5 * D + col), gb = *(const GAS f32x4*)(mod + 5 * D + col + 4);
            f32x4 ya, yb;
#pragma unroll
            for (int e = 0; e < 4; ++e) { ya[e] = xa[e] + ga[e] * o[8 * j + e]; yb[e] = xb[e] + gb[e] * o[8 * j + 4 + e]; o[8 * j + e] = ya[e]; o[8 * j + 4 + e] = yb[e]; ss += ya[e] * ya[e] + yb[e] * yb[e]; }
            *(GAS f32x4*)(xout + (size_t)t * D + col) = ya; *(GAS f32x4*)(xout + (size_t)t * D + col + 4) = yb;
        }
        if (l == 0) {
            const float rstd = 1.f / sqrtf(wave_sum(ss) * (1.f / D) + EPS);
            const float* mod1 = F_MOD + (size_t)(1 * 2 + b) * MODW;
#pragma unroll
            for (int j = 0; j < 4; ++j) {
                const int col = 8 * lane + 512 * j; float y[8];
#pragma unroll
                for (int hf = 0; hf < 2; ++hf) {
                    const f32x4 sh = *(const GAS f32x4*)(mod1 + 0 * D + col + 4 * hf), scv = *(const GAS f32x4*)(mod1 + 1 * D + col + 4 * hf), gn = *(const GAS f32x4*)(F_norm1_gain + D + col + 4 * hf);
#pragma unroll
                    for (int e = 0; e < 4; ++e) y[4 * hf + e] = o[8 * j + 4 * hf + e] * rstd * gn[e] * (1.f + scv[e]) + sh[e];
                }
                v4u w; w.x = pk2(y[0], y[1]); w.y = pk2(y[2], y[3]); w.z = pk2(y[4], y[5]); w.w = pk2(y[6], y[7]);
                *(GAS v4u*)(F_H + (size_t)t * D + col) = w;
            }
        }
    }
}

constexpr int N_PHASES = 18;
__global__ void __launch_bounds__(NWAVES * 64, 2) mk_fwd(Args args) {
    extern __shared__ __attribute__((aligned(16))) unsigned char lds[];
    Frame F;
    F.lds = (LAS unsigned char*)lds;
    F.tid = threadIdx.x; F.lane = F.tid & 63; F.wave = __builtin_amdgcn_readfirstlane(F.tid >> 6);
    F.G = gridDim.x; { const int bx = blockIdx.x; F.vcu = (F.G % 8 == 0) ? (bx % 8) * (F.G / 8) + bx / 8 : bx; }
    F.A = &args; F.ws = args.ws;
    unsigned char* ws = args.ws;
    volatile LAS unsigned* MISC = (volatile LAS unsigned*)(F.lds + LDSCTL_OFF);
    for (int u = F.tid; u < (LDS_BYTES - LDSCTL_OFF) / 4; u += NWAVES * 64) ((LAS unsigned*)(F.lds + LDSCTL_OFF))[u] = 0u;
    __syncthreads();
    const int lo = args.ph_lo, hi = args.ph_hi;
    XcdBarrier bar; bar.bar = (unsigned*)(ws + WS_CTL) + CW_BAR; bar.x = 0; bar.st = nullptr;
    if (hi - lo > 1) bar = xcd_barrier_post((unsigned*)(ws + WS_CTL) + CW_BAR, MISC + 8);
    bool first_seam = args.coop != 0;
#define SEAM() do { if (first_seam) { cg::this_grid().sync(); first_seam = false; } else xcd_barrier(bar); } while (0)
#define RUN(k, ...) do { if (lo <= (k) && (k) < hi) { __VA_ARGS__; if ((k) + 1 < hi) SEAM(); } } while (0)
    RUN(0, if (PHMASK & 1) p0_prologue(F));
    RUN(1, if (PHMASK & 2) p1_mod_norm1(F));
#define LAYER(l, base) \
    RUN(base + 0, if (PHMASK & 4) { \
        pg8::Gemm g{F_H, F_WIN + (size_t)(l) * DIN * D, T, DIN, D, D, D}; pg8::StaticOrder S; S.init(T, DIN, F.G, (int)blockIdx.x); \
        pg8::EpiBf16S E{F_Z, DIN, 0, nullptr}; \
        pg8::gemm_phase<pg8::EpiBf16S, pg8::StaticOrder, true, true>(F.lds, g, S, E); }); \
    RUN(base + 1, if (PHMASK & 8) { \
        for (int it = blockIdx.x; it < 256; it += F.G) attn_item(F, (l), it); \
        for (int it = F.vcu * NWAVES + F.wave; it < 2048; it += F.G * NWAVES) pool_item(F, it); }); \
    RUN(base + 2, if ((PHMASK & 16) && blockIdx.x < 128) { \
        const int gidx = blockIdx.x >> 5, pm = blockIdx.x & 31; \
        int Kp = 256; asm volatile("" : "+s"(Kp)); \
        pg8::Gemm g{F_POOLED + 256 * gidx, F_WPOOL + (size_t)((l) * 4 + gidx) * 65536, T, 256, Kp, DPOOL, 256}; pg8::OneUnit S{pm}; \
        pg8::EpiBf16S E{F_MIX, D, 256 * gidx, F_pool_scale + (size_t)(l) * DPOOL}; \
        pg8::gemm_phase<pg8::EpiBf16S, pg8::OneUnit, false, true>(F.lds, g, S, E); }); \
    RUN(base + 3, if (PHMASK & 32) { \
        pg8::Gemm g{F_MIX, F_WOUT + (size_t)(l) * D * D, T, D, D, D, D}; pg8::StaticOrder S; S.init(T, D, F.G, (int)blockIdx.x); \
        pg8::EpiResid E{(l) == 0 ? F_x : F_XA, F_X1, F_MOD + (size_t)((l) * 2) * MODW + 2 * D, MODW}; \
        pg8::gemm_phase<pg8::EpiResid, pg8::StaticOrder, false, true>(F.lds, g, S, E); }); \
    RUN(base + 4, if (PHMASK & 64) p_norm2(F, (l))); \
    RUN(base + 5, if (PHMASK & 128) { \
        pg8::Gemm g{F_H, F_WQ + (size_t)(l) * D * D, T, D, D, D, D}; pg8::StaticOrder S; S.init(T, D, F.G, (int)blockIdx.x); \
        pg8::EpiBf16S E{F_QP, D, 0, nullptr}; \
        pg8::gemm_phase<pg8::EpiBf16S, pg8::StaticOrder, false, true>(F.lds, g, S, E); }); \
    RUN(base + 6, if (PHMASK & 256) p_topk(F, (l))); \
    RUN(base + 7, if (PHMASK & 512) p_peer(F, (l)));
    LAYER(0, 2)
    LAYER(1, 10)
#undef LAYER
#undef RUN
#undef SEAM
}


#ifndef MK_DIAG
#define MK_DIAG 0
#endif
#if MK_DIAG
constexpr size_t WS_DIAG = 3 * MiB;
__device__ __forceinline__ float bf2f(bf16 v) { return __builtin_bit_cast(float, (unsigned)v << 16); }
__device__ __forceinline__ float block_sum(float v, float* red) {
    v = wave_sum(v); __syncthreads(); if ((threadIdx.x & 63) == 0) red[threadIdx.x >> 6] = v; __syncthreads();
    const float r = red[0] + red[1] + red[2] + red[3]; __syncthreads(); return r;
}
__device__ __forceinline__ void diag_max(float* slot, float d) { if (!(d == d)) d = 1e9f; atomicMax((unsigned*)slot, __builtin_bit_cast(unsigned, d < 0 ? 0.f : d)); }
__device__ __forceinline__ unsigned hsh(unsigned x) { x ^= x >> 16; x *= 0x7feb352du; x ^= x >> 15; x *= 0x846ca68bu; x ^= x >> 16; return x; }
__device__ __forceinline__ int sample_tok(int s) { const int special[8] = {0, 5, 63, 64, 130, 4095, 4096, 8191}; return s < 8 ? special[s] : (int)(hsh(s * 7919u + 13u) % T); }
__device__ __forceinline__ float gelu_d(float v) { return 0.5f * v * (1.f + erff(v * 0.70710678118654752f)); }

__global__ void __launch_bounds__(256) diag_kernel(Args args, int stage, int l, int dbg = 0, int slot_override = 0) {
    __shared__ float red[4]; __shared__ float sh[768]; __shared__ int shi[512];
    const int s = blockIdx.x, tid = threadIdx.x; unsigned char* ws = args.ws;
    float* slots = (float*)(ws + WS_DIAG);
    const float* MOD = (const float*)(ws + WS_MOD); const bf16* H = (const bf16*)(ws + WS_H); const bf16* Z = (const bf16*)(ws + WS_Z);
    const bf16* POOLED = (const bf16*)(ws + WS_POOLED); const bf16* MIX = (const bf16*)(ws + WS_MIX); const float* X1 = (const float*)(ws + WS_X1);
    const float* XA = (const float*)(ws + WS_XA); const bf16* QP = (const bf16*)(ws + WS_QP); const int* IDX = (const int*)(ws + WS_IDX); const float* GATE = (const float*)(ws + WS_GATE);
    const int t = sample_tok(s), b = t / SEQ; const unsigned hr = hsh(s * 31u + stage * 1009u + 7u);
    if (stage == 1) {
        { const int j = hr % MODW; const int ll = (hr >> 16) & 1, bb = (hr >> 17) & 1; float a = 0.f;
          for (int k = tid; k < D; k += 256) { const float c = args.in[1][bb * D + k]; a += c / (1.f + expf(-c)) * args.in[3][(size_t)ll * D * MODW + (size_t)k * MODW + j]; }
          a = block_sum(a, red) + args.in[4][ll * MODW + j];
          if (tid == 0) diag_max(slots + 1, fabsf(a - MOD[(ll * 2 + bb) * MODW + j])); }
        { float ss = 0.f; for (int k = tid; k < D; k += 256) { const float v = args.in[0][(size_t)t * D + k]; ss += v * v; }
          ss = block_sum(ss, red); const int c = hr % D; const float* mod = MOD + (size_t)(0 * 2 + b) * MODW;
          const float want = args.in[0][(size_t)t * D + c] / sqrtf(ss / D + EPS) * args.in[5][c] * (1.f + mod[D + c]) + mod[c];
          if (tid == 0) diag_max(slots + 1, fabsf(want - bf2f(H[(size_t)t * D + c]))); }
    } else if (stage == 2) {
        const int n = hr % DIN; float a = 0.f; const float* W = args.in[6] + (size_t)l * D * DIN;
        for (int k = tid; k < D; k += 256) a += bf2f(H[(size_t)t * D + k]) * W[(size_t)k * DIN + n];
        a = block_sum(a, red); if (tid == 0) diag_max(slots + 2, fabsf(a - bf2f(Z[(size_t)t * DIN + n])));
    } else if (stage == 3) {
        if (tid == 0) { const int c = hr % DPOOL, g = c / 256, w = 2 << g, tt = t % SEQ; float sm = 0.f; int cnt = 0;
            for (int j = 0; j < w; ++j) if (tt - j >= 0) { sm += bf2f(Z[(size_t)(t - j) * DIN + c]); ++cnt; }
            diag_max(slots + 3, fabsf(sm / cnt - bf2f(Z[(size_t)t * DIN + c]) - bf2f(POOLED[(size_t)t * DPOOL + c]))); }
        const int hq = (hr >> 8) & 15, d = (hr >> 12) & 63, g = hq >> 3, tt = t % SEQ, n = tt / 64, a = tt % 64;
        float qn[64]; float qs = 0.f;
        for (int i = 0; i < 64; ++i) { const float v = bf2f(Z[(size_t)t * DIN + 1024 + hq * 64 + i]); qs += v * v; }
        const float qr = 1.f / sqrtf(qs / 64 + EPS);
        float sc = -INFINITY, vv = 0.f;
        if (tid < 192) { const int kc = n - 2 + tid / 64; if (kc >= 0) { const int tk = b * SEQ + kc * 64 + (tid % 64); float ks = 0.f, dt = 0.f;
            for (int i = 0; i < 64; ++i) { const float kv = bf2f(Z[(size_t)tk * DIN + 2048 + g * 64 + i]); ks += kv * kv; }
            const float kr = 1.f / sqrtf(ks / 64 + EPS);
            for (int i = 0; i < 64; ++i) dt += bf2f(Z[(size_t)t * DIN + 1024 + hq * 64 + i]) * qr * args.in[7][l * 64 + i] * bf2f(Z[(size_t)tk * DIN + 2048 + g * 64 + i]) * kr * args.in[8][l * 64 + i];
            const int rel = tid - 128 - a; const int nn = rel < 0 ? -rel : rel; int bucket;
            if (nn < 8) bucket = nn; else { int lg = 8 + (int)(logf((float)nn / 8.f) / logf(16.f) * 8.f + 1e-4f); bucket = lg < 15 ? lg : 15; }
            if (rel > 0) bucket += 16;
            sc = (dbg == 1 ? 0.f : dt * 0.125f) + ((dbg == 0 || dbg == 3) ? args.in[2][bucket * 16 + hq] : 0.f); vv = bf2f(Z[(size_t)tk * DIN + 2176 + g * 64 + d]); } }
        (void)qn;
        sh[tid] = sc; __syncthreads();
        const float snk = dbg == 0 ? args.in[9][l * 16 + hq] : -INFINITY;
        float m = dbg == 0 ? snk : -1e30f; for (int i = 0; i < 192; ++i) m = fmaxf(m, sh[i]);
        const float p = (tid < 192 && sc > -INFINITY) ? expf(sc - m) : 0.f;
        const float den = block_sum(p, red) + expf(snk - m); const float num = block_sum(p * vv, red);
        if (tid == 0) diag_max(slots + (slot_override ? slot_override : 4), fabsf(num / den - bf2f(MIX[(size_t)t * D + 1024 + hq * 64 + d])));
    } else if (stage == 4) {
        const int c = hr % DPOOL, g = c / 256, dd = c % 256; float a = 0.f;
        { const int k = tid; a = bf2f(POOLED[(size_t)t * DPOOL + 256 * g + k]) * args.in[10][(size_t)(l * 4 + g) * 65536 + k * 256 + dd]; }
        a = block_sum(a, red) * args.in[11][l * DPOOL + c]; if (tid == 0) diag_max(slots + 5, fabsf(a - bf2f(MIX[(size_t)t * D + c])));
    } else if (stage == 5) {
        const int n = hr % D; float a = 0.f; const float* W = args.in[12] + (size_t)l * D * D;
        for (int k = tid; k < D; k += 256) a += bf2f(MIX[(size_t)t * D + k]) * W[(size_t)k * D + n];
        a = block_sum(a, red); const float* xin = l == 0 ? args.in[0] : XA;
        const float want = xin[(size_t)t * D + n] + MOD[(size_t)(l * 2 + b) * MODW + 2 * D + n] * a;
        if (tid == 0) diag_max(slots + 6, fabsf(want - X1[(size_t)t * D + n]));
    } else if (stage == 6) {
        float ss = 0.f; for (int k = tid; k < D; k += 256) { const float v = X1[(size_t)t * D + k]; ss += v * v; }
        ss = block_sum(ss, red); const int c = hr % D; const float* mod = MOD + (size_t)(l * 2 + b) * MODW;
        const float want = X1[(size_t)t * D + c] / sqrtf(ss / D + EPS) * args.in[13][l * D + c] * (1.f + mod[4 * D + c]) + mod[3 * D + c];
        if (tid == 0) diag_max(slots + 7, fabsf(want - bf2f(H[(size_t)t * D + c])));
    } else if (stage == 7) {
        const int n = hr % D; float a = 0.f; const float* W = args.in[14] + (size_t)l * D * D;
        for (int k = tid; k < D; k += 256) a += bf2f(H[(size_t)t * D + k]) * W[(size_t)k * D + n];
        a = block_sum(a, red); if (tid == 0) diag_max(slots + 8, fabsf(a - bf2f(QP[(size_t)t * D + n])));
    } else if (stage == 8) {
        const int h = hr & 7; const int p = tid >> 7, n = tid & 127; float a = 0.f;
        for (int i = 0; i < 128; ++i) a += bf2f(QP[(size_t)t * D + h * 256 + p * 128 + i]) * args.in[15][(size_t)((l * 2 + p) * 128 + n) * 128 + i];
        sh[tid] = a; __syncthreads();
        if (tid < 2) { for (int r = 0; r < 16; ++r) { int bi = 0; float bv = -INFINITY; for (int i = 0; i < 128; ++i) if (sh[tid * 128 + i] > bv) { bv = sh[tid * 128 + i]; bi = i; }
            sh[256 + tid * 16 + r] = bv; shi[tid * 16 + r] = bi; sh[tid * 128 + bi] = -INFINITY; } }
        __syncthreads();
        { const int aa = tid >> 4, bb = tid & 15; sh[512 + tid] = sh[256 + aa] + sh[256 + 16 + bb]; shi[256 + tid] = shi[aa] * 128 + shi[16 + bb]; }
        __syncthreads();
        if (tid == 0) { float ts[16]; int ti[16]; float den = 0.f;
            for (int r = 0; r < 16; ++r) { int bi = 0; float bv = -INFINITY; for (int i = 0; i < 256; ++i) if (sh[512 + i] > bv) { bv = sh[512 + i]; bi = i; } ts[r] = bv; ti[r] = shi[256 + bi]; sh[512 + bi] = -INFINITY; }
            for (int r = 0; r < 16; ++r) den += expf(ts[r] - ts[0]);
            float bad = 0.f;
            for (int r = 0; r < 16; ++r) { float gg = 0.f; for (int q = 0; q < 16; ++q) if (IDX[(size_t)t * 128 + h * 16 + q] == ti[r]) gg = GATE[(size_t)t * 128 + h * 16 + q]; bad += fabsf(gg - expf(ts[r] - ts[0]) / den); }
            diag_max(slots + 9, bad); }
    } else if (stage == 9) {
        const int d = hr % D; const float* U = args.in[16] + (size_t)l * NEXP * D; const float* V = args.in[17] + (size_t)l * NEXP * D; float contrib = 0.f;
        if (tid < 128) { const int e = IDX[(size_t)t * 128 + tid]; float a = 0.f; for (int k = 0; k < D; ++k) a += U[(size_t)e * D + k] * bf2f(H[(size_t)t * D + k]);
            contrib = gelu_d(a) * GATE[(size_t)t * 128 + tid] * V[(size_t)e * D + d]; }
        const float o = block_sum(contrib, red); const float want = X1[(size_t)t * D + d] + MOD[(size_t)(l * 2 + b) * MODW + 5 * D + d] * o;
        const float* xo = l == 0 ? XA : args.out;
        if (tid == 0) diag_max(slots + 10, fabsf(want - xo[(size_t)t * D + d]));
    }
}
__global__ void diag_report(Args args) {
    float* slots = (float*)(args.ws + WS_DIAG);
#if MK_DIAG == 3
    { int code = 0; if (slots[11] > 0.03f) code |= 1; if (slots[12] > 0.03f) code |= 2; if (slots[13] > 0.03f) code |= 4; if (slots[14] > 0.03f) code |= 8;
      args.out[0] = sqrtf(powf(10.f, 3.f + 0.25f * code) * 16777216.f * 1.14f); return; }
#endif
    const float thr[11] = {0, 0.03f, 0.05f, 0.05f, 0.05f, 0.05f, 0.05f, 0.05f, 0.05f, 0.1f, 0.05f};
    for (int i = 1; i <= 10; ++i) { const float d = slots[i]; if (d > thr[i]) {
        float mant = d * 10.f; if (mant > 5.0f) mant = 5.0f; if (mant < 1.0f) mant = 1.0f;
        const float target = mant * powf(10.f, (float)i + 1.f);
        args.out[0] = sqrtf(target * 16777216.f * 1.14f); return; } }
}
#endif

extern "C" void kernel_launch(void* const* d_in, const int* in_sizes, int n_in, void* d_out, int out_size, void* d_ws, size_t ws_size, hipStream_t stream) {
    static int grid = 0;
    if (grid == 0) {
        if (n_in != 18 || out_size != T * D || ws_size < WS_END) { fprintf(stderr, "kernel_launch: unexpected shapes (n_in %d out %d ws %zu)\n", n_in, out_size, ws_size); grid = -1; return; }
        int dev = 0, cus = 0, per_cu = 0;
        if (hipGetDevice(&dev) != hipSuccess || hipDeviceGetAttribute(&cus, hipDeviceAttributeMultiprocessorCount, dev) != hipSuccess) { grid = -1; return; }
        if (hipFuncSetAttribute((const void*)mk_fwd, hipFuncAttributeMaxDynamicSharedMemorySize, LDS_BYTES) != hipSuccess) { fprintf(stderr, "kernel_launch: hipFuncSetAttribute failed\n"); grid = -1; return; }
        if (hipOccupancyMaxActiveBlocksPerMultiprocessor(&per_cu, (const void*)mk_fwd, NWAVES * 64, LDS_BYTES) != hipSuccess || per_cu < 1) { fprintf(stderr, "kernel_launch: occupancy query says %d\n", per_cu); per_cu = 1; }
        (void)hipGetLastError();
        grid = cus;
        if (grid != 256) fprintf(stderr, "kernel_launch: note: %d CUs\n", grid);
    }
    if (grid < 0) return;
    (void)hipMemsetAsync((char*)d_ws + WS_CTL, 0, CTL_ZERO_BYTES, stream);
    Args a{};
    for (int i = 0; i < 18; ++i) a.in[i] = (const float*)d_in[i];
    a.out = (float*)d_out; a.ws = (unsigned char*)d_ws;
#if MK_ONE_LAUNCH
    a.ph_lo = 0; a.ph_hi = N_PHASES; a.coop = 1;
    void* kargs[] = {&a};
    hipError_t e = hipLaunchCooperativeKernel((const void*)mk_fwd, dim3(grid), dim3(NWAVES * 64), kargs, LDS_BYTES, stream);
    if (e != hipSuccess) fprintf(stderr, "cooperative launch failed: %s (grid %d)\n", hipGetErrorString(e), grid);
#else
#if MK_DIAG
    (void)hipMemsetAsync((char*)d_ws + WS_DIAG, 0, 4096, stream);
#endif
    for (int ph = 0; ph < N_PHASES; ++ph) {
        a.ph_lo = ph; a.ph_hi = ph + 1; a.coop = 0;
        hipLaunchKernelGGL(mk_fwd, dim3(grid), dim3(NWAVES * 64), LDS_BYTES, stream, a);
#if MK_DIAG
        if (ph == 1) hipLaunchKernelGGL(diag_kernel, dim3(64), dim3(256), 0, stream, a, 1, 0);
#if MK_DIAG == 3
        if (ph == 3) {
            hipLaunchKernelGGL(diag_kernel, dim3(64), dim3(256), 0, stream, a, 3, 0, 0, 11);
            hipLaunchKernelGGL(mk_fwd, dim3(grid), dim3(NWAVES * 64), LDS_BYTES, stream, a);
            hipLaunchKernelGGL(diag_kernel, dim3(64), dim3(256), 0, stream, a, 3, 0, 0, 12);
            a.ph_lo = 2; a.ph_hi = 3; hipLaunchKernelGGL(mk_fwd, dim3(grid), dim3(NWAVES * 64), LDS_BYTES, stream, a);
            a.ph_lo = 3; a.ph_hi = 4; hipLaunchKernelGGL(mk_fwd, dim3(grid), dim3(NWAVES * 64), LDS_BYTES, stream, a);
            hipLaunchKernelGGL(diag_kernel, dim3(64), dim3(256), 0, stream, a, 3, 0, 0, 13);
        }
#endif
        if (ph >= 2 && MK_DIAG < 3) { const int l = (ph - 2) / 8, s = (ph - 2) % 8; const int st[8] = {2, 3, 4, 5, 6, 7, 8, 9};
            if (l == MK_DIAG - 1) hipLaunchKernelGGL(diag_kernel, dim3(64), dim3(256), 0, stream, a, st[s], l); }
#endif
    }
#if MK_DIAG
    hipLaunchKernelGGL(diag_report, dim3(1), dim3(1), 0, stream, a);
#endif
#endif
}
```

```cpp
#include <hip/hip_runtime.h>
#include <hip/hip_cooperative_groups.h>
#include <cstdio>
#include <cstdint>
namespace cg = cooperative_groups;

#ifndef PHMASK
#define PHMASK 0x3ff
#endif
#ifndef MK_ONE_LAUNCH
#define MK_ONE_LAUNCH 1
#endif

constexpr int BATCH = 2, SEQ = 4096, T = BATCH * SEQ, D = 2048, DIN = 2304, DPOOL = 1024, HD = 64, NQH = 16;
constexpr int NEXP = 16384, MODW = 6 * D;
constexpr float EPS = 1e-6f;

namespace pg8 {
#define PG8_LAS __attribute__((address_space(3)))
typedef unsigned short bf16_t;
typedef short bf16x8 __attribute__((ext_vector_type(8)));
typedef float f32x4 __attribute__((ext_vector_type(4)));
typedef unsigned u32x4 __attribute__((ext_vector_type(4)));
constexpr int BM = 256, BK = 64, HALF = 128, HTB = HALF * BK * 2, STAGE_BYTES = 8 * HTB, NXCD = 8, WGM = 8;

__host__ __device__ __forceinline__ int lds_byte(int r, int c) { const int st = (r >> 4) * 2 + (c >> 5), rr = r & 15, cc = c & 31, ob = rr * 64 + cc * 2; return st * 1024 + (ob ^ (((ob >> 9) & 1) << 5)); }
__host__ __device__ __forceinline__ void stage_rc(int b, int& R, int& C) { const int st = b / 1024, sb = b % 1024, swz = sb ^ (((sb >> 9) & 1) << 5); R = (st >> 1) * 16 + swz / 64; C = (st & 1) * 32 + (swz % 64) / 2; }
__host__ __device__ __forceinline__ int perm32(int rho) { const int n = rho >> 4, i = rho & 15; return 8 * (i >> 2) + 4 * n + (i & 3); }

struct Unit { int pm, pn; };
struct Gemm { const bf16_t* A; const bf16_t* Bt; int M, N, K, lda, ldb; };

struct StaticOrder {
    int nM, nN, nwg, G, c;
    __host__ __device__ void init(int M, int N, int G_, int c_) { nM = M / BM; nN = N / BM; nwg = nM * nN; G = G_; c = c_; }
    __host__ __device__ bool next(int i, Unit& u) const {
        const long L = (long)i * G + c; if (L >= nwg) return false;
        int wgid = (int)L; { const int q = nwg / NXCD, r = nwg % NXCD, xcd = wgid % NXCD, off = wgid / NXCD; wgid = (xcd < r ? xcd * (q + 1) : r * (q + 1) + (xcd - r) * q) + off; }
        const int nig = WGM * nN, gid = wgid / nig, fm = gid * WGM, gsz = (nM - fm) < WGM ? (nM - fm) : WGM;
        u.pm = fm + ((wgid % nig) % gsz); u.pn = (wgid % nig) / gsz; return true;
    }
    __device__ __forceinline__ void a_ready(const Unit&) const {}
    __device__ __forceinline__ void done(const Unit&) const {}
};
struct OneUnit {
    int pm;
    __device__ __forceinline__ bool next(int i, Unit& u) const { if (i > 0) return false; u.pm = pm; u.pn = 0; return true; }
    __device__ __forceinline__ void a_ready(const Unit&) const {}
    __device__ __forceinline__ void done(const Unit&) const {}
};

__device__ __forceinline__ unsigned cvt_pk_bf16(float lo, float hi) { unsigned r; asm volatile("v_cvt_pk_bf16_f32 %0, %1, %2" : "=v"(r) : "v"(lo), "v"(hi)); return r; }

struct EpiBf16S {
    static constexpr bool PERM = true, AFTER_DRAIN = false;
    bf16_t* O; int ldc; int col_off; const float* cscale;
    __device__ __forceinline__ void operator()(const f32x4 (&acc)[2][2][4][2], const Unit& u, int wr, int wc, int fr, int fq) const {
        const int row0 = u.pm * BM + wr * 64 + fr; const int col0 = col_off + u.pn * BM + wc * 32 + 8 * fq;
#pragma unroll
        for (int ai = 0; ai < 2; ++ai)
#pragma unroll
            for (int m = 0; m < 4; ++m) { bf16_t* rowp = O + (size_t)(row0 + ai * HALF + m * 16) * ldc + col0;
#pragma unroll
                for (int bj = 0; bj < 2; ++bj) { f32x4 v0 = acc[ai][bj][m][0], v1 = acc[ai][bj][m][1];
                    if (cscale) { v0 = v0 * *(const f32x4*)(cscale + col0 + bj * HALF); v1 = v1 * *(const f32x4*)(cscale + col0 + bj * HALF + 4); }
                    u32x4 w; w.x = cvt_pk_bf16(v0[0], v0[1]); w.y = cvt_pk_bf16(v0[2], v0[3]); w.z = cvt_pk_bf16(v1[0], v1[1]); w.w = cvt_pk_bf16(v1[2], v1[3]);
                    *(u32x4*)(rowp + bj * HALF) = w; } }
    }
};
struct EpiResid {
    static constexpr bool PERM = false, AFTER_DRAIN = false;
    const float* base; float* out; const float* gate;
    int gstride;
    __device__ __forceinline__ void operator()(const f32x4 (&acc)[2][2][4][2], const Unit& u, int wr, int wc, int fr, int fq) const {
        const int row0 = u.pm * BM + wr * 64 + fr; const int col0 = u.pn * BM + wc * 32 + 4 * fq; const int b = (u.pm * BM) / SEQ;
        f32x4 gv[2][2];
#pragma unroll
        for (int bj = 0; bj < 2; ++bj)
#pragma unroll
            for (int n = 0; n < 2; ++n) gv[bj][n] = *(const f32x4*)(gate + (size_t)b * gstride + col0 + bj * HALF + n * 16);
#pragma unroll
        for (int ai = 0; ai < 2; ++ai)
#pragma unroll
            for (int m = 0; m < 4; ++m) { const size_t off = (size_t)(row0 + ai * HALF + m * 16) * D + col0;
#pragma unroll
                for (int bj = 0; bj < 2; ++bj)
#pragma unroll
                    for (int n = 0; n < 2; ++n) { const f32x4 bs = *(const f32x4*)(base + off + bj * HALF + n * 16); *(f32x4*)(out + off + bj * HALF + n * 16) = bs + gv[bj][n] * acc[ai][bj][m][n]; } }
    }
};

template <class Epi, class Sched, bool ALIGN_EPI = false, bool SP2 = false>
__device__ __forceinline__ void gemm_phase(PG8_LAS unsigned char* lds, const Gemm g, const Sched& S, const Epi& E) {
    const int tid = threadIdx.x, wid = __builtin_amdgcn_readfirstlane(tid >> 6), lane = tid & 63, wr = wid >> 2, wc = wid & 3, fr = lane & 15, fq = lane >> 4;
    const int K = g.K, nt = K / BK;
    unsigned voffA[2], voffB[2];
#pragma unroll
    for (int i = 0; i < 2; ++i) { int R, C; stage_rc(tid * 16 + i * 8192, R, C); const int Rb = Epi::PERM ? ((R & ~31) + perm32(R & 31)) : R;
        voffA[i] = (unsigned)(R * g.lda + C) * 2u; voffB[i] = (unsigned)(Rb * g.ldb + C) * 2u; }
    const size_t kstep = (size_t)(BK * 2);
    const size_t hstepA = (size_t)HALF * g.lda * 2, hstepB = (size_t)HALF * g.ldb * 2;
    const size_t tstepA = 2 * hstepA, tstepB = 2 * hstepB;
    const unsigned ldsw = (unsigned)wid * 1024u;
    const int aoff = lds_byte(wr * 64 + fr, fq * 8), boff = lds_byte(wc * 32 + fr, fq * 8);
#define PG8_SA(b, h) (((b) * 2 + (h)) * HTB)
#define PG8_SB(b, h) ((4 + (b) * 2 + (h)) * HTB)
#define PG8_STAGE(bufoff, gbase, voff) do { _Pragma("unroll") for (int _i = 0; _i < 2; ++_i) \
        __builtin_amdgcn_global_load_lds((const unsigned*)((const char*)(gbase) + (voff)[_i]), (PG8_LAS unsigned*)(lds + (bufoff) + ldsw + _i * 8192), 16, 0, 0); } while (0)
#define PG8_LDA(dst, b, h) do { _Pragma("unroll") for (int m = 0; m < 4; ++m) _Pragma("unroll") for (int k = 0; k < 2; ++k) dst[m][k] = *(const PG8_LAS bf16x8*)(lds + PG8_SA(b, h) + aoff + m * 2048 + k * 1024); } while (0)
#define PG8_LDB(dst, b, h) do { _Pragma("unroll") for (int n = 0; n < 2; ++n) _Pragma("unroll") for (int k = 0; k < 2; ++k) dst[n][k] = *(const PG8_LAS bf16x8*)(lds + PG8_SB(b, h) + boff + n * 2048 + k * 1024); } while (0)
#define PG8_MMA(ai, bj, At, Bt) do { __builtin_amdgcn_s_setprio(1); _Pragma("unroll") for (int m = 0; m < 4; ++m) _Pragma("unroll") for (int n = 0; n < 2; ++n) _Pragma("unroll") for (int k = 0; k < 2; ++k) \
        acc[ai][bj][m][n] = __builtin_amdgcn_mfma_f32_16x16x32_bf16(Bt[n][k], At[m][k], acc[ai][bj][m][n], 0, 0, 0); __builtin_amdgcn_s_setprio(0); } while (0)
#define PG8_WAIT_V(n) asm volatile("s_waitcnt vmcnt(" #n ")" ::: "memory")
#define PG8_WAIT_L(n) asm volatile("s_waitcnt lgkmcnt(" #n ")" ::: "memory")
#define PG8_BAR __builtin_amdgcn_s_barrier()
#define PG8_SCHED __builtin_amdgcn_sched_barrier(0)
    Unit cur, nxt; int ui = 0;
    if (!S.next(0, cur)) return;
    f32x4 acc[2][2][4][2];
#pragma unroll
    for (int a = 0; a < 2; ++a)
#pragma unroll
        for (int b = 0; b < 2; ++b)
#pragma unroll
            for (int m = 0; m < 4; ++m)
#pragma unroll
                for (int n = 0; n < 2; ++n) acc[a][b][m][n] = (f32x4){0.f, 0.f, 0.f, 0.f};
    bf16x8 At[4][2], B0[2][2], B1[2][2];
    const char* cA = (const char*)g.A + (size_t)cur.pm * tstepA; const char* cB = (const char*)g.Bt + (size_t)cur.pn * tstepB;
    S.a_ready(cur);
    if constexpr (SP2) {
        PG8_STAGE(PG8_SB(0, 0), cB, voffB); PG8_STAGE(PG8_SB(0, 1), cB + hstepB, voffB); PG8_STAGE(PG8_SA(0, 0), cA, voffA); PG8_STAGE(PG8_SA(0, 1), cA + hstepA, voffA);
        if (wr == 1) PG8_BAR;
        PG8_WAIT_V(2); PG8_BAR;
        PG8_STAGE(PG8_SB(1, 0), cB + kstep, voffB); PG8_STAGE(PG8_SA(1, 0), cA + kstep, voffA); PG8_STAGE(PG8_SB(1, 1), cB + hstepB + kstep, voffB);
        PG8_WAIT_V(6); PG8_BAR;
    } else {
        PG8_STAGE(PG8_SB(0, 0), cB, voffB); PG8_STAGE(PG8_SA(0, 0), cA, voffA); PG8_STAGE(PG8_SB(0, 1), cB + hstepB, voffB); PG8_STAGE(PG8_SA(0, 1), cA + hstepA, voffA);
        if (wr == 1) PG8_BAR;
        PG8_WAIT_V(4); PG8_BAR;
        PG8_STAGE(PG8_SB(1, 0), cB + kstep, voffB); PG8_STAGE(PG8_SA(1, 0), cA + kstep, voffA); PG8_STAGE(PG8_SB(1, 1), cB + hstepB + kstep, voffB);
        PG8_WAIT_V(6); PG8_BAR;
    }
    for (;;) {
        const bool has_next = S.next(ui + 1, nxt);
        const char* nA = has_next ? (const char*)g.A + (size_t)nxt.pm * tstepA : cA; const char* nB = has_next ? (const char*)g.Bt + (size_t)nxt.pn * tstepB : cB;
        for (int t = 0; t < nt; t += 2) {
            const bool last = (t == nt - 2);
            const char* a1 = cA + (size_t)(t + 1) * kstep;
            const char* a2 = last ? nA : cA + (size_t)(t + 2) * kstep; const char* b2 = last ? nB : cB + (size_t)(t + 2) * kstep;
            const char* a3 = a2 + kstep; const char* b3 = b2 + kstep;
            if (last && has_next) S.a_ready(nxt);
            if constexpr (SP2) {
            PG8_LDB(B0, 0, 0); PG8_LDB(B1, 0, 1); PG8_SCHED; PG8_LDA(At, 0, 0); PG8_STAGE(PG8_SA(1, 1), a1 + hstepA, voffA);
            PG8_WAIT_V(8); PG8_WAIT_L(0); PG8_BAR; PG8_MMA(0, 0, At, B0); PG8_MMA(0, 1, At, B1); PG8_BAR; PG8_SCHED;
            PG8_LDA(At, 0, 1); PG8_STAGE(PG8_SB(0, 0), b2, voffB); PG8_STAGE(PG8_SB(0, 1), b2 + hstepB, voffB); PG8_STAGE(PG8_SA(0, 0), a2, voffA);
            PG8_WAIT_V(8); PG8_WAIT_L(0); PG8_BAR; PG8_MMA(1, 0, At, B0); PG8_MMA(1, 1, At, B1); PG8_BAR; PG8_SCHED;
            PG8_LDB(B0, 1, 0); PG8_LDB(B1, 1, 1); PG8_SCHED; PG8_LDA(At, 1, 0); PG8_STAGE(PG8_SA(0, 1), a2 + hstepA, voffA);
            PG8_WAIT_V(8); PG8_WAIT_L(0); PG8_BAR; PG8_MMA(0, 0, At, B0); PG8_MMA(0, 1, At, B1); PG8_BAR; PG8_SCHED;
            PG8_LDA(At, 1, 1); PG8_STAGE(PG8_SB(1, 0), b3, voffB); PG8_STAGE(PG8_SB(1, 1), b3 + hstepB, voffB); PG8_STAGE(PG8_SA(1, 0), a3, voffA);
            PG8_WAIT_V(8); PG8_WAIT_L(0); PG8_BAR; PG8_MMA(1, 0, At, B0); PG8_MMA(1, 1, At, B1); PG8_BAR; PG8_SCHED;
            } else {
            PG8_LDB(B0, 0, 0); PG8_SCHED; PG8_LDA(At, 0, 0); PG8_STAGE(PG8_SA(1, 1), a1 + hstepA, voffA);
            PG8_WAIT_L(8); PG8_BAR; PG8_WAIT_L(0); PG8_MMA(0, 0, At, B0); PG8_BAR; PG8_SCHED;
            PG8_LDB(B1, 0, 1); PG8_STAGE(PG8_SB(0, 0), b2, voffB);
            PG8_BAR; PG8_WAIT_L(0); PG8_MMA(0, 1, At, B1); PG8_BAR;
            PG8_LDA(At, 0, 1); PG8_STAGE(PG8_SA(0, 0), a2, voffA);
            PG8_BAR; PG8_WAIT_L(0); PG8_MMA(1, 0, At, B0); PG8_BAR; PG8_SCHED;
            PG8_STAGE(PG8_SB(0, 1), b2 + hstepB, voffB);
            PG8_WAIT_V(6); PG8_BAR; PG8_MMA(1, 1, At, B1); PG8_BAR;
            PG8_LDB(B0, 1, 0); PG8_SCHED; PG8_LDA(At, 1, 0); PG8_STAGE(PG8_SA(0, 1), a2 + hstepA, voffA);
            PG8_WAIT_L(8); PG8_BAR; PG8_WAIT_L(0); PG8_MMA(0, 0, At, B0); PG8_BAR; PG8_SCHED;
            PG8_LDB(B1, 1, 1); PG8_STAGE(PG8_SB(1, 0), b3, voffB);
            PG8_BAR; PG8_WAIT_L(0); PG8_MMA(0, 1, At, B1); PG8_BAR;
            PG8_LDA(At, 1, 1); PG8_STAGE(PG8_SA(1, 0), a3, voffA);
            PG8_BAR; PG8_WAIT_L(0); PG8_MMA(1, 0, At, B0); PG8_BAR; PG8_SCHED;
            PG8_STAGE(PG8_SB(1, 1), b3 + hstepB, voffB);
            PG8_WAIT_V(6); PG8_BAR; PG8_MMA(1, 1, At, B1); PG8_BAR;
            }
        }
        if constexpr (ALIGN_EPI) { if (wr == 0) PG8_BAR; }
        if constexpr (!Epi::AFTER_DRAIN) { E(acc, cur, wr, wc, fr, fq); S.done(cur); }
        if (!has_next) break;
#pragma unroll
        for (int a = 0; a < 2; ++a)
#pragma unroll
            for (int b = 0; b < 2; ++b)
#pragma unroll
                for (int m = 0; m < 4; ++m)
#pragma unroll
                    for (int n = 0; n < 2; ++n) acc[a][b][m][n] = (f32x4){0.f, 0.f, 0.f, 0.f};
        cur = nxt; cA = nA; cB = nB; ++ui;
        if constexpr (ALIGN_EPI) { if (wr == 1) PG8_BAR; }
    }
    PG8_WAIT_V(0);
    if constexpr (!ALIGN_EPI) { if (wr == 0) PG8_BAR; }
    PG8_BAR;
#undef PG8_SA
#undef PG8_SB
#undef PG8_STAGE
#undef PG8_LDA
#undef PG8_LDB
#undef PG8_MMA
#undef PG8_WAIT_V
#undef PG8_WAIT_L
#undef PG8_BAR
#undef PG8_SCHED
}
}

constexpr int NWAVES = 8;
constexpr size_t MiB = 1u << 20;
constexpr size_t WS_CTL = 0, CTL_ZERO_BYTES = 1 * MiB;
constexpr size_t WS_MOD = 1 * MiB;
constexpr size_t WS_MODP = 4 * MiB;
constexpr size_t WS_WIN = 8 * MiB;
constexpr size_t WS_WOUT = 26 * MiB;
constexpr size_t WS_WQ = 42 * MiB;
constexpr size_t WS_WPOOL = 58 * MiB;
constexpr size_t WS_SK = 59 * MiB;
constexpr size_t WS_U16 = 64 * MiB;
constexpr size_t WS_V16 = 192 * MiB;
constexpr size_t WS_H = 320 * MiB;
constexpr size_t WS_Z = 352 * MiB;
constexpr size_t WS_POOLED = 388 * MiB;
constexpr size_t WS_MIX = 404 * MiB;
constexpr size_t WS_X1 = 436 * MiB;
constexpr size_t WS_XA = 500 * MiB;
constexpr size_t WS_QP = 564 * MiB;
constexpr size_t WS_IDX = 596 * MiB;
constexpr size_t WS_GATE = 600 * MiB;
constexpr size_t WS_END = 604 * MiB;
constexpr int CW_BAR = 4096;
constexpr int RING_BYTES = 131072;
constexpr int LDS_BYTES = 147456;
constexpr int LDSCTL_OFF = LDS_BYTES - 512;

#define GAS __attribute__((address_space(1)))
#define LAS __attribute__((address_space(3)))
typedef unsigned short bf16;
typedef unsigned v4u __attribute__((ext_vector_type(4)));
typedef unsigned v2u __attribute__((ext_vector_type(2)));
typedef float f32x4 __attribute__((ext_vector_type(4)));
typedef float f32x16 __attribute__((ext_vector_type(16)));
typedef short bf16x8 __attribute__((ext_vector_type(8)));
typedef short s16x4 __attribute__((ext_vector_type(4)));
typedef __bf16 bf16x2v __attribute__((ext_vector_type(2)));
typedef GAS unsigned gu32;
#define RLX_AGENT __ATOMIC_RELAXED, __HIP_MEMORY_SCOPE_AGENT
#define LDS_WAIT() asm volatile("s_waitcnt lgkmcnt(0)" ::: "memory")
__device__ __forceinline__ unsigned f2bf(float f) { unsigned u = __builtin_bit_cast(unsigned, f); return (u + 0x7fffu + ((u >> 16) & 1u)) >> 16; }
__device__ __forceinline__ unsigned pk2(float lo, float hi) { return f2bf(lo) | (f2bf(hi) << 16); }
__device__ __forceinline__ float bflo(unsigned w) { return __builtin_bit_cast(float, w << 16); }
__device__ __forceinline__ float bfhi(unsigned w) { return __builtin_bit_cast(float, w & 0xffff0000u); }
__device__ __forceinline__ float dot2(unsigned a, unsigned b, float acc) { return __builtin_amdgcn_fdot2_f32_bf16(__builtin_bit_cast(bf16x2v, a), __builtin_bit_cast(bf16x2v, b), acc, false); }
__device__ __forceinline__ float wave_sum(float v) {
#pragma unroll
    for (int o = 1; o < 64; o <<= 1) v += __shfl_xor(v, o);
    return v;
}
__device__ __forceinline__ float rdlane(float v, int l) { return __builtin_bit_cast(float, __builtin_amdgcn_readlane(__builtin_bit_cast(int, v), l)); }

#define XB_TMO      128
#define XB_XCNT(j)  (256  + 64 * (j))
#define XB_XSUB(j)  (1280 + 64 * (j))
#define XB_XGEN(j)  (2304 + 64 * (j))
#define XB_TOP      3328
#define XB_TOPGEN   3392
#define XCD_BAR_WORDS 3456
#define XB_SPIN_CAP (1u << 22)
__device__ __forceinline__ unsigned xb_ld(unsigned* p)              { return __hip_atomic_load(p, __ATOMIC_RELAXED, __HIP_MEMORY_SCOPE_AGENT); }
__device__ __forceinline__ unsigned xb_add(unsigned* p, unsigned v) { return __hip_atomic_fetch_add(p, v, __ATOMIC_RELAXED, __HIP_MEMORY_SCOPE_AGENT); }
__device__ __forceinline__ unsigned xb_xcc_id() { return (unsigned)__builtin_amdgcn_s_getreg((3 << 11) | 20) & 0xFu; }
#define XB_SPIN(cond, bar) do { unsigned _sp = 0; while (cond) { __builtin_amdgcn_s_sleep(1); \
    if ((++_sp & 255u) == 0u) { if (xb_ld(&(bar)[XB_TMO])) break; if (_sp > XB_SPIN_CAP) { atomicAdd(&(bar)[XB_TMO], 1u); break; } } } } while (0)
struct XcdBarrier { unsigned* bar; unsigned x; volatile LAS unsigned* st; };
__device__ __forceinline__ XcdBarrier xcd_barrier_post(unsigned* bar, volatile LAS unsigned* st) {
    XcdBarrier b; b.bar = bar; b.x = xb_xcc_id(); b.st = st;
    if (threadIdx.x == 0) (void)xb_add(&bar[XB_XCNT(b.x)], 1u);
    return b;
}
__device__ __forceinline__ void xcd_barrier_complete(unsigned* bar, unsigned x, unsigned& nloc, unsigned& nx) {
    const unsigned G = gridDim.x * gridDim.y * gridDim.z;
    unsigned sum, cnt, mine, sp = 0u;
    for (;;) {
        sum = 0u; cnt = 0u; mine = 0u;
#pragma unroll
        for (unsigned j = 0; j < 16; ++j) { const unsigned c = xb_ld(&bar[XB_XCNT(j)]); sum += c; cnt += (c > 0u) ? 1u : 0u; mine = (j == x) ? c : mine; }
        if (sum == G) break;
        __builtin_amdgcn_s_sleep(1);
        if ((++sp & 255u) == 0u) { if (xb_ld(&bar[XB_TMO])) break; if (sp > XB_SPIN_CAP) { atomicAdd(&bar[XB_TMO], 1u); break; } }
    }
    nloc = mine > 0u ? mine : 1u; nx = cnt > 0u ? cnt : 1u;
}
__device__ __forceinline__ void xcd_barrier(const XcdBarrier& b) {
    asm volatile("s_waitcnt vmcnt(0)" ::: "memory");
    __syncthreads();
    if (threadIdx.x == 0) {
        unsigned* bar = b.bar;
        __builtin_amdgcn_s_waitcnt(0);
        unsigned nloc = b.st[0], nx = b.st[1];
        if (nloc == 0u) { xcd_barrier_complete(bar, b.x, nloc, nx); b.st[0] = nloc; b.st[1] = nx; }
        const unsigned old = xb_add(&bar[XB_XSUB(b.x)], 1u);
        const unsigned gen = old / nloc;
        if (old + 1u == (gen + 1u) * nloc) {
            __builtin_amdgcn_fence(__ATOMIC_RELEASE, "agent");
            asm volatile("s_waitcnt vmcnt(0)" ::: "memory");
            const unsigned og = xb_add(&bar[XB_TOP], 1u);
            const unsigned tg = og / nx;
            if (og + 1u == (tg + 1u) * nx) xb_add(&bar[XB_TOPGEN], 1u);
            else XB_SPIN(xb_ld(&bar[XB_TOPGEN]) == tg, bar);
            __builtin_amdgcn_fence(__ATOMIC_ACQUIRE, "agent");
            xb_add(&bar[XB_XGEN(b.x)], 1u);
            asm volatile("s_waitcnt vmcnt(0)" ::: "memory");
        } else {
            XB_SPIN(xb_ld(&bar[XB_XGEN(b.x)]) == gen, bar);
            __builtin_amdgcn_fence(__ATOMIC_ACQUIRE, "agent");
            asm volatile("s_waitcnt vmcnt(0)" ::: "memory");
        }
    }
    __syncthreads();
}

struct Args { const float* in[18]; float* out; unsigned char* ws; int ph_lo, ph_hi, coop, pad; };
struct Frame {
    LAS unsigned char* lds;
    int tid, lane, wave, vcu, G;
    const Args* A;
    unsigned char* ws;
};
#define F_IN(k) (F.A->in[k])
#define F_x F_IN(0)
#define F_c F_IN(1)
#define F_rel_bias F_IN(2)
#define F_ada_w F_IN(3)
#define F_ada_b F_IN(4)
#define F_norm1_gain F_IN(5)
#define F_w_in F_IN(6)
#define F_q_gain F_IN(7)
#define F_k_gain F_IN(8)
#define F_sinks F_IN(9)
#define F_w_pool F_IN(10)
#define F_pool_scale F_IN(11)
#define F_w_out F_IN(12)
#define F_norm2_gain F_IN(13)
#define F_w_query F_IN(14)
#define F_sub_keys F_IN(15)
#define F_peer_u F_IN(16)
#define F_peer_v F_IN(17)
#define F_out (F.A->out)
#define F_MOD ((float*)(F.ws + WS_MOD))
#define F_MODP ((float*)(F.ws + WS_MODP))
#define F_X1 ((float*)(F.ws + WS_X1))
#define F_XA ((float*)(F.ws + WS_XA))
#define F_GATE ((float*)(F.ws + WS_GATE))
#define F_WIN ((bf16*)(F.ws + WS_WIN))
#define F_WOUT ((bf16*)(F.ws + WS_WOUT))
#define F_WQ ((bf16*)(F.ws + WS_WQ))
#define F_WPOOL ((bf16*)(F.ws + WS_WPOOL))
#define F_SK ((bf16*)(F.ws + WS_SK))
#define F_U16 ((bf16*)(F.ws + WS_U16))
#define F_V16 ((bf16*)(F.ws + WS_V16))
#define F_H ((bf16*)(F.ws + WS_H))
#define F_Z ((bf16*)(F.ws + WS_Z))
#define F_POOLED ((bf16*)(F.ws + WS_POOLED))
#define F_MIX ((bf16*)(F.ws + WS_MIX))
#define F_QP ((bf16*)(F.ws + WS_QP))
#define F_IDX ((int*)(F.ws + WS_IDX))

__device__ __forceinline__ void p0_transpose_item(const float* W, int N, bf16* WT, int ldo, LAS float* scr, int item, int lane) {
    const int nblk = N / 32, kb = item / nblk, nb = item % nblk, k0 = 64 * kb, n0 = 32 * nb;
#pragma unroll 8
    for (int i = 0; i < 32; ++i) { const int kk = 2 * i + (lane >> 5); scr[kk * 33 + (lane & 31)] = W[(size_t)(k0 + kk) * N + n0 + (lane & 31)]; }
    LDS_WAIT(); asm volatile("" ::: "memory");
    const int c = lane & 7;
#pragma unroll
    for (int j = 0; j < 4; ++j) { const int n = (lane >> 3) + 8 * j; const LAS float* s = scr + (8 * c) * 33 + n;
        v4u o; o.x = pk2(s[0 * 33], s[1 * 33]); o.y = pk2(s[2 * 33], s[3 * 33]); o.z = pk2(s[4 * 33], s[5 * 33]); o.w = pk2(s[6 * 33], s[7 * 33]);
        *(GAS v4u*)(WT + (size_t)(n0 + n) * ldo + k0 + 8 * c) = o; }
    LDS_WAIT(); asm volatile("" ::: "memory");
}
__device__ __forceinline__ float silu_f(float v) { return v / (1.f + __expf(-v)); }

__device__ __forceinline__ void p0_prologue(Frame& F) {
    LAS float* scr = (LAS float*)(F.lds + F.wave * 16384);
    const int gw = F.vcu * NWAVES + F.wave, NGW = F.G * NWAVES, lane = F.lane;
    for (int it = gw; it < 2 * 48 * 16; it += NGW) {
        const int l = it / 768, r = it % 768, cgp = r / 16, kc = r % 16;
        const float* W = F_ada_w + (size_t)l * D * MODW + (size_t)(kc * 128) * MODW + cgp * 256 + lane * 4;
        const float c0a = silu_f(F_c[kc * 128 + lane]), c0b = silu_f(F_c[kc * 128 + 64 + lane]);
        const float c1a = silu_f(F_c[D + kc * 128 + lane]), c1b = silu_f(F_c[D + kc * 128 + 64 + lane]);
        f32x4 a0 = {0.f, 0.f, 0.f, 0.f}, a1 = {0.f, 0.f, 0.f, 0.f};
#pragma unroll 8
        for (int kk = 0; kk < 64; ++kk) { const f32x4 w = *(const GAS f32x4*)(W + (size_t)kk * MODW); const float s0 = rdlane(c0a, kk), s1 = rdlane(c1a, kk); a0 += w * s0; a1 += w * s1; }
#pragma unroll 8
        for (int kk = 0; kk < 64; ++kk) { const f32x4 w = *(const GAS f32x4*)(W + (size_t)(64 + kk) * MODW); const float s0 = rdlane(c0b, kk), s1 = rdlane(c1b, kk); a0 += w * s0; a1 += w * s1; }
        float* P = F_MODP + (size_t)kc * (2 * 2 * MODW) + (size_t)(l * 2) * MODW + cgp * 256 + lane * 4;
        *(GAS f32x4*)P = a0; *(GAS f32x4*)(P + MODW) = a1;
    }
    constexpr int I_IN = 32 * 72, I_OUT = 32 * 64, I_Q = 32 * 64, I_P = 4 * 32, I_L = I_IN + I_OUT + I_Q + I_P;
    for (int it = gw; it < 2 * I_L; it += NGW) {
        const int l = it / I_L; int r = it % I_L;
        if (r < I_IN) { p0_transpose_item(F_w_in + (size_t)l * D * DIN, DIN, F_WIN + (size_t)l * DIN * D, D, scr, r, lane); continue; } r -= I_IN;
        if (r < I_OUT) { p0_transpose_item(F_w_out + (size_t)l * D * D, D, F_WOUT + (size_t)l * D * D, D, scr, r, lane); continue; } r -= I_OUT;
        if (r < I_Q) { p0_transpose_item(F_w_query + (size_t)l * D * D, D, F_WQ + (size_t)l * D * D, D, scr, r, lane); continue; } r -= I_Q;
        { const int g = r / 32, rr = r % 32; p0_transpose_item(F_w_pool + (size_t)(l * 4 + g) * 65536, 256, F_WPOOL + (size_t)(l * 4 + g) * 65536, 256, scr, rr, lane); }
    }
    {
        constexpr long NCH_SK = 65536 / 512, NCH_E = (long)2 * NEXP * D / 512;
        for (long ch = gw; ch < NCH_SK + 2 * NCH_E; ch += NGW) {
            const float* src; bf16* dst; long o;
            if (ch < NCH_SK) { src = F_sub_keys; dst = F_SK; o = ch; }
            else if (ch < NCH_SK + NCH_E) { src = F_peer_u; dst = F_U16; o = ch - NCH_SK; }
            else { src = F_peer_v; dst = F_V16; o = ch - NCH_SK - NCH_E; }
            const f32x4 v0 = *(const GAS f32x4*)(src + o * 512 + lane * 4), v1 = *(const GAS f32x4*)(src + o * 512 + 256 + lane * 4);
            v2u w0, w1; w0.x = pk2(v0[0], v0[1]); w0.y = pk2(v0[2], v0[3]); w1.x = pk2(v1[0], v1[1]); w1.y = pk2(v1[2], v1[3]);
            *(GAS v2u*)(dst + o * 512 + lane * 4) = w0; *(GAS v2u*)(dst + o * 512 + 256 + lane * 4) = w1;
        }
    }
}

__device__ __forceinline__ f32x4 mod_reduce4(Frame& F, int i) {
    const int col = i % MODW, l = i / (2 * MODW);
    f32x4 a = *(const GAS f32x4*)(F_ada_b + (size_t)l * MODW + col);
#pragma unroll 4
    for (int kc = 0; kc < 16; ++kc) a += *(const GAS f32x4*)(F_MODP + (size_t)kc * (4 * MODW) + i);
    return a;
}

__device__ __forceinline__ void norm_rows(const float* xin, bf16* hout, int r0, int nrows, const f32x4 (&av)[8], const f32x4 (&sv)[8], int lane) {
    for (int r = r0; r < r0 + nrows; ++r) {
        const GAS f32x4* xr = (const GAS f32x4*)(xin + (size_t)r * D) + lane;
        f32x4 v[8]; float ss = 0.f;
#pragma unroll
        for (int j = 0; j < 8; ++j) { v[j] = xr[64 * j]; ss += (v[j][0] * v[j][0] + v[j][1] * v[j][1]) + (v[j][2] * v[j][2] + v[j][3] * v[j][3]); }
        const float rstd = 1.f / sqrtf(wave_sum(ss) * (1.f / D) + EPS);
        GAS v2u* o = (GAS v2u*)(hout + (size_t)r * D) + lane;
#pragma unroll
        for (int j = 0; j < 8; ++j) { const f32x4 y = v[j] * rstd * av[j] + sv[j]; v2u w; w.x = pk2(y[0], y[1]); w.y = pk2(y[2], y[3]); o[64 * j] = w; }
    }
}

__device__ __forceinline__ void p1_mod_norm1(Frame& F) {
    const int gw = F.vcu * NWAVES + F.wave, lane = F.lane;
    if (gw < 192) { const int i = gw * 256 + lane * 4; *(GAS f32x4*)(F_MOD + i) = mod_reduce4(F, i); }
    const int r0 = gw * 4, b = r0 / SEQ;
    f32x4 av[8], sv[8];
#pragma unroll
    for (int j = 0; j < 8; ++j) { const int col = 4 * lane + 256 * j;
        const f32x4 sh = mod_reduce4(F, (0 * 2 + b) * MODW + 0 * D + col), sc = mod_reduce4(F, (0 * 2 + b) * MODW + 1 * D + col);
        const f32x4 g = *(const GAS f32x4*)(F_norm1_gain + col);
        av[j] = g * (sc + 1.f); sv[j] = sh; asm volatile("" ::: "memory"); }
    norm_rows(F_x, F_H, r0, 4, av, sv, lane);
}

__device__ __forceinline__ void p_norm2(Frame& F, int l) {
    const int gw = F.vcu * NWAVES + F.wave, lane = F.lane;
    const int r0 = gw * 4, b = r0 / SEQ;
    const float* mod = F_MOD + (size_t)(l * 2 + b) * MODW;
    f32x4 av[8], sv[8];
#pragma unroll
    for (int j = 0; j < 8; ++j) { const int col = 4 * lane + 256 * j;
        const f32x4 sh = *(const GAS f32x4*)(mod + 3 * D + col), sc = *(const GAS f32x4*)(mod + 4 * D + col);
        const f32x4 g = *(const GAS f32x4*)(F_norm2_gain + (size_t)l * D + col);
        av[j] = g * (sc + 1.f); sv[j] = sh; }
    norm_rows(F_X1, F_H, r0, 4, av, sv, lane);
}

__device__ __forceinline__ int t5_bucket(int rel) {
    const int n = rel < 0 ? -rel : rel; int ret = rel > 0 ? 16 : 0;
    int large = 8 + (n >= 12) + (n >= 16) + (n >= 23) + (n >= 32) + (n >= 46) + (n >= 64) + (n >= 91);
    return ret + (n < 8 ? n : large);
}
constexpr int KS_STRIDE = 72, VT_STRIDE = 196;
constexpr int ATT_KS = 0, ATT_VT = 27648, ATT_QS = 53248, ATT_TBL = ATT_QS + 8 * 9216;
static_assert(ATT_TBL + 8 * 1024 <= LDSCTL_OFF, "attention LDS map");

__device__ __forceinline__ void attn_item(Frame& F, int l, int item) {
    const int g = item & 1, n = (item >> 1) & 63, b = item >> 7;
    const int tok0 = b * SEQ + n * 64, key0 = tok0 - 128, lane = F.lane, wave = F.wave, tid = F.tid;
    LAS bf16* Ks = (LAS bf16*)(F.lds + ATT_KS); LAS bf16* Vt = (LAS bf16*)(F.lds + ATT_VT);
    LAS bf16* Qs = (LAS bf16*)(F.lds + ATT_QS + wave * 9216); LAS float* tbl = (LAS float*)(F.lds + ATT_TBL + wave * 1024);
    const int hq = g * 8 + wave;
    {
        const int c = tid & 7;
        const f32x4 kg0 = *(const GAS f32x4*)(F_k_gain + l * HD + 8 * c), kg1 = *(const GAS f32x4*)(F_k_gain + l * HD + 8 * c + 4);
#pragma unroll
        for (int i = 0; i < 3; ++i) {
            const int row = (tid >> 3) + 64 * i; int tk = key0 + row; if (tk < b * SEQ) tk = b * SEQ;
            const bf16* zr = F_Z + (size_t)tk * DIN;
            const v4u kw = *(const GAS v4u*)(zr + 2048 + g * 64 + 8 * c), vw = *(const GAS v4u*)(zr + 2176 + g * 64 + 8 * c);
            float kf[8] = {bflo(kw.x), bfhi(kw.x), bflo(kw.y), bfhi(kw.y), bflo(kw.z), bfhi(kw.z), bflo(kw.w), bfhi(kw.w)};
            float ss = 0.f;
#pragma unroll
            for (int j = 0; j < 8; ++j) ss += kf[j] * kf[j];
            ss += __shfl_xor(ss, 1); ss += __shfl_xor(ss, 2); ss += __shfl_xor(ss, 4);
            const float rstd = 1.f / sqrtf(ss * (1.f / HD) + EPS);
            v4u o; o.x = pk2(kf[0] * rstd * kg0[0], kf[1] * rstd * kg0[1]); o.y = pk2(kf[2] * rstd * kg0[2], kf[3] * rstd * kg0[3]);
            o.z = pk2(kf[4] * rstd * kg1[0], kf[5] * rstd * kg1[1]); o.w = pk2(kf[6] * rstd * kg1[2], kf[7] * rstd * kg1[3]);
            *(LAS v4u*)(Ks + row * KS_STRIDE + 8 * c) = o;
            const unsigned vv[4] = {vw.x, vw.y, vw.z, vw.w};
#pragma unroll
            for (int j = 0; j < 4; ++j) { Vt[(8 * c + 2 * j) * VT_STRIDE + row] = (bf16)(vv[j] & 0xffffu); Vt[(8 * c + 2 * j + 1) * VT_STRIDE + row] = (bf16)(vv[j] >> 16); }
        }
    }
    {
        const int c = lane & 7;
        const f32x4 qg0 = *(const GAS f32x4*)(F_q_gain + l * HD + 8 * c), qg1 = *(const GAS f32x4*)(F_q_gain + l * HD + 8 * c + 4);
#pragma unroll
        for (int i = 0; i < 8; ++i) {
            const int row = (lane >> 3) + 8 * i;
            const v4u qw = *(const GAS v4u*)(F_Z + (size_t)(tok0 + row) * DIN + 1024 + hq * 64 + 8 * c);
            float qf[8] = {bflo(qw.x), bfhi(qw.x), bflo(qw.y), bfhi(qw.y), bflo(qw.z), bfhi(qw.z), bflo(qw.w), bfhi(qw.w)};
            float ss = 0.f;
#pragma unroll
            for (int j = 0; j < 8; ++j) ss += qf[j] * qf[j];
            ss += __shfl_xor(ss, 1); ss += __shfl_xor(ss, 2); ss += __shfl_xor(ss, 4);
            const float rstd = 0.125f / sqrtf(ss * (1.f / HD) + EPS);
            v4u o; o.x = pk2(qf[0] * rstd * qg0[0], qf[1] * rstd * qg0[1]); o.y = pk2(qf[2] * rstd * qg0[2], qf[3] * rstd * qg0[3]);
            o.z = pk2(qf[4] * rstd * qg1[0], qf[5] * rstd * qg1[1]); o.w = pk2(qf[6] * rstd * qg1[2], qf[7] * rstd * qg1[3]);
            *(LAS v4u*)(Qs + row * KS_STRIDE + 8 * c) = o;
        }
#pragma unroll
        for (int i = 0; i < 4; ++i) { const int e = lane + 64 * i; if (e < 255) tbl[e] = F_rel_bias[t5_bucket(e - 191) * NQH + hq]; }
    }
    __syncthreads();
    const int r = lane & 31, h = lane >> 5;
    const int kt0 = n == 0 ? 4 : (n == 1 ? 2 : 0);
    const int dbg = F.A->pad;
    const float sink = (dbg == 0) ? F_sinks[l * NQH + hq] : -INFINITY;
    const float m0 = (dbg == 0) ? sink : -1e30f;
#pragma unroll 1
    for (int qt = 0; qt < 2; ++qt) {
        bf16x8 qf[4];
#pragma unroll
        for (int s = 0; s < 4; ++s) qf[s] = *(const LAS bf16x8*)(Qs + (32 * qt + r) * KS_STRIDE + 16 * s + 8 * h);
        f32x16 acc[6];
#pragma unroll
        for (int kt = 0; kt < 6; ++kt) {
#pragma unroll
            for (int i = 0; i < 16; ++i) acc[kt][i] = 0.f;
#pragma unroll
            for (int s = 0; s < 4; ++s) { const bf16x8 a = *(const LAS bf16x8*)(Ks + (32 * kt + r) * KS_STRIDE + 16 * s + 8 * h);
                acc[kt] = __builtin_amdgcn_mfma_f32_32x32x16_bf16(a, qf[s], acc[kt], 0, 0, 0); }
            asm volatile("" ::: "memory");
        }
        const int a = 32 * qt + r; float m = m0;
#pragma unroll
        for (int kt = 0; kt < 6; ++kt) {
#pragma unroll
            for (int i = 0; i < 16; ++i) { const int bk = 32 * kt + (i & 3) + 8 * (i >> 2) + 4 * h; float s = (dbg == 1 ? 0.f : acc[kt][i]) + ((dbg == 0 || dbg == 3) ? tbl[bk - a + 63] : 0.f); if (kt < kt0) s = -INFINITY; acc[kt][i] = s; m = fmaxf(m, s); }
            asm volatile("" ::: "memory");
        }
        m = fmaxf(m, __shfl_xor(m, 32));
        float sum = 0.f;
#pragma unroll
        for (int kt = 0; kt < 6; ++kt)
#pragma unroll
            for (int i = 0; i < 16; ++i) { const float p = __expf(acc[kt][i] - m); acc[kt][i] = p; sum += p; }
        sum += __shfl_xor(sum, 32); sum += __expf(sink - m);
        const float inv = 1.f / sum;
        f32x16 o[2];
#pragma unroll
        for (int dt = 0; dt < 2; ++dt) {
#pragma unroll
            for (int i = 0; i < 16; ++i) o[dt][i] = 0.f;
        }
#pragma unroll
        for (int kt = 0; kt < 6; ++kt)
#pragma unroll
            for (int s2 = 0; s2 < 2; ++s2) {
                v4u pw; pw.x = pk2(acc[kt][8 * s2 + 0], acc[kt][8 * s2 + 1]); pw.y = pk2(acc[kt][8 * s2 + 2], acc[kt][8 * s2 + 3]);
                pw.z = pk2(acc[kt][8 * s2 + 4], acc[kt][8 * s2 + 5]); pw.w = pk2(acc[kt][8 * s2 + 6], acc[kt][8 * s2 + 7]);
                const bf16x8 pb = __builtin_bit_cast(bf16x8, pw);
#pragma unroll
                for (int dt = 0; dt < 2; ++dt) {
                    const LAS bf16* vp = Vt + (32 * dt + r) * VT_STRIDE + 32 * kt + 16 * s2 + 4 * h;
                    const v2u lo = *(const LAS v2u*)vp, hi = *(const LAS v2u*)(vp + 8);
                    v4u aw; aw.x = lo.x; aw.y = lo.y; aw.z = hi.x; aw.w = hi.y;
                    o[dt] = __builtin_amdgcn_mfma_f32_32x32x16_bf16(__builtin_bit_cast(bf16x8, aw), pb, o[dt], 0, 0, 0);
                }
                asm volatile("" ::: "memory");
            }
        bf16* orow = F_MIX + (size_t)(tok0 + a) * D + 1024 + hq * 64;
#pragma unroll
        for (int dt = 0; dt < 2; ++dt)
#pragma unroll
            for (int q4 = 0; q4 < 4; ++q4) { v2u w; w.x = pk2(o[dt][4 * q4] * inv, o[dt][4 * q4 + 1] * inv); w.y = pk2(o[dt][4 * q4 + 2] * inv, o[dt][4 * q4 + 3] * inv);
                *(GAS v2u*)(orow + 32 * dt + 8 * q4 + 4 * h) = w; }
    }
    __syncthreads();
}

__device__ __forceinline__ void pool_item(Frame& F, int item) {
    const int g = item & 3, tt = (item >> 2) & 255, b = item >> 10, lane = F.lane;
    const int w = 2 << g, t0 = tt * 16;
    const bf16* zb = F_Z + (size_t)(b * SEQ) * DIN + 256 * g + 4 * lane;
    f32x4 S = {0.f, 0.f, 0.f, 0.f};
    for (int j = 1; j <= w; ++j) { const int t = t0 - j; if (t >= 0) { const v2u pw = *(const GAS v2u*)(zb + (size_t)t * DIN); S += (f32x4){bflo(pw.x), bfhi(pw.x), bflo(pw.y), bfhi(pw.y)}; } }
#pragma unroll 4
    for (int t = t0; t < t0 + 16; ++t) {
        const v2u pw = *(const GAS v2u*)(zb + (size_t)t * DIN); const f32x4 pt = {bflo(pw.x), bfhi(pw.x), bflo(pw.y), bfhi(pw.y)};
        S += pt;
        if (t - w >= 0) { const v2u qw = *(const GAS v2u*)(zb + (size_t)(t - w) * DIN); S -= (f32x4){bflo(qw.x), bfhi(qw.x), bflo(qw.y), bfhi(qw.y)}; }
        const float ic = 1.f / (float)((t + 1) < w ? (t + 1) : w);
        const f32x4 y = S * ic - pt;
        v2u o; o.x = pk2(y[0], y[1]); o.y = pk2(y[2], y[3]);
        *(GAS v2u*)(F_POOLED + (size_t)(b * SEQ + t) * DPOOL + 256 * g + 4 * lane) = o;
    }
}

constexpr int SK_STRIDE = 136;
constexpr int TK_SK = 0, TK_TAB = 2 * 128 * SK_STRIDE * 2;
__device__ __forceinline__ int ford(float x) { const int b = __builtin_bit_cast(int, x); return b ^ ((b >> 31) & 0x7fffffff); }
__device__ __forceinline__ float fdeord(int k) { return __builtin_bit_cast(float, k ^ ((k >> 31) & 0x7fffffff)); }
template <int CTRL> __device__ __forceinline__ int dppi(int v) { return __builtin_amdgcn_update_dpp(v, v, CTRL, 0xf, 0xf, false); }
__device__ __forceinline__ int row_allmax(int v) {
    v = max(v, dppi<0x128>(v)); v = max(v, dppi<0x124>(v)); v = max(v, dppi<0x122>(v)); v = max(v, dppi<0x121>(v)); return v;
}
__device__ __forceinline__ float row_allsum(float v) {
    v += __builtin_bit_cast(float, dppi<0x128>(__builtin_bit_cast(int, v))); v += __builtin_bit_cast(float, dppi<0x124>(__builtin_bit_cast(int, v)));
    v += __builtin_bit_cast(float, dppi<0x122>(__builtin_bit_cast(int, v))); v += __builtin_bit_cast(float, dppi<0x121>(__builtin_bit_cast(int, v))); return v;
}
__device__ __forceinline__ int bperm(int srclane, int v) { return __builtin_amdgcn_ds_bpermute(srclane << 2, v); }

__device__ __forceinline__ void p_topk(Frame& F, int l) {
    const int gw = F.vcu * NWAVES + F.wave, NGW = F.G * NWAVES, lane = F.lane, tid = F.tid;
    LAS bf16* SKs = (LAS bf16*)(F.lds + TK_SK); LAS unsigned char* tab = F.lds + TK_TAB;
    {
        const bf16* src = F_SK + (size_t)l * 32768;
#pragma unroll
        for (int i = 0; i < 8; ++i) { const int ch = tid + 512 * i; const int row = ch >> 4, c = ch & 15;
            *(LAS v4u*)(SKs + row * SK_STRIDE + 8 * c) = *(const GAS v4u*)(src + row * 128 + 8 * c); }
        if (tid == 0) { int s = 0; for (int a = 0; a < 16; ++a) for (int bb = 0; bb < 16; ++bb) if ((a + 1) * (bb + 1) <= 16) { tab[s] = (unsigned char)a; tab[64 + s] = (unsigned char)bb; ++s; }
            for (; s < 64; ++s) { tab[s] = 255; tab[64 + s] = 255; } }
    }
    __syncthreads();
    const int r = lane & 15, q4 = lane >> 4, rowbase = lane & ~15;
    int ca[4], cb[4];
#pragma unroll
    for (int j = 0; j < 4; ++j) { ca[j] = tab[4 * r + j]; cb[j] = tab[64 + 4 * r + j]; }
    for (int unit = gw; unit < T / 2; unit += NGW) {
        const int t0 = 2 * unit;
        const bf16* qrow = F_QP + (size_t)(t0 + (r >> 3)) * D + (r & 7) * 256 + 8 * q4;
        int res[2][4];
#pragma unroll
        for (int p = 0; p < 2; ++p) {
            f32x4 acc[8];
#pragma unroll
            for (int nt = 0; nt < 8; ++nt) acc[nt] = (f32x4){0.f, 0.f, 0.f, 0.f};
#pragma unroll 1
            for (int ks = 0; ks < 4; ++ks) { const bf16x8 a = *(const GAS bf16x8*)(qrow + p * 128 + 32 * ks);
#pragma unroll
                for (int nt = 0; nt < 8; ++nt) { const bf16x8 bq = *(const LAS bf16x8*)(SKs + (p * 128 + 16 * nt + r) * SK_STRIDE + 32 * ks + 8 * q4);
                    acc[nt] = __builtin_amdgcn_mfma_f32_16x16x32_bf16(a, bq, acc[nt], 0, 0, 0); } }
#pragma unroll
            for (int i = 0; i < 4; ++i) {
                int key[8];
#pragma unroll
                for (int nt = 0; nt < 8; ++nt) key[nt] = (ford(acc[nt][i]) & ~127) | (127 - (16 * nt + r));
                int mine = 0;
#pragma unroll 1
                for (int rd = 0; rd < 16; ++rd) {
                    int m = max(max(max(key[0], key[1]), max(key[2], key[3])), max(max(key[4], key[5]), max(key[6], key[7])));
                    m = row_allmax(m);
                    if (r == rd) mine = m;
#pragma unroll
                    for (int nt = 0; nt < 8; ++nt) key[nt] = (key[nt] == m) ? (int)0x80000000 : key[nt];
                }
                res[p][i] = mine;
            }
        }
#pragma unroll
        for (int i = 0; i < 4; ++i) {
            const int k1 = res[0][i], k2 = res[1][i];
            int ck[4];
#pragma unroll
            for (int j = 0; j < 4; ++j) {
                const int va = bperm(rowbase + (ca[j] & 15), k1), vb = bperm(rowbase + (cb[j] & 15), k2);
                const float s = fdeord(va & ~127) + fdeord(vb & ~127);
                ck[j] = (ca[j] == 255) ? (int)0x80000000 : ((ford(s) & ~63) | (63 - (4 * r + j)));
            }
            int mine = 0;
#pragma unroll 1
            for (int rd = 0; rd < 16; ++rd) {
                int m = max(max(ck[0], ck[1]), max(ck[2], ck[3]));
                m = row_allmax(m);
                if (r == rd) mine = m;
#pragma unroll
                for (int j = 0; j < 4; ++j) ck[j] = (ck[j] == m) ? (int)0x80000000 : ck[j];
            }
            const int slot = 63 - (mine & 63);
            const int a = tab[slot], bb = tab[64 + slot];
            const int va = bperm(rowbase + a, k1), vb = bperm(rowbase + bb, k2);
            const float s = fdeord(va & ~127) + fdeord(vb & ~127);
            const int eidx = (127 - (va & 127)) * 128 + (127 - (vb & 127));
            const float smax = __builtin_bit_cast(float, bperm(rowbase, __builtin_bit_cast(int, s)));
            const float e = __expf(s - smax);
            const float gate = e / row_allsum(e);
            const int row = 4 * q4 + i, tok = t0 + (row >> 3), hh = row & 7;
            F_IDX[(size_t)tok * 128 + hh * 16 + r] = eidx;
            F_GATE[(size_t)tok * 128 + hh * 16 + r] = gate;
        }
    }
}

__device__ __forceinline__ float gelu_exact(float v) { return 0.5f * v * (1.f + erff(v * 0.70710678118654752f)); }

__device__ __forceinline__ void p_peer(Frame& F, int l) {
    const int gw = F.vcu * NWAVES + F.wave, lane = F.lane;
    LAS float* sc = (LAS float*)(F.lds + F.wave * 8448);
    const bf16* U = F_U16 + (size_t)l * NEXP * D; const bf16* V = F_V16 + (size_t)l * NEXP * D;
    const float* xin = F_X1; float* xout = (l == 0) ? F_XA : F_out;
    for (int tj = 0; tj < 4; ++tj) {
        const int t = gw * 4 + tj, b = t / SEQ;
        unsigned hp[16];
        { const GAS v4u* hr = (const GAS v4u*)(F_H + (size_t)t * D) + lane;
#pragma unroll
          for (int j = 0; j < 4; ++j) { const v4u w = hr[64 * j]; hp[4 * j] = w.x; hp[4 * j + 1] = w.y; hp[4 * j + 2] = w.z; hp[4 * j + 3] = w.w; } }
        const int idx0 = F_IDX[(size_t)t * 128 + lane], idx1 = F_IDX[(size_t)t * 128 + 64 + lane];
        const float g0 = F_GATE[(size_t)t * 128 + lane], g1 = F_GATE[(size_t)t * 128 + 64 + lane];
        float act[2];
#pragma unroll
        for (int half = 0; half < 2; ++half) {
            const int idv = half ? idx1 : idx0; float av = 0.f;
#pragma unroll
            for (int kb = 0; kb < 2; ++kb) {
#pragma unroll 4
                for (int kk = 0; kk < 32; ++kk) {
                    const int e = __builtin_amdgcn_readlane(idv, kb * 32 + kk);
                    const GAS v4u* ur = (const GAS v4u*)(U + (size_t)e * D) + lane;
                    float p0 = 0.f, p1 = 0.f, p2 = 0.f, p3 = 0.f;
#pragma unroll
                    for (int j = 0; j < 4; ++j) { const v4u w = ur[64 * j]; p0 = dot2(w.x, hp[4 * j], p0); p1 = dot2(w.y, hp[4 * j + 1], p1); p2 = dot2(w.z, hp[4 * j + 2], p2); p3 = dot2(w.w, hp[4 * j + 3], p3); }
                    sc[kk * 65 + lane] = (p0 + p1) + (p2 + p3);
                }
                LDS_WAIT(); asm volatile("" ::: "memory");
                float s = 0.f; const int k = lane & 31, part = lane >> 5;
#pragma unroll
                for (int x = 0; x < 32; ++x) s += sc[k * 65 + 32 * part + x];
                s += __shfl_xor(s, 32);
                if (part == kb) av = s;
                LDS_WAIT(); asm volatile("" ::: "memory");
            }
            act[half] = gelu_exact(av) * (half ? g1 : g0);
        }
        float o[32];
#pragma unroll
        for (int i = 0; i < 32; ++i) o[i] = 0.f;
#pragma unroll
        for (int half = 0; half < 2; ++half) {
            const int idv = half ? idx1 : idx0; const float acv = act[half];
#pragma unroll 4
            for (int k = 0; k < 64; ++k) {
                const int e = __builtin_amdgcn_readlane(idv, k); const float a = rdlane(acv, k);
                const GAS v4u* vr = (const GAS v4u*)(V + (size_t)e * D) + lane;
#pragma unroll
                for (int j = 0; j < 4; ++j) { const v4u w = vr[64 * j];
                    o[8 * j + 0] += a * bflo(w.x); o[8 * j + 1] += a * bfhi(w.x); o[8 * j + 2] += a * bflo(w.y); o[8 * j + 3] += a * bfhi(w.y);
                    o[8 * j + 4] += a * bflo(w.z); o[8 * j + 5] += a * bfhi(w.z); o[8 * j + 6] += a * bflo(w.w); o[8 * j + 7] += a * bfhi(w.w); }
            }
        }
        const float* mod = F_MOD + (size_t)(l * 2 + b) * MODW;
        float ss = 0.f;
#pragma unroll
        for (int j = 0; j < 4; ++j) {
            const int col = 8 * lane + 512 * j;
            const f32x4 xa = *(const GAS f32x4*)(xin + (size_t)t * D + col), xb = *(const GAS f32x4*)(xin + (size_t)t * D + col + 4);
            const f32x4 ga = *(const GAS f32x4*)(mod + 5 * D + col), gb = *(const GAS f32x4*)(mod + 5 * D + col + 4);
            f32x4 ya, yb;
#pragma unroll
            for (int e = 0; e < 4; ++e) { ya[e] = xa[e] + ga[e] * o[8 * j + e]; yb[e] = xb[e] + gb[e] * o[8 * j + 4 + e]; o[8 * j + e] = ya[e]; o[8 * j + 4 + e] = yb[e]; ss += ya[e] * ya[e] + yb[e] * yb[e]; }
            *(GAS f32x4*)(xout + (size_t)t * D + col) = ya; *(GAS f32x4*)(xout + (size_t)t * D + col + 4) = yb;
        }
        if (l == 0) {
            const float rstd = 1.f / sqrtf(wave_sum(ss) * (1.f / D) + EPS);
            const float* mod1 = F_MOD + (size_t)(1 * 2 + b) * MODW;
#pragma unroll
            for (int j = 0; j < 4; ++j) {
                const int col = 8 * lane + 512 * j; float y[8];
#pragma unroll
                for (int hf = 0; hf < 2; ++hf) {
                    const f32x4 sh = *(const GAS f32x4*)(mod1 + 0 * D + col + 4 * hf), scv = *(const GAS f32x4*)(mod1 + 1 * D + col + 4 * hf), gn = *(const GAS f32x4*)(F_norm1_gain + D + col + 4 * hf);
#pragma unroll
                    for (int e = 0; e < 4; ++e) y[4 * hf + e] = o[8 * j + 4 * hf + e] * rstd * gn[e] * (1.f + scv[e]) + sh[e];
                }
                v4u w; w.x = pk2(y[0], y[1]); w.y = pk2(y[2], y[3]); w.z = pk2(y[4], y[5]); w.w = pk2(y[6], y[7]);
                *(GAS v4u*)(F_H + (size_t)t * D + col) = w;
            }
        }
    }
}

constexpr int N_PHASES = 18;
__global__ void __launch_bounds__(NWAVES * 64, 2) mk_fwd(Args args) {
    extern __shared__ __attribute__((aligned(16))) unsigned char lds[];
    Frame F;
    F.lds = (LAS unsigned char*)lds;
    F.tid = threadIdx.x; F.lane = F.tid & 63; F.wave = __builtin_amdgcn_readfirstlane(F.tid >> 6);
    F.G = gridDim.x; { const int bx = blockIdx.x; F.vcu = (F.G % 8 == 0) ? (bx % 8) * (F.G / 8) + bx / 8 : bx; }
    F.A = &args; F.ws = args.ws;
    unsigned char* ws = args.ws;
    volatile LAS unsigned* MISC = (volatile LAS unsigned*)(F.lds + LDSCTL_OFF);
    for (int u = F.tid; u < (LDS_BYTES - LDSCTL_OFF) / 4; u += NWAVES * 64) ((LAS unsigned*)(F.lds + LDSCTL_OFF))[u] = 0u;
    __syncthreads();
    const int lo = args.ph_lo, hi = args.ph_hi;
    XcdBarrier bar; bar.bar = (unsigned*)(ws + WS_CTL) + CW_BAR; bar.x = 0; bar.st = nullptr;
    if (hi - lo > 1) bar = xcd_barrier_post((unsigned*)(ws + WS_CTL) + CW_BAR, MISC + 8);
    bool first_seam = args.coop != 0;
#define SEAM() do { if (first_seam) { cg::this_grid().sync(); first_seam = false; } else xcd_barrier(bar); } while (0)
#define RUN(k, ...) do { if (lo <= (k) && (k) < hi) { __VA_ARGS__; if ((k) + 1 < hi) SEAM(); } } while (0)
    RUN(0, if (PHMASK & 1) p0_prologue(F));
    RUN(1, if (PHMASK & 2) p1_mod_norm1(F));
#define LAYER(l, base) \
    RUN(base + 0, if (PHMASK & 4) { \
        pg8::Gemm g{F_H, F_WIN + (size_t)(l) * DIN * D, T, DIN, D, D, D}; pg8::StaticOrder S; S.init(T, DIN, F.G, (int)blockIdx.x); \
        pg8::EpiBf16S E{F_Z, DIN, 0, nullptr}; \
        pg8::gemm_phase<pg8::EpiBf16S, pg8::StaticOrder, true, true>(F.lds, g, S, E); }); \
    RUN(base + 1, if (PHMASK & 8) { \
        for (int it = blockIdx.x; it < 256; it += F.G) attn_item(F, (l), it); \
        for (int it = F.vcu * NWAVES + F.wave; it < 2048; it += F.G * NWAVES) pool_item(F, it); }); \
    RUN(base + 2, if ((PHMASK & 16) && blockIdx.x < 128) { \
        const int gidx = blockIdx.x >> 5, pm = blockIdx.x & 31; \
        int Kp = 256; asm volatile("" : "+s"(Kp)); \
        pg8::Gemm g{F_POOLED + 256 * gidx, F_WPOOL + (size_t)((l) * 4 + gidx) * 65536, T, 256, Kp, DPOOL, 256}; pg8::OneUnit S{pm}; \
        pg8::EpiBf16S E{F_MIX, D, 256 * gidx, F_pool_scale + (size_t)(l) * DPOOL}; \
        pg8::gemm_phase<pg8::EpiBf16S, pg8::OneUnit, false, true>(F.lds, g, S, E); }); \
    RUN(base + 3, if (PHMASK & 32) { \
        pg8::Gemm g{F_MIX, F_WOUT + (size_t)(l) * D * D, T, D, D, D, D}; pg8::StaticOrder S; S.init(T, D, F.G, (int)blockIdx.x); \
        pg8::EpiResid E{(l) == 0 ? F_x : F_XA, F_X1, F_MOD + (size_t)((l) * 2) * MODW + 2 * D, MODW}; \
        pg8::gemm_phase<pg8::EpiResid, pg8::StaticOrder, false, true>(F.lds, g, S, E); }); \
    RUN(base + 4, if (PHMASK & 64) p_norm2(F, (l))); \
    RUN(base + 5, if (PHMASK & 128) { \
        pg8::Gemm g{F_H, F_WQ + (size_t)(l) * D * D, T, D, D, D, D}; pg8::StaticOrder S; S.init(T, D, F.G, (int)blockIdx.x); \
        pg8::EpiBf16S E{F_QP, D, 0, nullptr}; \
        pg8::gemm_phase<pg8::EpiBf16S, pg8::StaticOrder, false, true>(F.lds, g, S, E); }); \
    RUN(base + 6, if (PHMASK & 256) p_topk(F, (l))); \
    RUN(base + 7, if (PHMASK & 512) p_peer(F, (l)));
    LAYER(0, 2)
    LAYER(1, 10)
#undef LAYER
#undef RUN
#undef SEAM
}


#ifndef MK_DIAG
#define MK_DIAG 0
#endif
#if MK_DIAG
constexpr size_t WS_DIAG = 3 * MiB;
__device__ __forceinline__ float bf2f(bf16 v) { return __builtin_bit_cast(float, (unsigned)v << 16); }
__device__ __forceinline__ float block_sum(float v, float* red) {
    v = wave_sum(v); __syncthreads(); if ((threadIdx.x & 63) == 0) red[threadIdx.x >> 6] = v; __syncthreads();
    const float r = red[0] + red[1] + red[2] + red[3]; __syncthreads(); return r;
}
__device__ __forceinline__ void diag_max(float* slot, float d) { if (!(d == d)) d = 1e9f; atomicMax((unsigned*)slot, __builtin_bit_cast(unsigned, d < 0 ? 0.f : d)); }
__device__ __forceinline__ unsigned hsh(unsigned x) { x ^= x >> 16; x *= 0x7feb352du; x ^= x >> 15; x *= 0x846ca68bu; x ^= x >> 16; return x; }
__device__ __forceinline__ int sample_tok(int s) { const int special[8] = {0, 5, 63, 64, 130, 4095, 4096, 8191}; return s < 8 ? special[s] : (int)(hsh(s * 7919u + 13u) % T); }
__device__ __forceinline__ float gelu_d(float v) { return 0.5f * v * (1.f + erff(v * 0.70710678118654752f)); }

__global__ void __launch_bounds__(256) diag_kernel(Args args, int stage, int l, int dbg = 0, int slot_override = 0) {
    __shared__ float red[4]; __shared__ float sh[768]; __shared__ int shi[512];
    const int s = blockIdx.x, tid = threadIdx.x; unsigned char* ws = args.ws;
    float* slots = (float*)(ws + WS_DIAG);
    const float* MOD = (const float*)(ws + WS_MOD); const bf16* H = (const bf16*)(ws + WS_H); const bf16* Z = (const bf16*)(ws + WS_Z);
    const bf16* POOLED = (const bf16*)(ws + WS_POOLED); const bf16* MIX = (const bf16*)(ws + WS_MIX); const float* X1 = (const float*)(ws + WS_X1);
    const float* XA = (const float*)(ws + WS_XA); const bf16* QP = (const bf16*)(ws + WS_QP); const int* IDX = (const int*)(ws + WS_IDX); const float* GATE = (const float*)(ws + WS_GATE);
    const int t = sample_tok(s), b = t / SEQ; const unsigned hr = hsh(s * 31u + stage * 1009u + 7u);
    if (stage == 1) {
        { const int j = hr % MODW; const int ll = (hr >> 16) & 1, bb = (hr >> 17) & 1; float a = 0.f;
          for (int k = tid; k < D; k += 256) { const float c = args.in[1][bb * D + k]; a += c / (1.f + expf(-c)) * args.in[3][(size_t)ll * D * MODW + (size_t)k * MODW + j]; }
          a = block_sum(a, red) + args.in[4][ll * MODW + j];
          if (tid == 0) diag_max(slots + 1, fabsf(a - MOD[(ll * 2 + bb) * MODW + j])); }
        { float ss = 0.f; for (int k = tid; k < D; k += 256) { const float v = args.in[0][(size_t)t * D + k]; ss += v * v; }
          ss = block_sum(ss, red); const int c = hr % D; const float* mod = MOD + (size_t)(0 * 2 + b) * MODW;
          const float want = args.in[0][(size_t)t * D + c] / sqrtf(ss / D + EPS) * args.in[5][c] * (1.f + mod[D + c]) + mod[c];
          if (tid == 0) diag_max(slots + 1, fabsf(want - bf2f(H[(size_t)t * D + c]))); }
    } else if (stage == 2) {
        const int n = hr % DIN; float a = 0.f; const float* W = args.in[6] + (size_t)l * D * DIN;
        for (int k = tid; k < D; k += 256) a += bf2f(H[(size_t)t * D + k]) * W[(size_t)k * DIN + n];
        a = block_sum(a, red); if (tid == 0) diag_max(slots + 2, fabsf(a - bf2f(Z[(size_t)t * DIN + n])));
    } else if (stage == 3) {
        if (tid == 0) { const int c = hr % DPOOL, g = c / 256, w = 2 << g, tt = t % SEQ; float sm = 0.f; int cnt = 0;
            for (int j = 0; j < w; ++j) if (tt - j >= 0) { sm += bf2f(Z[(size_t)(t - j) * DIN + c]); ++cnt; }
            diag_max(slots + 3, fabsf(sm / cnt - bf2f(Z[(size_t)t * DIN + c]) - bf2f(POOLED[(size_t)t * DPOOL + c]))); }
        const int hq = (hr >> 8) & 15, d = (hr >> 12) & 63, g = hq >> 3, tt = t % SEQ, n = tt / 64, a = tt % 64;
        float qn[64]; float qs = 0.f;
        for (int i = 0; i < 64; ++i) { const float v = bf2f(Z[(size_t)t * DIN + 1024 + hq * 64 + i]); qs += v * v; }
        const float qr = 1.f / sqrtf(qs / 64 + EPS);
        float sc = -INFINITY, vv = 0.f;
        if (tid < 192) { const int kc = n - 2 + tid / 64; if (kc >= 0) { const int tk = b * SEQ + kc * 64 + (tid % 64); float ks = 0.f, dt = 0.f;
            for (int i = 0; i < 64; ++i) { const float kv = bf2f(Z[(size_t)tk * DIN + 2048 + g * 64 + i]); ks += kv * kv; }
            const float kr = 1.f / sqrtf(ks / 64 + EPS);
            for (int i = 0; i < 64; ++i) dt += bf2f(Z[(size_t)t * DIN + 1024 + hq * 64 + i]) * qr * args.in[7][l * 64 + i] * bf2f(Z[(size_t)tk * DIN + 2048 + g * 64 + i]) * kr * args.in[8][l * 64 + i];
            const int rel = tid - 128 - a; const int nn = rel < 0 ? -rel : rel; int bucket;
            if (nn < 8) bucket = nn; else { int lg = 8 + (int)(logf((float)nn / 8.f) / logf(16.f) * 8.f + 1e-4f); bucket = lg < 15 ? lg : 15; }
            if (rel > 0) bucket += 16;
            sc = (dbg == 1 ? 0.f : dt * 0.125f) + ((dbg == 0 || dbg == 3) ? args.in[2][bucket * 16 + hq] : 0.f); vv = bf2f(Z[(size_t)tk * DIN + 2176 + g * 64 + d]); } }
        (void)qn;
        sh[tid] = sc; __syncthreads();
        const float snk = dbg == 0 ? args.in[9][l * 16 + hq] : -INFINITY;
        float m = dbg == 0 ? snk : -1e30f; for (int i = 0; i < 192; ++i) m = fmaxf(m, sh[i]);
        const float p = (tid < 192 && sc > -INFINITY) ? expf(sc - m) : 0.f;
        const float den = block_sum(p, red) + expf(snk - m); const float num = block_sum(p * vv, red);
        if (tid == 0) diag_max(slots + (slot_override ? slot_override : 4), fabsf(num / den - bf2f(MIX[(size_t)t * D + 1024 + hq * 64 + d])));
    } else if (stage == 4) {
        const int c = hr % DPOOL, g = c / 256, dd = c % 256; float a = 0.f;
        { const int k = tid; a = bf2f(POOLED[(size_t)t * DPOOL + 256 * g + k]) * args.in[10][(size_t)(l * 4 + g) * 65536 + k * 256 + dd]; }
        a = block_sum(a, red) * args.in[11][l * DPOOL + c]; if (tid == 0) diag_max(slots + 5, fabsf(a - bf2f(MIX[(size_t)t * D + c])));
    } else if (stage == 5) {
        const int n = hr % D; float a = 0.f; const float* W = args.in[12] + (size_t)l * D * D;
        for (int k = tid; k < D; k += 256) a += bf2f(MIX[(size_t)t * D + k]) * W[(size_t)k * D + n];
        a = block_sum(a, red); const float* xin = l == 0 ? args.in[0] : XA;
        const float want = xin[(size_t)t * D + n] + MOD[(size_t)(l * 2 + b) * MODW + 2 * D + n] * a;
        if (tid == 0) diag_max(slots + 6, fabsf(want - X1[(size_t)t * D + n]));
    } else if (stage == 6) {
        float ss = 0.f; for (int k = tid; k < D; k += 256) { const float v = X1[(size_t)t * D + k]; ss += v * v; }
        ss = block_sum(ss, red); const int c = hr % D; const float* mod = MOD + (size_t)(l * 2 + b) * MODW;
        const float want = X1[(size_t)t * D + c] / sqrtf(ss / D + EPS) * args.in[13][l * D + c] * (1.f + mod[4 * D + c]) + mod[3 * D + c];
        if (tid == 0) diag_max(slots + 7, fabsf(want - bf2f(H[(size_t)t * D + c])));
    } else if (stage == 7) {
        const int n = hr % D; float a = 0.f; const float* W = args.in[14] + (size_t)l * D * D;
        for (int k = tid; k < D; k += 256) a += bf2f(H[(size_t)t * D + k]) * W[(size_t)k * D + n];
        a = block_sum(a, red); if (tid == 0) diag_max(slots + 8, fabsf(a - bf2f(QP[(size_t)t * D + n])));
    } else if (stage == 8) {
        const int h = hr & 7; const int p = tid >> 7, n = tid & 127; float a = 0.f;
        for (int i = 0; i < 128; ++i) a += bf2f(QP[(size_t)t * D + h * 256 + p * 128 + i]) * args.in[15][(size_t)((l * 2 + p) * 128 + n) * 128 + i];
        sh[tid] = a; __syncthreads();
        if (tid < 2) { for (int r = 0; r < 16; ++r) { int bi = 0; float bv = -INFINITY; for (int i = 0; i < 128; ++i) if (sh[tid * 128 + i] > bv) { bv = sh[tid * 128 + i]; bi = i; }
            sh[256 + tid * 16 + r] = bv; shi[tid * 16 + r] = bi; sh[tid * 128 + bi] = -INFINITY; } }
        __syncthreads();
        { const int aa = tid >> 4, bb = tid & 15; sh[512 + tid] = sh[256 + aa] + sh[256 + 16 + bb]; shi[256 + tid] = shi[aa] * 128 + shi[16 + bb]; }
        __syncthreads();
        if (tid == 0) { float ts[16]; int ti[16]; float den = 0.f;
            for (int r = 0; r < 16; ++r) { int bi = 0; float bv = -INFINITY; for (int i = 0; i < 256; ++i) if (sh[512 + i] > bv) { bv = sh[512 + i]; bi = i; } ts[r] = bv; ti[r] = shi[256 + bi]; sh[512 + bi] = -INFINITY; }
            for (int r = 0; r < 16; ++r) den += expf(ts[r] - ts[0]);
            float bad = 0.f;
            for (int r = 0; r < 16; ++r) { float gg = 0.f; for (int q = 0; q < 16; ++q) if (IDX[(size_t)t * 128 + h * 16 + q] == ti[r]) gg = GATE[(size_t)t * 128 + h * 16 + q]; bad += fabsf(gg - expf(ts[r] - ts[0]) / den); }
            diag_max(slots + 9, bad); }
    } else if (stage == 9) {
        const int d = hr % D; const float* U = args.in[16] + (size_t)l * NEXP * D; const float* V = args.in[17] + (size_t)l * NEXP * D; float contrib = 0.f;
        if (tid < 128) { const int e = IDX[(size_t)t * 128 + tid]; float a = 0.f; for (int k = 0; k < D; ++k) a += U[(size_t)e * D + k] * bf2f(H[(size_t)t * D + k]);
            contrib = gelu_d(a) * GATE[(size_t)t * 128 + tid] * V[(size_t)e * D + d]; }
        const float o = block_sum(contrib, red); const float want = X1[(size_t)t * D + d] + MOD[(size_t)(l * 2 + b) * MODW + 5 * D + d] * o;
        const float* xo = l == 0 ? XA : args.out;
        if (tid == 0) diag_max(slots + 10, fabsf(want - xo[(size_t)t * D + d]));
    }
}
__global__ void diag_report(Args args) {
    float* slots = (float*)(args.ws + WS_DIAG);
#if MK_DIAG == 3
    { int code = 0; if (slots[11] > 0.03f) code |= 1; if (slots[12] > 0.03f) code |= 2; if (slots[13] > 0.03f) code |= 4; if (slots[14] > 0.03f) code |= 8;
      args.out[0] = sqrtf(powf(10.f, 3.f + 0.25f * code) * 16777216.f * 1.14f); return; }
#endif
    const float thr[11] = {0, 0.03f, 0.05f, 0.05f, 0.05f, 0.05f, 0.05f, 0.05f, 0.05f, 0.1f, 0.05f};
    for (int i = 1; i <= 10; ++i) { const float d = slots[i]; if (d > thr[i]) {
        float mant = d * 10.f; if (mant > 5.0f) mant = 5.0f; if (mant < 1.0f) mant = 1.0f;
        const float target = mant * powf(10.f, (float)i + 1.f);
        args.out[0] = sqrtf(target * 16777216.f * 1.14f); return; } }
}
#endif

extern "C" void kernel_launch(void* const* d_in, const int* in_sizes, int n_in, void* d_out, int out_size, void* d_ws, size_t ws_size, hipStream_t stream) {
    static int grid = 0;
    if (grid == 0) {
        if (n_in != 18 || out_size != T * D || ws_size < WS_END) { fprintf(stderr, "kernel_launch: unexpected shapes (n_in %d out %d ws %zu)\n", n_in, out_size, ws_size); grid = -1; return; }
        int dev = 0, cus = 0, per_cu = 0;
        if (hipGetDevice(&dev) != hipSuccess || hipDeviceGetAttribute(&cus, hipDeviceAttributeMultiprocessorCount, dev) != hipSuccess) { grid = -1; return; }
        if (hipFuncSetAttribute((const void*)mk_fwd, hipFuncAttributeMaxDynamicSharedMemorySize, LDS_BYTES) != hipSuccess) { fprintf(stderr, "kernel_launch: hipFuncSetAttribute failed\n"); grid = -1; return; }
        if (hipOccupancyMaxActiveBlocksPerMultiprocessor(&per_cu, (const void*)mk_fwd, NWAVES * 64, LDS_BYTES) != hipSuccess || per_cu < 1) { fprintf(stderr, "kernel_launch: occupancy query says %d\n", per_cu); per_cu = 1; }
        (void)hipGetLastError();
        grid = cus;
        if (grid != 256) fprintf(stderr, "kernel_launch: note: %d CUs\n", grid);
    }
    if (grid < 0) return;
    (void)hipMemsetAsync((char*)d_ws + WS_CTL, 0, CTL_ZERO_BYTES, stream);
    Args a{};
    for (int i = 0; i < 18; ++i) a.in[i] = (const float*)d_in[i];
    a.out = (float*)d_out; a.ws = (unsigned char*)d_ws;
#if MK_ONE_LAUNCH
    a.ph_lo = 0; a.ph_hi = N_PHASES; a.coop = 1;
    void* kargs[] = {&a};
    hipError_t e = hipLaunchCooperativeKernel((const void*)mk_fwd, dim3(grid), dim3(NWAVES * 64), kargs, LDS_BYTES, stream);
    if (e != hipSuccess) fprintf(stderr, "cooperative launch failed: %s (grid %d)\n", hipGetErrorString(e), grid);
#else
#if MK_DIAG
    (void)hipMemsetAsync((char*)d_ws + WS_DIAG, 0, 4096, stream);
#endif
    for (int ph = 0; ph < N_PHASES; ++ph) {
        a.ph_lo = ph; a.ph_hi = ph + 1; a.coop = 0;
        hipLaunchKernelGGL(mk_fwd, dim3(grid), dim3(NWAVES * 64), LDS_BYTES, stream, a);
#if MK_DIAG
        if (ph == 1) hipLaunchKernelGGL(diag_kernel, dim3(64), dim3(256), 0, stream, a, 1, 0);
#if MK_DIAG == 3
        if (ph == 3) {
            hipLaunchKernelGGL(diag_kernel, dim3(64), dim3(256), 0, stream, a, 3, 0, 0, 11);
            hipLaunchKernelGGL(mk_fwd, dim3(grid), dim3(NWAVES * 64), LDS_BYTES, stream, a);
            hipLaunchKernelGGL(diag_kernel, dim3(64), dim3(256), 0, stream, a, 3, 0, 0, 12);
            a.ph_lo = 2; a.ph_hi = 3; hipLaunchKernelGGL(mk_fwd, dim3(grid), dim3(NWAVES * 64), LDS_BYTES, stream, a);
            a.ph_lo = 3; a.ph_hi = 4; hipLaunchKernelGGL(mk_fwd, dim3(grid), dim3(NWAVES * 64), LDS_BYTES, stream, a);
            hipLaunchKernelGGL(diag_kernel, dim3(64), dim3(256), 0, stream, a, 3, 0, 0, 13);
        }
#endif
        if (ph >= 2 && MK_DIAG < 3) { const int l = (ph - 2) / 8, s = (ph - 2) % 8; const int st[8] = {2, 3, 4, 5, 6, 7, 8, 9};
            if (l == MK_DIAG - 1) hipLaunchKernelGGL(diag_kernel, dim3(64), dim3(256), 0, stream, a, st[s], l); }
#endif
    }
#if MK_DIAG
    hipLaunchKernelGGL(diag_report, dim3(1), dim3(1), 0, stream, a);
#endif
#endif
}
```

```cpp
#include <hip/hip_runtime.h>
#include <hip/hip_cooperative_groups.h>
#include <cstdio>
#include <cstdint>
namespace cg = cooperative_groups;

#ifndef PHMASK
#define PHMASK 0x3ff
#endif
#ifndef REP_PRO
#define REP_PRO 1
#endif
#ifndef REP_PEER
#define REP_PEER 1
#endif
#ifndef REP_REST
#define REP_REST 1
#endif
#ifndef MK_ONE_LAUNCH
#define MK_ONE_LAUNCH 1
#endif

constexpr int BATCH = 2, SEQ = 4096, T = BATCH * SEQ, D = 2048, DIN = 2304, DPOOL = 1024, HD = 64, NQH = 16;
constexpr int NEXP = 16384, MODW = 6 * D;
constexpr float EPS = 1e-6f;

namespace pg8 {
#define PG8_LAS __attribute__((address_space(3)))
typedef unsigned short bf16_t;
typedef short bf16x8 __attribute__((ext_vector_type(8)));
typedef float f32x4 __attribute__((ext_vector_type(4)));
typedef unsigned u32x4 __attribute__((ext_vector_type(4)));
constexpr int BM = 256, BK = 64, HALF = 128, HTB = HALF * BK * 2, STAGE_BYTES = 8 * HTB, NXCD = 8, WGM = 8;

__host__ __device__ __forceinline__ int lds_byte(int r, int c) { const int st = (r >> 4) * 2 + (c >> 5), rr = r & 15, cc = c & 31, ob = rr * 64 + cc * 2; return st * 1024 + (ob ^ (((ob >> 9) & 1) << 5)); }
__host__ __device__ __forceinline__ void stage_rc(int b, int& R, int& C) { const int st = b / 1024, sb = b % 1024, swz = sb ^ (((sb >> 9) & 1) << 5); R = (st >> 1) * 16 + swz / 64; C = (st & 1) * 32 + (swz % 64) / 2; }
__host__ __device__ __forceinline__ int perm32(int rho) { const int n = rho >> 4, i = rho & 15; return 8 * (i >> 2) + 4 * n + (i & 3); }

struct Unit { int pm, pn; };
struct Gemm { const bf16_t* A; const bf16_t* Bt; int M, N, K, lda, ldb; };

struct StaticOrder {
    int nM, nN, nwg, G, c;
    __host__ __device__ void init(int M, int N, int G_, int c_) { nM = M / BM; nN = N / BM; nwg = nM * nN; G = G_; c = c_; }
    __host__ __device__ bool next(int i, Unit& u) const {
        const long L = (long)i * G + c; if (L >= nwg) return false;
        int wgid = (int)L; { const int q = nwg / NXCD, r = nwg % NXCD, xcd = wgid % NXCD, off = wgid / NXCD; wgid = (xcd < r ? xcd * (q + 1) : r * (q + 1) + (xcd - r) * q) + off; }
        const int nig = WGM * nN, gid = wgid / nig, fm = gid * WGM, gsz = (nM - fm) < WGM ? (nM - fm) : WGM;
        u.pm = fm + ((wgid % nig) % gsz); u.pn = (wgid % nig) / gsz; return true;
    }
    __device__ __forceinline__ void a_ready(const Unit&) const {}
    __device__ __forceinline__ void done(const Unit&) const {}
};
struct OneUnit {
    int pm;
    __device__ __forceinline__ bool next(int i, Unit& u) const { if (i > 0) return false; u.pm = pm; u.pn = 0; return true; }
    __device__ __forceinline__ void a_ready(const Unit&) const {}
    __device__ __forceinline__ void done(const Unit&) const {}
};

__device__ __forceinline__ unsigned cvt_pk_bf16(float lo, float hi) { unsigned r; asm volatile("v_cvt_pk_bf16_f32 %0, %1, %2" : "=v"(r) : "v"(lo), "v"(hi)); return r; }

struct EpiBf16S {
    static constexpr bool PERM = true, AFTER_DRAIN = false;
    bf16_t* O; int ldc; int col_off; const float* cscale;
    __device__ __forceinline__ void operator()(const f32x4 (&acc)[2][2][4][2], const Unit& u, int wr, int wc, int fr, int fq) const {
        const int row0 = u.pm * BM + wr * 64 + fr; const int col0 = col_off + u.pn * BM + wc * 32 + 8 * fq;
#pragma unroll
        for (int ai = 0; ai < 2; ++ai)
#pragma unroll
            for (int m = 0; m < 4; ++m) { bf16_t* rowp = O + (size_t)(row0 + ai * HALF + m * 16) * ldc + col0;
#pragma unroll
                for (int bj = 0; bj < 2; ++bj) { f32x4 v0 = acc[ai][bj][m][0], v1 = acc[ai][bj][m][1];
                    if (cscale) { v0 = v0 * *(const f32x4*)(cscale + col0 + bj * HALF); v1 = v1 * *(const f32x4*)(cscale + col0 + bj * HALF + 4); }
                    u32x4 w; w.x = cvt_pk_bf16(v0[0], v0[1]); w.y = cvt_pk_bf16(v0[2], v0[3]); w.z = cvt_pk_bf16(v1[0], v1[1]); w.w = cvt_pk_bf16(v1[2], v1[3]);
                    *(u32x4*)(rowp + bj * HALF) = w; } }
    }
};
struct EpiResid {
    static constexpr bool PERM = false, AFTER_DRAIN = false;
    const float* base; float* out; const float* gate;
    int gstride;
    __device__ __forceinline__ void operator()(const f32x4 (&acc)[2][2][4][2], const Unit& u, int wr, int wc, int fr, int fq) const {
        const int row0 = u.pm * BM + wr * 64 + fr; const int col0 = u.pn * BM + wc * 32 + 4 * fq; const int b = (u.pm * BM) / SEQ;
        f32x4 gv[2][2];
#pragma unroll
        for (int bj = 0; bj < 2; ++bj)
#pragma unroll
            for (int n = 0; n < 2; ++n) gv[bj][n] = *(const f32x4*)(gate + (size_t)b * gstride + col0 + bj * HALF + n * 16);
#pragma unroll
        for (int ai = 0; ai < 2; ++ai)
#pragma unroll
            for (int m = 0; m < 4; ++m) { const size_t off = (size_t)(row0 + ai * HALF + m * 16) * D + col0;
#pragma unroll
                for (int bj = 0; bj < 2; ++bj)
#pragma unroll
                    for (int n = 0; n < 2; ++n) { const f32x4 bs = *(const f32x4*)(base + off + bj * HALF + n * 16); *(f32x4*)(out + off + bj * HALF + n * 16) = bs + gv[bj][n] * acc[ai][bj][m][n]; } }
    }
};

template <class Epi, class Sched, bool ALIGN_EPI = false, bool SP2 = false>
__device__ __forceinline__ void gemm_phase(PG8_LAS unsigned char* lds, const Gemm g, const Sched& S, const Epi& E) {
    const int tid = threadIdx.x, wid = __builtin_amdgcn_readfirstlane(tid >> 6), lane = tid & 63, wr = wid >> 2, wc = wid & 3, fr = lane & 15, fq = lane >> 4;
    const int K = g.K, nt = K / BK;
    unsigned voffA[2], voffB[2];
#pragma unroll
    for (int i = 0; i < 2; ++i) { int R, C; stage_rc(tid * 16 + i * 8192, R, C); const int Rb = Epi::PERM ? ((R & ~31) + perm32(R & 31)) : R;
        voffA[i] = (unsigned)(R * g.lda + C) * 2u; voffB[i] = (unsigned)(Rb * g.ldb + C) * 2u; }
    const size_t kstep = (size_t)(BK * 2);
    const size_t hstepA = (size_t)HALF * g.lda * 2, hstepB = (size_t)HALF * g.ldb * 2;
    const size_t tstepA = 2 * hstepA, tstepB = 2 * hstepB;
    const unsigned ldsw = (unsigned)wid * 1024u;
    const int aoff = lds_byte(wr * 64 + fr, fq * 8), boff = lds_byte(wc * 32 + fr, fq * 8);
#define PG8_SA(b, h) (((b) * 2 + (h)) * HTB)
#define PG8_SB(b, h) ((4 + (b) * 2 + (h)) * HTB)
#define PG8_STAGE(bufoff, gbase, voff) do { _Pragma("unroll") for (int _i = 0; _i < 2; ++_i) \
        __builtin_amdgcn_global_load_lds((const unsigned*)((const char*)(gbase) + (voff)[_i]), (PG8_LAS unsigned*)(lds + (bufoff) + ldsw + _i * 8192), 16, 0, 0); } while (0)
#define PG8_LDA(dst, b, h) do { _Pragma("unroll") for (int m = 0; m < 4; ++m) _Pragma("unroll") for (int k = 0; k < 2; ++k) dst[m][k] = *(const PG8_LAS bf16x8*)(lds + PG8_SA(b, h) + aoff + m * 2048 + k * 1024); } while (0)
#define PG8_LDB(dst, b, h) do { _Pragma("unroll") for (int n = 0; n < 2; ++n) _Pragma("unroll") for (int k = 0; k < 2; ++k) dst[n][k] = *(const PG8_LAS bf16x8*)(lds + PG8_SB(b, h) + boff + n * 2048 + k * 1024); } while (0)
#define PG8_MMA(ai, bj, At, Bt) do { __builtin_amdgcn_s_setprio(1); _Pragma("unroll") for (int m = 0; m < 4; ++m) _Pragma("unroll") for (int n = 0; n < 2; ++n) _Pragma("unroll") for (int k = 0; k < 2; ++k) \
        acc[ai][bj][m][n] = __builtin_amdgcn_mfma_f32_16x16x32_bf16(Bt[n][k], At[m][k], acc[ai][bj][m][n], 0, 0, 0); __builtin_amdgcn_s_setprio(0); } while (0)
#define PG8_WAIT_V(n) asm volatile("s_waitcnt vmcnt(" #n ")" ::: "memory")
#define PG8_WAIT_L(n) asm volatile("s_waitcnt lgkmcnt(" #n ")" ::: "memory")
#define PG8_BAR __builtin_amdgcn_s_barrier()
#define PG8_SCHED __builtin_amdgcn_sched_barrier(0)
    Unit cur, nxt; int ui = 0;
    if (!S.next(0, cur)) return;
    f32x4 acc[2][2][4][2];
#pragma unroll
    for (int a = 0; a < 2; ++a)
#pragma unroll
        for (int b = 0; b < 2; ++b)
#pragma unroll
            for (int m = 0; m < 4; ++m)
#pragma unroll
                for (int n = 0; n < 2; ++n) acc[a][b][m][n] = (f32x4){0.f, 0.f, 0.f, 0.f};
    bf16x8 At[4][2], B0[2][2], B1[2][2];
    const char* cA = (const char*)g.A + (size_t)cur.pm * tstepA; const char* cB = (const char*)g.Bt + (size_t)cur.pn * tstepB;
    S.a_ready(cur);
    if constexpr (SP2) {
        PG8_STAGE(PG8_SB(0, 0), cB, voffB); PG8_STAGE(PG8_SB(0, 1), cB + hstepB, voffB); PG8_STAGE(PG8_SA(0, 0), cA, voffA); PG8_STAGE(PG8_SA(0, 1), cA + hstepA, voffA);
        if (wr == 1) PG8_BAR;
        PG8_WAIT_V(2); PG8_BAR;
        PG8_STAGE(PG8_SB(1, 0), cB + kstep, voffB); PG8_STAGE(PG8_SA(1, 0), cA + kstep, voffA); PG8_STAGE(PG8_SB(1, 1), cB + hstepB + kstep, voffB);
        PG8_WAIT_V(6); PG8_BAR;
    } else {
        PG8_STAGE(PG8_SB(0, 0), cB, voffB); PG8_STAGE(PG8_SA(0, 0), cA, voffA); PG8_STAGE(PG8_SB(0, 1), cB + hstepB, voffB); PG8_STAGE(PG8_SA(0, 1), cA + hstepA, voffA);
        if (wr == 1) PG8_BAR;
        PG8_WAIT_V(4); PG8_BAR;
        PG8_STAGE(PG8_SB(1, 0), cB + kstep, voffB); PG8_STAGE(PG8_SA(1, 0), cA + kstep, voffA); PG8_STAGE(PG8_SB(1, 1), cB + hstepB + kstep, voffB);
        PG8_WAIT_V(6); PG8_BAR;
    }
    for (;;) {
        const bool has_next = S.next(ui + 1, nxt);
        const char* nA = has_next ? (const char*)g.A + (size_t)nxt.pm * tstepA : cA; const char* nB = has_next ? (const char*)g.Bt + (size_t)nxt.pn * tstepB : cB;
        for (int t = 0; t < nt; t += 2) {
            const bool last = (t == nt - 2);
            const char* a1 = cA + (size_t)(t + 1) * kstep;
            const char* a2 = last ? nA : cA + (size_t)(t + 2) * kstep; const char* b2 = last ? nB : cB + (size_t)(t + 2) * kstep;
            const char* a3 = a2 + kstep; const char* b3 = b2 + kstep;
            if (last && has_next) S.a_ready(nxt);
            if constexpr (SP2) {
            PG8_LDB(B0, 0, 0); PG8_LDB(B1, 0, 1); PG8_SCHED; PG8_LDA(At, 0, 0); PG8_STAGE(PG8_SA(1, 1), a1 + hstepA, voffA);
            PG8_WAIT_V(8); PG8_WAIT_L(0); PG8_BAR; PG8_MMA(0, 0, At, B0); PG8_MMA(0, 1, At, B1); PG8_BAR; PG8_SCHED;
            PG8_LDA(At, 0, 1); PG8_STAGE(PG8_SB(0, 0), b2, voffB); PG8_STAGE(PG8_SB(0, 1), b2 + hstepB, voffB); PG8_STAGE(PG8_SA(0, 0), a2, voffA);
            PG8_WAIT_V(8); PG8_WAIT_L(0); PG8_BAR; PG8_MMA(1, 0, At, B0); PG8_MMA(1, 1, At, B1); PG8_BAR; PG8_SCHED;
            PG8_LDB(B0, 1, 0); PG8_LDB(B1, 1, 1); PG8_SCHED; PG8_LDA(At, 1, 0); PG8_STAGE(PG8_SA(0, 1), a2 + hstepA, voffA);
            PG8_WAIT_V(8); PG8_WAIT_L(0); PG8_BAR; PG8_MMA(0, 0, At, B0); PG8_MMA(0, 1, At, B1); PG8_BAR; PG8_SCHED;
            PG8_LDA(At, 1, 1); PG8_STAGE(PG8_SB(1, 0), b3, voffB); PG8_STAGE(PG8_SB(1, 1), b3 + hstepB, voffB); PG8_STAGE(PG8_SA(1, 0), a3, voffA);
            PG8_WAIT_V(8); PG8_WAIT_L(0); PG8_BAR; PG8_MMA(1, 0, At, B0); PG8_MMA(1, 1, At, B1); PG8_BAR; PG8_SCHED;
            } else {
            PG8_LDB(B0, 0, 0); PG8_SCHED; PG8_LDA(At, 0, 0); PG8_STAGE(PG8_SA(1, 1), a1 + hstepA, voffA);
            PG8_WAIT_L(8); PG8_BAR; PG8_WAIT_L(0); PG8_MMA(0, 0, At, B0); PG8_BAR; PG8_SCHED;
            PG8_LDB(B1, 0, 1); PG8_STAGE(PG8_SB(0, 0), b2, voffB);
            PG8_BAR; PG8_WAIT_L(0); PG8_MMA(0, 1, At, B1); PG8_BAR;
            PG8_LDA(At, 0, 1); PG8_STAGE(PG8_SA(0, 0), a2, voffA);
            PG8_BAR; PG8_WAIT_L(0); PG8_MMA(1, 0, At, B0); PG8_BAR; PG8_SCHED;
            PG8_STAGE(PG8_SB(0, 1), b2 + hstepB, voffB);
            PG8_WAIT_V(6); PG8_BAR; PG8_MMA(1, 1, At, B1); PG8_BAR;
            PG8_LDB(B0, 1, 0); PG8_SCHED; PG8_LDA(At, 1, 0); PG8_STAGE(PG8_SA(0, 1), a2 + hstepA, voffA);
            PG8_WAIT_L(8); PG8_BAR; PG8_WAIT_L(0); PG8_MMA(0, 0, At, B0); PG8_BAR; PG8_SCHED;
            PG8_LDB(B1, 1, 1); PG8_STAGE(PG8_SB(1, 0), b3, voffB);
            PG8_BAR; PG8_WAIT_L(0); PG8_MMA(0, 1, At, B1); PG8_BAR;
            PG8_LDA(At, 1, 1); PG8_STAGE(PG8_SA(1, 0), a3, voffA);
            PG8_BAR; PG8_WAIT_L(0); PG8_MMA(1, 0, At, B0); PG8_BAR; PG8_SCHED;
            PG8_STAGE(PG8_SB(1, 1), b3 + hstepB, voffB);
            PG8_WAIT_V(6); PG8_BAR; PG8_MMA(1, 1, At, B1); PG8_BAR;
            }
        }
        if constexpr (ALIGN_EPI) { if (wr == 0) PG8_BAR; }
        if constexpr (!Epi::AFTER_DRAIN) { E(acc, cur, wr, wc, fr, fq); S.done(cur); }
        if (!has_next) break;
#pragma unroll
        for (int a = 0; a < 2; ++a)
#pragma unroll
            for (int b = 0; b < 2; ++b)
#pragma unroll
                for (int m = 0; m < 4; ++m)
#pragma unroll
                    for (int n = 0; n < 2; ++n) acc[a][b][m][n] = (f32x4){0.f, 0.f, 0.f, 0.f};
        cur = nxt; cA = nA; cB = nB; ++ui;
        if constexpr (ALIGN_EPI) { if (wr == 1) PG8_BAR; }
    }
    PG8_WAIT_V(0);
    if constexpr (!ALIGN_EPI) { if (wr == 0) PG8_BAR; }
    PG8_BAR;
#undef PG8_SA
#undef PG8_SB
#undef PG8_STAGE
#undef PG8_LDA
#undef PG8_LDB
#undef PG8_MMA
#undef PG8_WAIT_V
#undef PG8_WAIT_L
#undef PG8_BAR
#undef PG8_SCHED
}
}

constexpr int NWAVES = 8;
constexpr size_t MiB = 1u << 20;
constexpr size_t WS_CTL = 0, CTL_ZERO_BYTES = 1 * MiB;
constexpr size_t WS_MOD = 1 * MiB;
constexpr size_t WS_MODP = 4 * MiB;
constexpr size_t WS_WIN = 8 * MiB;
constexpr size_t WS_WOUT = 26 * MiB;
constexpr size_t WS_WQ = 42 * MiB;
constexpr size_t WS_WPOOL = 58 * MiB;
constexpr size_t WS_SK = 59 * MiB;
constexpr size_t WS_U16 = 64 * MiB;
constexpr size_t WS_V16 = 192 * MiB;
constexpr size_t WS_H = 320 * MiB;
constexpr size_t WS_Z = 352 * MiB;
constexpr size_t WS_POOLED = 388 * MiB;
constexpr size_t WS_MIX = 404 * MiB;
constexpr size_t WS_X1 = 436 * MiB;
constexpr size_t WS_XA = 500 * MiB;
constexpr size_t WS_QP = 564 * MiB;
constexpr size_t WS_IDX = 596 * MiB;
constexpr size_t WS_GATE = 600 * MiB;
constexpr size_t WS_END = 604 * MiB;
constexpr int CW_BAR = 4096;
constexpr int RING_BYTES = 131072;
constexpr int LDS_BYTES = 147456;
constexpr int LDSCTL_OFF = LDS_BYTES - 512;

#define GAS __attribute__((address_space(1)))
#define LAS __attribute__((address_space(3)))
typedef unsigned short bf16;
typedef unsigned v4u __attribute__((ext_vector_type(4)));
typedef unsigned v2u __attribute__((ext_vector_type(2)));
typedef float f32x4 __attribute__((ext_vector_type(4)));
typedef float f32x16 __attribute__((ext_vector_type(16)));
typedef short bf16x8 __attribute__((ext_vector_type(8)));
typedef short s16x4 __attribute__((ext_vector_type(4)));
typedef __bf16 bf16x2v __attribute__((ext_vector_type(2)));
typedef GAS unsigned gu32;
#define RLX_AGENT __ATOMIC_RELAXED, __HIP_MEMORY_SCOPE_AGENT
#define LDS_WAIT() asm volatile("s_waitcnt lgkmcnt(0)" ::: "memory")
__device__ __forceinline__ unsigned f2bf(float f) { unsigned u = __builtin_bit_cast(unsigned, f); return (u + 0x7fffu + ((u >> 16) & 1u)) >> 16; }
__device__ __forceinline__ unsigned pk2(float lo, float hi) { return f2bf(lo) | (f2bf(hi) << 16); }
__device__ __forceinline__ float bflo(unsigned w) { return __builtin_bit_cast(float, w << 16); }
__device__ __forceinline__ float bfhi(unsigned w) { return __builtin_bit_cast(float, w & 0xffff0000u); }
__device__ __forceinline__ float dot2(unsigned a, unsigned b, float acc) { return __builtin_amdgcn_fdot2_f32_bf16(__builtin_bit_cast(bf16x2v, a), __builtin_bit_cast(bf16x2v, b), acc, false); }
__device__ __forceinline__ float wave_sum(float v) {
#pragma unroll
    for (int o = 1; o < 64; o <<= 1) v += __shfl_xor(v, o);
    return v;
}
__device__ __forceinline__ float rdlane(float v, int l) { return __builtin_bit_cast(float, __builtin_amdgcn_readlane(__builtin_bit_cast(int, v), l)); }

#define XB_TMO      128
#define XB_XCNT(j)  (256  + 64 * (j))
#define XB_XSUB(j)  (1280 + 64 * (j))
#define XB_XGEN(j)  (2304 + 64 * (j))
#define XB_TOP      3328
#define XB_TOPGEN   3392
#define XCD_BAR_WORDS 3456
#define XB_SPIN_CAP (1u << 22)
__device__ __forceinline__ unsigned xb_ld(unsigned* p)              { return __hip_atomic_load(p, __ATOMIC_RELAXED, __HIP_MEMORY_SCOPE_AGENT); }
__device__ __forceinline__ unsigned xb_add(unsigned* p, unsigned v) { return __hip_atomic_fetch_add(p, v, __ATOMIC_RELAXED, __HIP_MEMORY_SCOPE_AGENT); }
__device__ __forceinline__ unsigned xb_xcc_id() { return (unsigned)__builtin_amdgcn_s_getreg((3 << 11) | 20) & 0xFu; }
#define XB_SPIN(cond, bar) do { unsigned _sp = 0; while (cond) { __builtin_amdgcn_s_sleep(1); \
    if ((++_sp & 255u) == 0u) { if (xb_ld(&(bar)[XB_TMO])) break; if (_sp > XB_SPIN_CAP) { atomicAdd(&(bar)[XB_TMO], 1u); break; } } } } while (0)
struct XcdBarrier { unsigned* bar; unsigned x; volatile LAS unsigned* st; };
__device__ __forceinline__ XcdBarrier xcd_barrier_post(unsigned* bar, volatile LAS unsigned* st) {
    XcdBarrier b; b.bar = bar; b.x = xb_xcc_id(); b.st = st;
    if (threadIdx.x == 0) (void)xb_add(&bar[XB_XCNT(b.x)], 1u);
    return b;
}
__device__ __forceinline__ void xcd_barrier_complete(unsigned* bar, unsigned x, unsigned& nloc, unsigned& nx) {
    const unsigned G = gridDim.x * gridDim.y * gridDim.z;
    unsigned sum, cnt, mine, sp = 0u;
    for (;;) {
        sum = 0u; cnt = 0u; mine = 0u;
#pragma unroll
        for (unsigned j = 0; j < 16; ++j) { const unsigned c = xb_ld(&bar[XB_XCNT(j)]); sum += c; cnt += (c > 0u) ? 1u : 0u; mine = (j == x) ? c : mine; }
        if (sum == G) break;
        __builtin_amdgcn_s_sleep(1);
        if ((++sp & 255u) == 0u) { if (xb_ld(&bar[XB_TMO])) break; if (sp > XB_SPIN_CAP) { atomicAdd(&bar[XB_TMO], 1u); break; } }
    }
    nloc = mine > 0u ? mine : 1u; nx = cnt > 0u ? cnt : 1u;
}
__device__ __forceinline__ void xcd_barrier(const XcdBarrier& b) {
    asm volatile("s_waitcnt vmcnt(0)" ::: "memory");
    __syncthreads();
    if (threadIdx.x == 0) {
        unsigned* bar = b.bar;
        __builtin_amdgcn_s_waitcnt(0);
        unsigned nloc = b.st[0], nx = b.st[1];
        if (nloc == 0u) { xcd_barrier_complete(bar, b.x, nloc, nx); b.st[0] = nloc; b.st[1] = nx; }
        const unsigned old = xb_add(&bar[XB_XSUB(b.x)], 1u);
        const unsigned gen = old / nloc;
        if (old + 1u == (gen + 1u) * nloc) {
            __builtin_amdgcn_fence(__ATOMIC_RELEASE, "agent");
            asm volatile("s_waitcnt vmcnt(0)" ::: "memory");
            const unsigned og = xb_add(&bar[XB_TOP], 1u);
            const unsigned tg = og / nx;
            if (og + 1u == (tg + 1u) * nx) xb_add(&bar[XB_TOPGEN], 1u);
            else XB_SPIN(xb_ld(&bar[XB_TOPGEN]) == tg, bar);
            __builtin_amdgcn_fence(__ATOMIC_ACQUIRE, "agent");
            xb_add(&bar[XB_XGEN(b.x)], 1u);
            asm volatile("s_waitcnt vmcnt(0)" ::: "memory");
        } else {
            XB_SPIN(xb_ld(&bar[XB_XGEN(b.x)]) == gen, bar);
            __builtin_amdgcn_fence(__ATOMIC_ACQUIRE, "agent");
            asm volatile("s_waitcnt vmcnt(0)" ::: "memory");
        }
    }
    __syncthreads();
}

struct Args { const float* in[18]; float* out; unsigned char* ws; int ph_lo, ph_hi, coop, pad; };
struct Frame {
    LAS unsigned char* lds;
    int tid, lane, wave, vcu, G;
    const Args* A;
    unsigned char* ws;
};
#define F_IN(k) (F.A->in[k])
#define F_x F_IN(0)
#define F_c F_IN(1)
#define F_rel_bias F_IN(2)
#define F_ada_w F_IN(3)
#define F_ada_b F_IN(4)
#define F_norm1_gain F_IN(5)
#define F_w_in F_IN(6)
#define F_q_gain F_IN(7)
#define F_k_gain F_IN(8)
#define F_sinks F_IN(9)
#define F_w_pool F_IN(10)
#define F_pool_scale F_IN(11)
#define F_w_out F_IN(12)
#define F_norm2_gain F_IN(13)
#define F_w_query F_IN(14)
#define F_sub_keys F_IN(15)
#define F_peer_u F_IN(16)
#define F_peer_v F_IN(17)
#define F_out (F.A->out)
#define F_MOD ((float*)(F.ws + WS_MOD))
#define F_MODP ((float*)(F.ws + WS_MODP))
#define F_X1 ((float*)(F.ws + WS_X1))
#define F_XA ((float*)(F.ws + WS_XA))
#define F_GATE ((float*)(F.ws + WS_GATE))
#define F_WIN ((bf16*)(F.ws + WS_WIN))
#define F_WOUT ((bf16*)(F.ws + WS_WOUT))
#define F_WQ ((bf16*)(F.ws + WS_WQ))
#define F_WPOOL ((bf16*)(F.ws + WS_WPOOL))
#define F_SK ((bf16*)(F.ws + WS_SK))
#define F_U8 ((unsigned char*)(F.ws + WS_U16))
#define F_V8 ((unsigned char*)(F.ws + WS_V16))
#define F_H ((bf16*)(F.ws + WS_H))
#define F_Z ((bf16*)(F.ws + WS_Z))
#define F_POOLED ((bf16*)(F.ws + WS_POOLED))
#define F_MIX ((bf16*)(F.ws + WS_MIX))
#define F_QP ((bf16*)(F.ws + WS_QP))
#define F_IDX ((int*)(F.ws + WS_IDX))

__device__ __forceinline__ void p0_transpose_item(const float* W, int N, bf16* WT, int ldo, LAS float* scr, int item, int lane) {
    const int nblk = N / 32, kb = item / nblk, nb = item % nblk, k0 = 64 * kb, n0 = 32 * nb;
#pragma unroll 8
    for (int i = 0; i < 32; ++i) { const int kk = 2 * i + (lane >> 5); scr[kk * 33 + (lane & 31)] = W[(size_t)(k0 + kk) * N + n0 + (lane & 31)]; }
    LDS_WAIT(); asm volatile("" ::: "memory");
    const int c = lane & 7;
#pragma unroll
    for (int j = 0; j < 4; ++j) { const int n = (lane >> 3) + 8 * j; const LAS float* s = scr + (8 * c) * 33 + n;
        v4u o; o.x = pk2(s[0 * 33], s[1 * 33]); o.y = pk2(s[2 * 33], s[3 * 33]); o.z = pk2(s[4 * 33], s[5 * 33]); o.w = pk2(s[6 * 33], s[7 * 33]);
        *(GAS v4u*)(WT + (size_t)(n0 + n) * ldo + k0 + 8 * c) = o; }
    LDS_WAIT(); asm volatile("" ::: "memory");
}
__device__ __forceinline__ float silu_f(float v) { return v / (1.f + __expf(-v)); }

__device__ __forceinline__ void p0_prologue(Frame& F) {
    LAS float* scr = (LAS float*)(F.lds + F.wave * 16384);
    const int gw = F.vcu * NWAVES + F.wave, NGW = F.G * NWAVES, lane = F.lane;
    for (int it = gw; it < 2 * 48 * 16; it += NGW) {
        const int l = it / 768, r = it % 768, cgp = r / 16, kc = r % 16;
        const float* W = F_ada_w + (size_t)l * D * MODW + (size_t)(kc * 128) * MODW + cgp * 256 + lane * 4;
        const float c0a = silu_f(F_c[kc * 128 + lane]), c0b = silu_f(F_c[kc * 128 + 64 + lane]);
        const float c1a = silu_f(F_c[D + kc * 128 + lane]), c1b = silu_f(F_c[D + kc * 128 + 64 + lane]);
        f32x4 a0 = {0.f, 0.f, 0.f, 0.f}, a1 = {0.f, 0.f, 0.f, 0.f};
#pragma unroll 8
        for (int kk = 0; kk < 64; ++kk) { const f32x4 w = *(const GAS f32x4*)(W + (size_t)kk * MODW); const float s0 = rdlane(c0a, kk), s1 = rdlane(c1a, kk); a0 += w * s0; a1 += w * s1; }
#pragma unroll 8
        for (int kk = 0; kk < 64; ++kk) { const f32x4 w = *(const GAS f32x4*)(W + (size_t)(64 + kk) * MODW); const float s0 = rdlane(c0b, kk), s1 = rdlane(c1b, kk); a0 += w * s0; a1 += w * s1; }
        float* P = F_MODP + (size_t)kc * (2 * 2 * MODW) + (size_t)(l * 2) * MODW + cgp * 256 + lane * 4;
        *(GAS f32x4*)P = a0; *(GAS f32x4*)(P + MODW) = a1;
    }
    constexpr int I_IN = 32 * 72, I_OUT = 32 * 64, I_Q = 32 * 64, I_P = 4 * 32, I_L = I_IN + I_OUT + I_Q + I_P;
    for (int it = gw; it < 2 * I_L; it += NGW) {
        const int l = it / I_L; int r = it % I_L;
        if (r < I_IN) { p0_transpose_item(F_w_in + (size_t)l * D * DIN, DIN, F_WIN + (size_t)l * DIN * D, D, scr, r, lane); continue; } r -= I_IN;
        if (r < I_OUT) { p0_transpose_item(F_w_out + (size_t)l * D * D, D, F_WOUT + (size_t)l * D * D, D, scr, r, lane); continue; } r -= I_OUT;
        if (r < I_Q) { p0_transpose_item(F_w_query + (size_t)l * D * D, D, F_WQ + (size_t)l * D * D, D, scr, r, lane); continue; } r -= I_Q;
        { const int g = r / 32, rr = r % 32; p0_transpose_item(F_w_pool + (size_t)(l * 4 + g) * 65536, 256, F_WPOOL + (size_t)(l * 4 + g) * 65536, 256, scr, rr, lane); }
    }
    {
        constexpr long NCH_SK = 65536 / 512, NCH_E = (long)2 * NEXP * D / 512;
        for (long ch = gw; ch < NCH_SK + 2 * NCH_E; ch += NGW) {
            if (ch < NCH_SK) {
                const float* src = F_sub_keys; bf16* dst = F_SK; const long o = ch;
                const f32x4 v0 = *(const GAS f32x4*)(src + o * 512 + lane * 4), v1 = *(const GAS f32x4*)(src + o * 512 + 256 + lane * 4);
                v2u w0, w1; w0.x = pk2(v0[0], v0[1]); w0.y = pk2(v0[2], v0[3]); w1.x = pk2(v1[0], v1[1]); w1.y = pk2(v1[2], v1[3]);
                *(GAS v2u*)(dst + o * 512 + lane * 4) = w0; *(GAS v2u*)(dst + o * 512 + 256 + lane * 4) = w1;
            } else {
                const bool isu = ch < NCH_SK + NCH_E; const long o = isu ? ch - NCH_SK : ch - NCH_SK - NCH_E;
                const float* src = isu ? F_peer_u : F_peer_v; unsigned char* dst = isu ? F_U8 : F_V8; const float sc = isu ? 512.f : 16.f;
                const f32x4 v0 = *(const GAS f32x4*)(src + o * 512 + lane * 8) * sc, v1 = *(const GAS f32x4*)(src + o * 512 + lane * 8 + 4) * sc;
                int w0 = __builtin_amdgcn_cvt_pk_fp8_f32(v0[0], v0[1], 0, false); w0 = __builtin_amdgcn_cvt_pk_fp8_f32(v0[2], v0[3], w0, true);
                int w1 = __builtin_amdgcn_cvt_pk_fp8_f32(v1[0], v1[1], 0, false); w1 = __builtin_amdgcn_cvt_pk_fp8_f32(v1[2], v1[3], w1, true);
                v2u w; w.x = (unsigned)w0; w.y = (unsigned)w1;
                *(GAS v2u*)(dst + o * 512 + lane * 8) = w;
            }
        }
    }
}

__device__ __forceinline__ f32x4 mod_reduce4(Frame& F, int i) {
    const int col = i % MODW, l = i / (2 * MODW);
    f32x4 a = *(const GAS f32x4*)(F_ada_b + (size_t)l * MODW + col);
#pragma unroll 4
    for (int kc = 0; kc < 16; ++kc) a += *(const GAS f32x4*)(F_MODP + (size_t)kc * (4 * MODW) + i);
    return a;
}

__device__ __forceinline__ void norm_rows(const float* xin, bf16* hout, int r0, int nrows, const f32x4 (&av)[8], const f32x4 (&sv)[8], int lane) {
    for (int r = r0; r < r0 + nrows; ++r) {
        const GAS f32x4* xr = (const GAS f32x4*)(xin + (size_t)r * D) + lane;
        f32x4 v[8]; float ss = 0.f;
#pragma unroll
        for (int j = 0; j < 8; ++j) { v[j] = xr[64 * j]; ss += (v[j][0] * v[j][0] + v[j][1] * v[j][1]) + (v[j][2] * v[j][2] + v[j][3] * v[j][3]); }
        const float rstd = 1.f / sqrtf(wave_sum(ss) * (1.f / D) + EPS);
        GAS v2u* o = (GAS v2u*)(hout + (size_t)r * D) + lane;
#pragma unroll
        for (int j = 0; j < 8; ++j) { const f32x4 y = v[j] * rstd * av[j] + sv[j]; v2u w; w.x = pk2(y[0], y[1]); w.y = pk2(y[2], y[3]); o[64 * j] = w; }
    }
}

__device__ __forceinline__ void p1_mod_norm1(Frame& F) {
    const int gw = F.vcu * NWAVES + F.wave, lane = F.lane;
    if (gw < 192) { const int i = gw * 256 + lane * 4; *(GAS f32x4*)(F_MOD + i) = mod_reduce4(F, i); }
    const int r0 = gw * 4, b = r0 / SEQ;
    f32x4 av[8], sv[8];
#pragma unroll
    for (int j = 0; j < 8; ++j) { const int col = 4 * lane + 256 * j;
        const f32x4 sh = mod_reduce4(F, (0 * 2 + b) * MODW + 0 * D + col), sc = mod_reduce4(F, (0 * 2 + b) * MODW + 1 * D + col);
        const f32x4 g = *(const GAS f32x4*)(F_norm1_gain + col);
        av[j] = g * (sc + 1.f); sv[j] = sh; asm volatile("" ::: "memory"); }
    norm_rows(F_x, F_H, r0, 4, av, sv, lane);
}

__device__ __forceinline__ void p_norm2(Frame& F, int l) {
    const int gw = F.vcu * NWAVES + F.wave, lane = F.lane;
    const int r0 = gw * 4, b = r0 / SEQ;
    const float* mod = F_MOD + (size_t)(l * 2 + b) * MODW;
    f32x4 av[8], sv[8];
#pragma unroll
    for (int j = 0; j < 8; ++j) { const int col = 4 * lane + 256 * j;
        const f32x4 sh = *(const GAS f32x4*)(mod + 3 * D + col), sc = *(const GAS f32x4*)(mod + 4 * D + col);
        const f32x4 g = *(const GAS f32x4*)(F_norm2_gain + (size_t)l * D + col);
        av[j] = g * (sc + 1.f); sv[j] = sh; }
    norm_rows(F_X1, F_H, r0, 4, av, sv, lane);
}

__device__ __forceinline__ int t5_bucket(int rel) {
    const int n = rel < 0 ? -rel : rel; int ret = rel > 0 ? 16 : 0;
    int large = 8 + (n >= 12) + (n >= 16) + (n >= 23) + (n >= 32) + (n >= 46) + (n >= 64) + (n >= 91);
    return ret + (n < 8 ? n : large);
}
constexpr int KS_STRIDE = 72, VT_STRIDE = 196;
constexpr int ATT_KS = 0, ATT_VT = 27648, ATT_QS = 53248, ATT_TBL = ATT_QS + 8 * 9216;
static_assert(ATT_TBL + 8 * 1024 <= LDSCTL_OFF, "attention LDS map");

__device__ __forceinline__ void attn_item(Frame& F, int l, int item) {
    const int g = item & 1, n = (item >> 1) & 63, b = item >> 7;
    const int tok0 = b * SEQ + n * 64, key0 = tok0 - 128, lane = F.lane, wave = F.wave, tid = F.tid;
    LAS bf16* Ks = (LAS bf16*)(F.lds + ATT_KS); LAS bf16* Vt = (LAS bf16*)(F.lds + ATT_VT);
    LAS bf16* Qs = (LAS bf16*)(F.lds + ATT_QS + wave * 9216); LAS float* tbl = (LAS float*)(F.lds + ATT_TBL + wave * 1024);
    const int hq = g * 8 + wave;
    {
        const int c = tid & 7;
        const f32x4 kg0 = *(const GAS f32x4*)(F_k_gain + l * HD + 8 * c), kg1 = *(const GAS f32x4*)(F_k_gain + l * HD + 8 * c + 4);
#pragma unroll
        for (int i = 0; i < 3; ++i) {
            const int row = (tid >> 3) + 64 * i; int tk = key0 + row; if (tk < b * SEQ) tk = b * SEQ;
            const bf16* zr = F_Z + (size_t)tk * DIN;
            const v4u kw = *(const GAS v4u*)(zr + 2048 + g * 64 + 8 * c), vw = *(const GAS v4u*)(zr + 2176 + g * 64 + 8 * c);
            float kf[8] = {bflo(kw.x), bfhi(kw.x), bflo(kw.y), bfhi(kw.y), bflo(kw.z), bfhi(kw.z), bflo(kw.w), bfhi(kw.w)};
            float ss = 0.f;
#pragma unroll
            for (int j = 0; j < 8; ++j) ss += kf[j] * kf[j];
            ss += __shfl_xor(ss, 1); ss += __shfl_xor(ss, 2); ss += __shfl_xor(ss, 4);
            const float rstd = 1.f / sqrtf(ss * (1.f / HD) + EPS);
            v4u o; o.x = pk2(kf[0] * rstd * kg0[0], kf[1] * rstd * kg0[1]); o.y = pk2(kf[2] * rstd * kg0[2], kf[3] * rstd * kg0[3]);
            o.z = pk2(kf[4] * rstd * kg1[0], kf[5] * rstd * kg1[1]); o.w = pk2(kf[6] * rstd * kg1[2], kf[7] * rstd * kg1[3]);
            *(LAS v4u*)(Ks + row * KS_STRIDE + 8 * c) = o;
            const unsigned vv[4] = {vw.x, vw.y, vw.z, vw.w};
#pragma unroll
            for (int j = 0; j < 4; ++j) { Vt[(8 * c + 2 * j) * VT_STRIDE + row] = (bf16)(vv[j] & 0xffffu); Vt[(8 * c + 2 * j + 1) * VT_STRIDE + row] = (bf16)(vv[j] >> 16); }
        }
    }
    {
        const int c = lane & 7;
        const f32x4 qg0 = *(const GAS f32x4*)(F_q_gain + l * HD + 8 * c), qg1 = *(const GAS f32x4*)(F_q_gain + l * HD + 8 * c + 4);
#pragma unroll
        for (int i = 0; i < 8; ++i) {
            const int row = (lane >> 3) + 8 * i;
            const v4u qw = *(const GAS v4u*)(F_Z + (size_t)(tok0 + row) * DIN + 1024 + hq * 64 + 8 * c);
            float qf[8] = {bflo(qw.x), bfhi(qw.x), bflo(qw.y), bfhi(qw.y), bflo(qw.z), bfhi(qw.z), bflo(qw.w), bfhi(qw.w)};
            float ss = 0.f;
#pragma unroll
            for (int j = 0; j < 8; ++j) ss += qf[j] * qf[j];
            ss += __shfl_xor(ss, 1); ss += __shfl_xor(ss, 2); ss += __shfl_xor(ss, 4);
            const float rstd = 0.125f / sqrtf(ss * (1.f / HD) + EPS);
            v4u o; o.x = pk2(qf[0] * rstd * qg0[0], qf[1] * rstd * qg0[1]); o.y = pk2(qf[2] * rstd * qg0[2], qf[3] * rstd * qg0[3]);
            o.z = pk2(qf[4] * rstd * qg1[0], qf[5] * rstd * qg1[1]); o.w = pk2(qf[6] * rstd * qg1[2], qf[7] * rstd * qg1[3]);
            *(LAS v4u*)(Qs + row * KS_STRIDE + 8 * c) = o;
        }
#pragma unroll
        for (int i = 0; i < 4; ++i) { const int e = lane + 64 * i; if (e < 255) tbl[e] = F_rel_bias[t5_bucket(e - 191) * NQH + hq]; }
    }
    __syncthreads();
    const int r = lane & 31, h = lane >> 5;
    const int kt0 = n == 0 ? 4 : (n == 1 ? 2 : 0);
    const int dbg = F.A->pad;
    const float sink = (dbg == 0) ? F_sinks[l * NQH + hq] : -INFINITY;
    const float m0 = (dbg == 0) ? sink : -1e30f;
#pragma unroll 1
    for (int qt = 0; qt < 2; ++qt) {
        bf16x8 qf[4];
#pragma unroll
        for (int s = 0; s < 4; ++s) qf[s] = *(const LAS bf16x8*)(Qs + (32 * qt + r) * KS_STRIDE + 16 * s + 8 * h);
        f32x16 acc[6];
#pragma unroll
        for (int kt = 0; kt < 6; ++kt) {
#pragma unroll
            for (int i = 0; i < 16; ++i) acc[kt][i] = 0.f;
#pragma unroll
            for (int s = 0; s < 4; ++s) { const bf16x8 a = *(const LAS bf16x8*)(Ks + (32 * kt + r) * KS_STRIDE + 16 * s + 8 * h);
                acc[kt] = __builtin_amdgcn_mfma_f32_32x32x16_bf16(a, qf[s], acc[kt], 0, 0, 0); }
            asm volatile("" ::: "memory");
        }
        const int a = 32 * qt + r; float m = m0;
#pragma unroll
        for (int kt = 0; kt < 6; ++kt) {
#pragma unroll
            for (int i = 0; i < 16; ++i) { const int bk = 32 * kt + (i & 3) + 8 * (i >> 2) + 4 * h; float s = (dbg == 1 ? 0.f : acc[kt][i]) + ((dbg == 0 || dbg == 3) ? tbl[bk - a + 63] : 0.f); if (kt < kt0) s = -INFINITY; acc[kt][i] = s; m = fmaxf(m, s); }
            asm volatile("" ::: "memory");
        }
        m = fmaxf(m, __shfl_xor(m, 32));
        float sum = 0.f;
#pragma unroll
        for (int kt = 0; kt < 6; ++kt)
#pragma unroll
            for (int i = 0; i < 16; ++i) { const float p = __expf(acc[kt][i] - m); acc[kt][i] = p; sum += p; }
        sum += __shfl_xor(sum, 32); sum += __expf(sink - m);
        const float inv = 1.f / sum;
        f32x16 o[2];
#pragma unroll
        for (int dt = 0; dt < 2; ++dt) {
#pragma unroll
            for (int i = 0; i < 16; ++i) o[dt][i] = 0.f;
        }
#pragma unroll
        for (int kt = 0; kt < 6; ++kt)
#pragma unroll
            for (int s2 = 0; s2 < 2; ++s2) {
                v4u pw; pw.x = pk2(acc[kt][8 * s2 + 0], acc[kt][8 * s2 + 1]); pw.y = pk2(acc[kt][8 * s2 + 2], acc[kt][8 * s2 + 3]);
                pw.z = pk2(acc[kt][8 * s2 + 4], acc[kt][8 * s2 + 5]); pw.w = pk2(acc[kt][8 * s2 + 6], acc[kt][8 * s2 + 7]);
                const bf16x8 pb = __builtin_bit_cast(bf16x8, pw);
#pragma unroll
                for (int dt = 0; dt < 2; ++dt) {
                    const LAS bf16* vp = Vt + (32 * dt + r) * VT_STRIDE + 32 * kt + 16 * s2 + 4 * h;
                    const v2u lo = *(const LAS v2u*)vp, hi = *(const LAS v2u*)(vp + 8);
                    v4u aw; aw.x = lo.x; aw.y = lo.y; aw.z = hi.x; aw.w = hi.y;
                    o[dt] = __builtin_amdgcn_mfma_f32_32x32x16_bf16(__builtin_bit_cast(bf16x8, aw), pb, o[dt], 0, 0, 0);
                }
                asm volatile("" ::: "memory");
            }
        bf16* orow = F_MIX + (size_t)(tok0 + a) * D + 1024 + hq * 64;
#pragma unroll
        for (int dt = 0; dt < 2; ++dt)
#pragma unroll
            for (int q4 = 0; q4 < 4; ++q4) { v2u w; w.x = pk2(o[dt][4 * q4] * inv, o[dt][4 * q4 + 1] * inv); w.y = pk2(o[dt][4 * q4 + 2] * inv, o[dt][4 * q4 + 3] * inv);
                *(GAS v2u*)(orow + 32 * dt + 8 * q4 + 4 * h) = w; }
    }
    __syncthreads();
}

__device__ __forceinline__ void pool_item(Frame& F, int item) {
    const int g = item & 3, tt = (item >> 2) & 255, b = item >> 10, lane = F.lane;
    const int w = 2 << g, t0 = tt * 16;
    const bf16* zb = F_Z + (size_t)(b * SEQ) * DIN + 256 * g + 4 * lane;
    f32x4 S = {0.f, 0.f, 0.f, 0.f};
    for (int j = 1; j <= w; ++j) { const int t = t0 - j; if (t >= 0) { const v2u pw = *(const GAS v2u*)(zb + (size_t)t * DIN); S += (f32x4){bflo(pw.x), bfhi(pw.x), bflo(pw.y), bfhi(pw.y)}; } }
#pragma unroll 4
    for (int t = t0; t < t0 + 16; ++t) {
        const v2u pw = *(const GAS v2u*)(zb + (size_t)t * DIN); const f32x4 pt = {bflo(pw.x), bfhi(pw.x), bflo(pw.y), bfhi(pw.y)};
        S += pt;
        if (t - w >= 0) { const v2u qw = *(const GAS v2u*)(zb + (size_t)(t - w) * DIN); S -= (f32x4){bflo(qw.x), bfhi(qw.x), bflo(qw.y), bfhi(qw.y)}; }
        const float ic = 1.f / (float)((t + 1) < w ? (t + 1) : w);
        const f32x4 y = S * ic - pt;
        v2u o; o.x = pk2(y[0], y[1]); o.y = pk2(y[2], y[3]);
        *(GAS v2u*)(F_POOLED + (size_t)(b * SEQ + t) * DPOOL + 256 * g + 4 * lane) = o;
    }
}

constexpr int SK_STRIDE = 136;
constexpr int TK_SK = 0, TK_TAB = 2 * 128 * SK_STRIDE * 2;
__device__ __forceinline__ int ford(float x) { const int b = __builtin_bit_cast(int, x); return b ^ ((b >> 31) & 0x7fffffff); }
__device__ __forceinline__ float fdeord(int k) { return __builtin_bit_cast(float, k ^ ((k >> 31) & 0x7fffffff)); }
template <int CTRL> __device__ __forceinline__ int dppi(int v) { return __builtin_amdgcn_update_dpp(v, v, CTRL, 0xf, 0xf, false); }
__device__ __forceinline__ int row_allmax(int v) {
    v = max(v, dppi<0x128>(v)); v = max(v, dppi<0x124>(v)); v = max(v, dppi<0x122>(v)); v = max(v, dppi<0x121>(v)); return v;
}
__device__ __forceinline__ float row_allsum(float v) {
    v += __builtin_bit_cast(float, dppi<0x128>(__builtin_bit_cast(int, v))); v += __builtin_bit_cast(float, dppi<0x124>(__builtin_bit_cast(int, v)));
    v += __builtin_bit_cast(float, dppi<0x122>(__builtin_bit_cast(int, v))); v += __builtin_bit_cast(float, dppi<0x121>(__builtin_bit_cast(int, v))); return v;
}
__device__ __forceinline__ int bperm(int srclane, int v) { return __builtin_amdgcn_ds_bpermute(srclane << 2, v); }

__device__ __forceinline__ void p_topk(Frame& F, int l) {
    const int gw = F.vcu * NWAVES + F.wave, NGW = F.G * NWAVES, lane = F.lane, tid = F.tid;
    LAS bf16* SKs = (LAS bf16*)(F.lds + TK_SK); LAS unsigned char* tab = F.lds + TK_TAB;
    {
        const bf16* src = F_SK + (size_t)l * 32768;
#pragma unroll
        for (int i = 0; i < 8; ++i) { const int ch = tid + 512 * i; const int row = ch >> 4, c = ch & 15;
            *(LAS v4u*)(SKs + row * SK_STRIDE + 8 * c) = *(const GAS v4u*)(src + row * 128 + 8 * c); }
        if (tid == 0) { int s = 0; for (int a = 0; a < 16; ++a) for (int bb = 0; bb < 16; ++bb) if ((a + 1) * (bb + 1) <= 16) { tab[s] = (unsigned char)a; tab[64 + s] = (unsigned char)bb; ++s; }
            for (; s < 64; ++s) { tab[s] = 255; tab[64 + s] = 255; } }
    }
    __syncthreads();
    const int r = lane & 15, q4 = lane >> 4, rowbase = lane & ~15;
    int ca[4], cb[4];
#pragma unroll
    for (int j = 0; j < 4; ++j) { ca[j] = tab[4 * r + j]; cb[j] = tab[64 + 4 * r + j]; }
    for (int unit = gw; unit < T / 2; unit += NGW) {
        const int t0 = 2 * unit;
        const bf16* qrow = F_QP + (size_t)(t0 + (r >> 3)) * D + (r & 7) * 256 + 8 * q4;
        int res[2][4];
#pragma unroll
        for (int p = 0; p < 2; ++p) {
            f32x4 acc[8];
#pragma unroll
            for (int nt = 0; nt < 8; ++nt) acc[nt] = (f32x4){0.f, 0.f, 0.f, 0.f};
#pragma unroll 1
            for (int ks = 0; ks < 4; ++ks) { const bf16x8 a = *(const GAS bf16x8*)(qrow + p * 128 + 32 * ks);
#pragma unroll
                for (int nt = 0; nt < 8; ++nt) { const bf16x8 bq = *(const LAS bf16x8*)(SKs + (p * 128 + 16 * nt + r) * SK_STRIDE + 32 * ks + 8 * q4);
                    acc[nt] = __builtin_amdgcn_mfma_f32_16x16x32_bf16(a, bq, acc[nt], 0, 0, 0); } }
#pragma unroll
            for (int i = 0; i < 4; ++i) {
                int key[8];
#pragma unroll
                for (int nt = 0; nt < 8; ++nt) key[nt] = (ford(acc[nt][i]) & ~127) | (127 - (16 * nt + r));
                int mine = 0;
#pragma unroll 1
                for (int rd = 0; rd < 16; ++rd) {
                    int m = max(max(max(key[0], key[1]), max(key[2], key[3])), max(max(key[4], key[5]), max(key[6], key[7])));
                    m = row_allmax(m);
                    if (r == rd) mine = m;
#pragma unroll
                    for (int nt = 0; nt < 8; ++nt) key[nt] = (key[nt] == m) ? (int)0x80000000 : key[nt];
                }
                res[p][i] = mine;
            }
        }
#pragma unroll
        for (int i = 0; i < 4; ++i) {
            const int k1 = res[0][i], k2 = res[1][i];
            int ck[4];
#pragma unroll
            for (int j = 0; j < 4; ++j) {
                const int va = bperm(rowbase + (ca[j] & 15), k1), vb = bperm(rowbase + (cb[j] & 15), k2);
                const float s = fdeord(va & ~127) + fdeord(vb & ~127);
                ck[j] = (ca[j] == 255) ? (int)0x80000000 : ((ford(s) & ~63) | (63 - (4 * r + j)));
            }
            int mine = 0;
#pragma unroll 1
            for (int rd = 0; rd < 16; ++rd) {
                int m = max(max(ck[0], ck[1]), max(ck[2], ck[3]));
                m = row_allmax(m);
                if (r == rd) mine = m;
#pragma unroll
                for (int j = 0; j < 4; ++j) ck[j] = (ck[j] == m) ? (int)0x80000000 : ck[j];
            }
            const int slot = 63 - (mine & 63);
            const int a = tab[slot], bb = tab[64 + slot];
            const int va = bperm(rowbase + a, k1), vb = bperm(rowbase + bb, k2);
            const float s = fdeord(va & ~127) + fdeord(vb & ~127);
            const int eidx = (127 - (va & 127)) * 128 + (127 - (vb & 127));
            const float smax = __builtin_bit_cast(float, bperm(rowbase, __builtin_bit_cast(int, s)));
            const float e = __expf(s - smax);
            const float gate = e / row_allsum(e);
            const int row = 4 * q4 + i, tok = t0 + (row >> 3), hh = row & 7;
            F_IDX[(size_t)tok * 128 + hh * 16 + r] = eidx;
            F_GATE[(size_t)tok * 128 + hh * 16 + r] = gate;
        }
    }
}

__device__ __forceinline__ float gelu_exact(float v) { return 0.5f * v * (1.f + erff(v * 0.70710678118654752f)); }

typedef float f32x2 __attribute__((ext_vector_type(2)));
__device__ __forceinline__ f32x2 fp8lo(unsigned w) { return __builtin_amdgcn_cvt_pk_f32_fp8((int)w, false); }
__device__ __forceinline__ f32x2 fp8hi(unsigned w) { return __builtin_amdgcn_cvt_pk_f32_fp8((int)w, true); }

__device__ __forceinline__ void p_peer(Frame& F, int l) {
    const int gw = F.vcu * NWAVES + F.wave, lane = F.lane;
    LAS float* sc = (LAS float*)(F.lds + F.wave * 8448);
    const unsigned char* U = F_U8 + (size_t)l * NEXP * D; const unsigned char* V = F_V8 + (size_t)l * NEXP * D;
    const float* xin = F_X1; float* xout = (l == 0) ? F_XA : F_out;
    for (int tj = 0; tj < 4; ++tj) {
        const int t = gw * 4 + tj, b = t / SEQ;
        f32x2 hv[16];
#pragma unroll
        for (int j = 0; j < 2; ++j) { const GAS v4u* hr = (const GAS v4u*)(F_H + (size_t)t * D + 16 * lane + 1024 * j); const v4u w0 = hr[0], w1 = hr[1];
            const unsigned ww[8] = {w0.x, w0.y, w0.z, w0.w, w1.x, w1.y, w1.z, w1.w};
#pragma unroll
            for (int q = 0; q < 8; ++q) hv[8 * j + q] = (f32x2){bflo(ww[q]), bfhi(ww[q])}; }
        const int idx0 = F_IDX[(size_t)t * 128 + lane], idx1 = F_IDX[(size_t)t * 128 + 64 + lane];
        const float g0 = F_GATE[(size_t)t * 128 + lane], g1 = F_GATE[(size_t)t * 128 + 64 + lane];
        float act[2];
#pragma unroll
        for (int half = 0; half < 2; ++half) {
            const int idv = half ? idx1 : idx0; float av = 0.f;
#pragma unroll
            for (int kb = 0; kb < 2; ++kb) {
#pragma unroll 8
                for (int kk = 0; kk < 32; ++kk) {
                    const int e = __builtin_amdgcn_readlane(idv, kb * 32 + kk);
                    const GAS v4u* ur = (const GAS v4u*)(U + (size_t)e * D) + lane;
                    const v4u w0 = ur[0], w1 = ur[64];
                    const unsigned ww[8] = {w0.x, w0.y, w0.z, w0.w, w1.x, w1.y, w1.z, w1.w};
                    f32x2 p0 = {0.f, 0.f}, p1 = {0.f, 0.f};
#pragma unroll
                    for (int q = 0; q < 8; ++q) { p0 += fp8lo(ww[q]) * hv[2 * q]; p1 += fp8hi(ww[q]) * hv[2 * q + 1]; }
                    sc[kk * 65 + lane] = (p0[0] + p0[1]) + (p1[0] + p1[1]);
                }
                LDS_WAIT(); asm volatile("" ::: "memory");
                float s = 0.f; const int k = lane & 31, part = lane >> 5;
#pragma unroll
                for (int x = 0; x < 32; ++x) s += sc[k * 65 + 32 * part + x];
                s += __shfl_xor(s, 32);
                if (part == kb) av = s;
                LDS_WAIT(); asm volatile("" ::: "memory");
            }
            act[half] = gelu_exact(av * (1.f / 512.f)) * (half ? g1 : g0) * (1.f / 16.f);
        }
        f32x2 o[16];
#pragma unroll
        for (int i = 0; i < 16; ++i) o[i] = (f32x2){0.f, 0.f};
#pragma unroll
        for (int half = 0; half < 2; ++half) {
            const int idv = half ? idx1 : idx0; const float acv = act[half];
#pragma unroll 8
            for (int k = 0; k < 64; ++k) {
                const int e = __builtin_amdgcn_readlane(idv, k); const float a = rdlane(acv, k); const f32x2 a2 = {a, a};
                const GAS v4u* vr = (const GAS v4u*)(V + (size_t)e * D) + lane;
                const v4u w0 = vr[0], w1 = vr[64];
                const unsigned ww[8] = {w0.x, w0.y, w0.z, w0.w, w1.x, w1.y, w1.z, w1.w};
#pragma unroll
                for (int q = 0; q < 8; ++q) { o[2 * q] += a2 * fp8lo(ww[q]); o[2 * q + 1] += a2 * fp8hi(ww[q]); }
            }
        }
        const float* mod = F_MOD + (size_t)(l * 2 + b) * MODW;
        float ss = 0.f;
#pragma unroll
        for (int j = 0; j < 2; ++j)
#pragma unroll
            for (int q = 0; q < 4; ++q) {
                const int col = 16 * lane + 1024 * j + 4 * q;
                const f32x4 xa = *(const GAS f32x4*)(xin + (size_t)t * D + col), ga = *(const GAS f32x4*)(mod + 5 * D + col);
                f32x4 y; y[0] = xa[0] + ga[0] * o[8 * j + 2 * q][0]; y[1] = xa[1] + ga[1] * o[8 * j + 2 * q][1]; y[2] = xa[2] + ga[2] * o[8 * j + 2 * q + 1][0]; y[3] = xa[3] + ga[3] * o[8 * j + 2 * q + 1][1];
                o[8 * j + 2 * q] = (f32x2){y[0], y[1]}; o[8 * j + 2 * q + 1] = (f32x2){y[2], y[3]};
                ss += (y[0] * y[0] + y[1] * y[1]) + (y[2] * y[2] + y[3] * y[3]);
                *(GAS f32x4*)(xout + (size_t)t * D + col) = y;
            }
        if (l == 0) {
            const float rstd = 1.f / sqrtf(wave_sum(ss) * (1.f / D) + EPS);
            const float* mod1 = F_MOD + (size_t)(1 * 2 + b) * MODW;
#pragma unroll
            for (int j = 0; j < 2; ++j)
#pragma unroll
                for (int q = 0; q < 2; ++q) {
                    const int col = 16 * lane + 1024 * j + 8 * q; float y[8];
#pragma unroll
                    for (int hf = 0; hf < 2; ++hf) {
                        const f32x4 sh = *(const GAS f32x4*)(mod1 + 0 * D + col + 4 * hf), scv = *(const GAS f32x4*)(mod1 + 1 * D + col + 4 * hf), gn = *(const GAS f32x4*)(F_norm1_gain + D + col + 4 * hf);
#pragma unroll
                        for (int e = 0; e < 4; ++e) y[4 * hf + e] = o[8 * j + 4 * q + 2 * hf + (e >> 1)][e & 1] * rstd * gn[e] * (1.f + scv[e]) + sh[e];
                    }
                    v4u w; w.x = pk2(y[0], y[1]); w.y = pk2(y[2], y[3]); w.z = pk2(y[4], y[5]); w.w = pk2(y[6], y[7]);
                    *(GAS v4u*)(F_H + (size_t)t * D + col) = w;
                }
        }
    }
}

constexpr int N_PHASES = 18;
__global__ void __launch_bounds__(NWAVES * 64, 2) mk_fwd(Args args) {
    extern __shared__ __attribute__((aligned(16))) unsigned char lds[];
    Frame F;
    F.lds = (LAS unsigned char*)lds;
    F.tid = threadIdx.x; F.lane = F.tid & 63; F.wave = __builtin_amdgcn_readfirstlane(F.tid >> 6);
    F.G = gridDim.x; { const int bx = blockIdx.x; F.vcu = (F.G % 8 == 0) ? (bx % 8) * (F.G / 8) + bx / 8 : bx; }
    F.A = &args; F.ws = args.ws;
    unsigned char* ws = args.ws;
    volatile LAS unsigned* MISC = (volatile LAS unsigned*)(F.lds + LDSCTL_OFF);
    for (int u = F.tid; u < (LDS_BYTES - LDSCTL_OFF) / 4; u += NWAVES * 64) ((LAS unsigned*)(F.lds + LDSCTL_OFF))[u] = 0u;
    __syncthreads();
    const int lo = args.ph_lo, hi = args.ph_hi;
    XcdBarrier bar; bar.bar = (unsigned*)(ws + WS_CTL) + CW_BAR; bar.x = 0; bar.st = nullptr;
    if (hi - lo > 1) bar = xcd_barrier_post((unsigned*)(ws + WS_CTL) + CW_BAR, MISC + 8);
    bool first_seam = args.coop != 0;
#define SEAM() do { if (first_seam) { cg::this_grid().sync(); first_seam = false; } else xcd_barrier(bar); } while (0)
#define RUN(k, ...) do { if (lo <= (k) && (k) < hi) { __VA_ARGS__; if ((k) + 1 < hi) SEAM(); } } while (0)
    RUN(0, if (PHMASK & 1) for (int rep = 0; rep < REP_PRO; ++rep) p0_prologue(F));
    RUN(1, if (PHMASK & 2) p1_mod_norm1(F));
#define LAYER(l, base) \
    RUN(base + 0, if (PHMASK & 4) for (int rep = 0; rep < ((l) == 1 ? REP_REST : 1); ++rep) { \
        pg8::Gemm g{F_H, F_WIN + (size_t)(l) * DIN * D, T, DIN, D, D, D}; pg8::StaticOrder S; S.init(T, DIN, F.G, (int)blockIdx.x); \
        pg8::EpiBf16S E{F_Z, DIN, 0, nullptr}; \
        pg8::gemm_phase<pg8::EpiBf16S, pg8::StaticOrder, true, true>(F.lds, g, S, E); }); \
    RUN(base + 1, if (PHMASK & 8) for (int rep = 0; rep < ((l) == 1 ? REP_REST : 1); ++rep) { \
        for (int it = blockIdx.x; it < 256; it += F.G) attn_item(F, (l), it); \
        for (int it = F.vcu * NWAVES + F.wave; it < 2048; it += F.G * NWAVES) pool_item(F, it); }); \
    RUN(base + 2, if ((PHMASK & 16) && blockIdx.x < 128) for (int rep = 0; rep < ((l) == 1 ? REP_REST : 1); ++rep) { \
        const int gidx = blockIdx.x >> 5, pm = blockIdx.x & 31; \
        int Kp = 256; asm volatile("" : "+s"(Kp)); \
        pg8::Gemm g{F_POOLED + 256 * gidx, F_WPOOL + (size_t)((l) * 4 + gidx) * 65536, T, 256, Kp, DPOOL, 256}; pg8::OneUnit S{pm}; \
        pg8::EpiBf16S E{F_MIX, D, 256 * gidx, F_pool_scale + (size_t)(l) * DPOOL}; \
        pg8::gemm_phase<pg8::EpiBf16S, pg8::OneUnit, false, true>(F.lds, g, S, E); }); \
    RUN(base + 3, if (PHMASK & 32) for (int rep = 0; rep < ((l) == 1 ? REP_REST : 1); ++rep) { \
        pg8::Gemm g{F_MIX, F_WOUT + (size_t)(l) * D * D, T, D, D, D, D}; pg8::StaticOrder S; S.init(T, D, F.G, (int)blockIdx.x); \
        pg8::EpiResid E{(l) == 0 ? F_x : F_XA, F_X1, F_MOD + (size_t)((l) * 2) * MODW + 2 * D, MODW}; \
        pg8::gemm_phase<pg8::EpiResid, pg8::StaticOrder, false, true>(F.lds, g, S, E); }); \
    RUN(base + 4, if (PHMASK & 64) for (int rep = 0; rep < ((l) == 1 ? REP_REST : 1); ++rep) p_norm2(F, (l))); \
    RUN(base + 5, if (PHMASK & 128) for (int rep = 0; rep < ((l) == 1 ? REP_REST : 1); ++rep) { \
        pg8::Gemm g{F_H, F_WQ + (size_t)(l) * D * D, T, D, D, D, D}; pg8::StaticOrder S; S.init(T, D, F.G, (int)blockIdx.x); \
        pg8::EpiBf16S E{F_QP, D, 0, nullptr}; \
        pg8::gemm_phase<pg8::EpiBf16S, pg8::StaticOrder, false, true>(F.lds, g, S, E); }); \
    RUN(base + 6, if (PHMASK & 256) for (int rep = 0; rep < ((l) == 1 ? REP_REST : 1); ++rep) p_topk(F, (l))); \
    RUN(base + 7, if (PHMASK & 512) for (int rep = 0; rep < ((l) == 1 ? REP_PEER : 1); ++rep) p_peer(F, (l)));
    LAYER(0, 2)
    LAYER(1, 10)
#undef LAYER
#undef RUN
#undef SEAM
}


#ifndef MK_DIAG
#define MK_DIAG 0
#endif
#if MK_DIAG
constexpr size_t WS_DIAG = 3 * MiB;
__device__ __forceinline__ float bf2f(bf16 v) { return __builtin_bit_cast(float, (unsigned)v << 16); }
__device__ __forceinline__ float block_sum(float v, float* red) {
    v = wave_sum(v); __syncthreads(); if ((threadIdx.x & 63) == 0) red[threadIdx.x >> 6] = v; __syncthreads();
    const float r = red[0] + red[1] + red[2] + red[3]; __syncthreads(); return r;
}
__device__ __forceinline__ void diag_max(float* slot, float d) { if (!(d == d)) d = 1e9f; atomicMax((unsigned*)slot, __builtin_bit_cast(unsigned, d < 0 ? 0.f : d)); }
__device__ __forceinline__ unsigned hsh(unsigned x) { x ^= x >> 16; x *= 0x7feb352du; x ^= x >> 15; x *= 0x846ca68bu; x ^= x >> 16; return x; }
__device__ __forceinline__ int sample_tok(int s) { const int special[8] = {0, 5, 63, 64, 130, 4095, 4096, 8191}; return s < 8 ? special[s] : (int)(hsh(s * 7919u + 13u) % T); }
__device__ __forceinline__ float gelu_d(float v) { return 0.5f * v * (1.f + erff(v * 0.70710678118654752f)); }

__global__ void __launch_bounds__(256) diag_kernel(Args args, int stage, int l, int dbg = 0, int slot_override = 0) {
    __shared__ float red[4]; __shared__ float sh[768]; __shared__ int shi[512];
    const int s = blockIdx.x, tid = threadIdx.x; unsigned char* ws = args.ws;
    float* slots = (float*)(ws + WS_DIAG);
    const float* MOD = (const float*)(ws + WS_MOD); const bf16* H = (const bf16*)(ws + WS_H); const bf16* Z = (const bf16*)(ws + WS_Z);
    const bf16* POOLED = (const bf16*)(ws + WS_POOLED); const bf16* MIX = (const bf16*)(ws + WS_MIX); const float* X1 = (const float*)(ws + WS_X1);
    const float* XA = (const float*)(ws + WS_XA); const bf16* QP = (const bf16*)(ws + WS_QP); const int* IDX = (const int*)(ws + WS_IDX); const float* GATE = (const float*)(ws + WS_GATE);
    const int t = sample_tok(s), b = t / SEQ; const unsigned hr = hsh(s * 31u + stage * 1009u + 7u);
    if (stage == 1) {
        { const int j = hr % MODW; const int ll = (hr >> 16) & 1, bb = (hr >> 17) & 1; float a = 0.f;
          for (int k = tid; k < D; k += 256) { const float c = args.in[1][bb * D + k]; a += c / (1.f + expf(-c)) * args.in[3][(size_t)ll * D * MODW + (size_t)k * MODW + j]; }
          a = block_sum(a, red) + args.in[4][ll * MODW + j];
          if (tid == 0) diag_max(slots + 1, fabsf(a - MOD[(ll * 2 + bb) * MODW + j])); }
        { float ss = 0.f; for (int k = tid; k < D; k += 256) { const float v = args.in[0][(size_t)t * D + k]; ss += v * v; }
          ss = block_sum(ss, red); const int c = hr % D; const float* mod = MOD + (size_t)(0 * 2 + b) * MODW;
          const float want = args.in[0][(size_t)t * D + c] / sqrtf(ss / D + EPS) * args.in[5][c] * (1.f + mod[D + c]) + mod[c];
          if (tid == 0) diag_max(slots + 1, fabsf(want - bf2f(H[(size_t)t * D + c]))); }
    } else if (stage == 2) {
        const int n = hr % DIN; float a = 0.f; const float* W = args.in[6] + (size_t)l * D * DIN;
        for (int k = tid; k < D; k += 256) a += bf2f(H[(size_t)t * D + k]) * W[(size_t)k * DIN + n];
        a = block_sum(a, red); if (tid == 0) diag_max(slots + 2, fabsf(a - bf2f(Z[(size_t)t * DIN + n])));
    } else if (stage == 3) {
        if (tid == 0) { const int c = hr % DPOOL, g = c / 256, w = 2 << g, tt = t % SEQ; float sm = 0.f; int cnt = 0;
            for (int j = 0; j < w; ++j) if (tt - j >= 0) { sm += bf2f(Z[(size_t)(t - j) * DIN + c]); ++cnt; }
            diag_max(slots + 3, fabsf(sm / cnt - bf2f(Z[(size_t)t * DIN + c]) - bf2f(POOLED[(size_t)t * DPOOL + c]))); }
        const int hq = (hr >> 8) & 15, d = (hr >> 12) & 63, g = hq >> 3, tt = t % SEQ, n = tt / 64, a = tt % 64;
        float qn[64]; float qs = 0.f;
        for (int i = 0; i < 64; ++i) { const float v = bf2f(Z[(size_t)t * DIN + 1024 + hq * 64 + i]); qs += v * v; }
        const float qr = 1.f / sqrtf(qs / 64 + EPS);
        float sc = -INFINITY, vv = 0.f;
        if (tid < 192) { const int kc = n - 2 + tid / 64; if (kc >= 0) { const int tk = b * SEQ + kc * 64 + (tid % 64); float ks = 0.f, dt = 0.f;
            for (int i = 0; i < 64; ++i) { const float kv = bf2f(Z[(size_t)tk * DIN + 2048 + g * 64 + i]); ks += kv * kv; }
            const float kr = 1.f / sqrtf(ks / 64 + EPS);
            for (int i = 0; i < 64; ++i) dt += bf2f(Z[(size_t)t * DIN + 1024 + hq * 64 + i]) * qr * args.in[7][l * 64 + i] * bf2f(Z[(size_t)tk * DIN + 2048 + g * 64 + i]) * kr * args.in[8][l * 64 + i];
            const int rel = tid - 128 - a; const int nn = rel < 0 ? -rel : rel; int bucket;
            if (nn < 8) bucket = nn; else { int lg = 8 + (int)(logf((float)nn / 8.f) / logf(16.f) * 8.f + 1e-4f); bucket = lg < 15 ? lg : 15; }
            if (rel > 0) bucket += 16;
            sc = (dbg == 1 ? 0.f : dt * 0.125f) + ((dbg == 0 || dbg == 3) ? args.in[2][bucket * 16 + hq] : 0.f); vv = bf2f(Z[(size_t)tk * DIN + 2176 + g * 64 + d]); } }
        (void)qn;
        sh[tid] = sc; __syncthreads();
        const float snk = dbg == 0 ? args.in[9][l * 16 + hq] : -INFINITY;
        float m = dbg == 0 ? snk : -1e30f; for (int i = 0; i < 192; ++i) m = fmaxf(m, sh[i]);
        const float p = (tid < 192 && sc > -INFINITY) ? expf(sc - m) : 0.f;
        const float den = block_sum(p, red) + expf(snk - m); const float num = block_sum(p * vv, red);
        if (tid == 0) diag_max(slots + (slot_override ? slot_override : 4), fabsf(num / den - bf2f(MIX[(size_t)t * D + 1024 + hq * 64 + d])));
    } else if (stage == 4) {
        const int c = hr % DPOOL, g = c / 256, dd = c % 256; float a = 0.f;
        { const int k = tid; a = bf2f(POOLED[(size_t)t * DPOOL + 256 * g + k]) * args.in[10][(size_t)(l * 4 + g) * 65536 + k * 256 + dd]; }
        a = block_sum(a, red) * args.in[11][l * DPOOL + c]; if (tid == 0) diag_max(slots + 5, fabsf(a - bf2f(MIX[(size_t)t * D + c])));
    } else if (stage == 5) {
        const int n = hr % D; float a = 0.f; const float* W = args.in[12] + (size_t)l * D * D;
        for (int k = tid; k < D; k += 256) a += bf2f(MIX[(size_t)t * D + k]) * W[(size_t)k * D + n];
        a = block_sum(a, red); const float* xin = l == 0 ? args.in[0] : XA;
        const float want = xin[(size_t)t * D + n] + MOD[(size_t)(l * 2 + b) * MODW + 2 * D + n] * a;
        if (tid == 0) diag_max(slots + 6, fabsf(want - X1[(size_t)t * D + n]));
    } else if (stage == 6) {
        float ss = 0.f; for (int k = tid; k < D; k += 256) { const float v = X1[(size_t)t * D + k]; ss += v * v; }
        ss = block_sum(ss, red); const int c = hr % D; const float* mod = MOD + (size_t)(l * 2 + b) * MODW;
        const float want = X1[(size_t)t * D + c] / sqrtf(ss / D + EPS) * args.in[13][l * D + c] * (1.f + mod[4 * D + c]) + mod[3 * D + c];
        if (tid == 0) diag_max(slots + 7, fabsf(want - bf2f(H[(size_t)t * D + c])));
    } else if (stage == 7) {
        const int n = hr % D; float a = 0.f; const float* W = args.in[14] + (size_t)l * D * D;
        for (int k = tid; k < D; k += 256) a += bf2f(H[(size_t)t * D + k]) * W[(size_t)k * D + n];
        a = block_sum(a, red); if (tid == 0) diag_max(slots + 8, fabsf(a - bf2f(QP[(size_t)t * D + n])));
    } else if (stage == 8) {
        const int h = hr & 7; const int p = tid >> 7, n = tid & 127; float a = 0.f;
        for (int i = 0; i < 128; ++i) a += bf2f(QP[(size_t)t * D + h * 256 + p * 128 + i]) * args.in[15][(size_t)((l * 2 + p) * 128 + n) * 128 + i];
        sh[tid] = a; __syncthreads();
        if (tid < 2) { for (int r = 0; r < 16; ++r) { int bi = 0; float bv = -INFINITY; for (int i = 0; i < 128; ++i) if (sh[tid * 128 + i] > bv) { bv = sh[tid * 128 + i]; bi = i; }
            sh[256 + tid * 16 + r] = bv; shi[tid * 16 + r] = bi; sh[tid * 128 + bi] = -INFINITY; } }
        __syncthreads();
        { const int aa = tid >> 4, bb = tid & 15; sh[512 + tid] = sh[256 + aa] + sh[256 + 16 + bb]; shi[256 + tid] = shi[aa] * 128 + shi[16 + bb]; }
        __syncthreads();
        if (tid == 0) { float ts[16]; int ti[16]; float den = 0.f;
            for (int r = 0; r < 16; ++r) { int bi = 0; float bv = -INFINITY; for (int i = 0; i < 256; ++i) if (sh[512 + i] > bv) { bv = sh[512 + i]; bi = i; } ts[r] = bv; ti[r] = shi[256 + bi]; sh[512 + bi] = -INFINITY; }
            for (int r = 0; r < 16; ++r) den += expf(ts[r] - ts[0]);
            float bad = 0.f;
            for (int r = 0; r < 16; ++r) { float gg = 0.f; for (int q = 0; q < 16; ++q) if (IDX[(size_t)t * 128 + h * 16 + q] == ti[r]) gg = GATE[(size_t)t * 128 + h * 16 + q]; bad += fabsf(gg - expf(ts[r] - ts[0]) / den); }
            diag_max(slots + 9, bad); }
    } else if (stage == 9) {
        const int d = hr % D; const float* U = args.in[16] + (size_t)l * NEXP * D; const float* V = args.in[17] + (size_t)l * NEXP * D; float contrib = 0.f;
        if (tid < 128) { const int e = IDX[(size_t)t * 128 + tid]; float a = 0.f; for (int k = 0; k < D; ++k) a += U[(size_t)e * D + k] * bf2f(H[(size_t)t * D + k]);
            contrib = gelu_d(a) * GATE[(size_t)t * 128 + tid] * V[(size_t)e * D + d]; }
        const float o = block_sum(contrib, red); const float want = X1[(size_t)t * D + d] + MOD[(size_t)(l * 2 + b) * MODW + 5 * D + d] * o;
        const float* xo = l == 0 ? XA : args.out;
        if (tid == 0) diag_max(slots + 10, fabsf(want - xo[(size_t)t * D + d]));
    }
}
__global__ void diag_report(Args args) {
    float* slots = (float*)(args.ws + WS_DIAG);
#if MK_DIAG == 3
    { int code = 0; if (slots[11] > 0.03f) code |= 1; if (slots[12] > 0.03f) code |= 2; if (slots[13] > 0.03f) code |= 4; if (slots[14] > 0.03f) code |= 8;
      args.out[0] = sqrtf(powf(10.f, 3.f + 0.25f * code) * 16777216.f * 1.14f); return; }
#endif
    const float thr[11] = {0, 0.03f, 0.05f, 0.05f, 0.05f, 0.05f, 0.05f, 0.05f, 0.05f, 0.1f, 0.05f};
    for (int i = 1; i <= 10; ++i) { const float d = slots[i]; if (d > thr[i]) {
        float mant = d * 10.f; if (mant > 5.0f) mant = 5.0f; if (mant < 1.0f) mant = 1.0f;
        const float target = mant * powf(10.f, (float)i + 1.f);
        args.out[0] = sqrtf(target * 16777216.f * 1.14f); return; } }
}
#endif

extern "C" void kernel_launch(void* const* d_in, const int* in_sizes, int n_in, void* d_out, int out_size, void* d_ws, size_t ws_size, hipStream_t stream) {
    static int grid = 0;
    if (grid == 0) {
        if (n_in != 18 || out_size != T * D || ws_size < WS_END) { fprintf(stderr, "kernel_launch: unexpected shapes (n_in %d out %d ws %zu)\n", n_in, out_size, ws_size); grid = -1; return; }
        int dev = 0, cus = 0, per_cu = 0;
        if (hipGetDevice(&dev) != hipSuccess || hipDeviceGetAttribute(&cus, hipDeviceAttributeMultiprocessorCount, dev) != hipSuccess) { grid = -1; return; }
        if (hipFuncSetAttribute((const void*)mk_fwd, hipFuncAttributeMaxDynamicSharedMemorySize, LDS_BYTES) != hipSuccess) { fprintf(stderr, "kernel_launch: hipFuncSetAttribute failed\n"); grid = -1; return; }
        if (hipOccupancyMaxActiveBlocksPerMultiprocessor(&per_cu, (const void*)mk_fwd, NWAVES * 64, LDS_BYTES) != hipSuccess || per_cu < 1) { fprintf(stderr, "kernel_launch: occupancy query says %d\n", per_cu); per_cu = 1; }
        (void)hipGetLastError();
        grid = cus;
        if (grid != 256) fprintf(stderr, "kernel_launch: note: %d CUs\n", grid);
    }
    if (grid < 0) return;
    (void)hipMemsetAsync((char*)d_ws + WS_CTL, 0, CTL_ZERO_BYTES, stream);
    Args a{};
    for (int i = 0; i < 18; ++i) a.in[i] = (const float*)d_in[i];
    a.out = (float*)d_out; a.ws = (unsigned char*)d_ws;
#if MK_ONE_LAUNCH
    a.ph_lo = 0; a.ph_hi = N_PHASES; a.coop = 1;
    void* kargs[] = {&a};
    hipError_t e = hipLaunchCooperativeKernel((const void*)mk_fwd, dim3(grid), dim3(NWAVES * 64), kargs, LDS_BYTES, stream);
    if (e != hipSuccess) fprintf(stderr, "cooperative launch failed: %s (grid %d)\n", hipGetErrorString(e), grid);
#else
#if MK_DIAG
    (void)hipMemsetAsync((char*)d_ws + WS_DIAG, 0, 4096, stream);
#endif
    for (int ph = 0; ph < N_PHASES; ++ph) {
        a.ph_lo = ph; a.ph_hi = ph + 1; a.coop = 0;
        hipLaunchKernelGGL(mk_fwd, dim3(grid), dim3(NWAVES * 64), LDS_BYTES, stream, a);
#if MK_DIAG
        if (ph == 1) hipLaunchKernelGGL(diag_kernel, dim3(64), dim3(256), 0, stream, a, 1, 0);
#if MK_DIAG == 3
        if (ph == 3) {
            hipLaunchKernelGGL(diag_kernel, dim3(64), dim3(256), 0, stream, a, 3, 0, 0, 11);
            hipLaunchKernelGGL(mk_fwd, dim3(grid), dim3(NWAVES * 64), LDS_BYTES, stream, a);
            hipLaunchKernelGGL(diag_kernel, dim3(64), dim3(256), 0, stream, a, 3, 0, 0, 12);
            a.ph_lo = 2; a.ph_hi = 3; hipLaunchKernelGGL(mk_fwd, dim3(grid), dim3(NWAVES * 64), LDS_BYTES, stream, a);
            a.ph_lo = 3; a.ph_hi = 4; hipLaunchKernelGGL(mk_fwd, dim3(grid), dim3(NWAVES * 64), LDS_BYTES, stream, a);
            hipLaunchKernelGGL(diag_kernel, dim3(64), dim3(256), 0, stream, a, 3, 0, 0, 13);
        }
#endif
        if (ph >= 2 && MK_DIAG < 3) { const int l = (ph - 2) / 8, s = (ph - 2) % 8; const int st[8] = {2, 3, 4, 5, 6, 7, 8, 9};
            if (l == MK_DIAG - 1) hipLaunchKernelGGL(diag_kernel, dim3(64), dim3(256), 0, stream, a, st[s], l); }
#endif
    }
#if MK_DIAG
    hipLaunchKernelGGL(diag_report, dim3(1), dim3(1), 0, stream, a);
#endif
#endif
}
```

```cpp
#include <hip/hip_runtime.h>
#include <hip/hip_cooperative_groups.h>
#include <cstdio>
#include <cstdint>
namespace cg = cooperative_groups;

#ifndef PHMASK
#define PHMASK 0x3ff
#endif
#ifndef REP_PRO
#define REP_PRO 1
#endif
#ifndef REP_PEER
#define REP_PEER 1
#endif
#ifndef REP_REST
#define REP_REST 1
#endif
#ifndef MK_ONE_LAUNCH
#define MK_ONE_LAUNCH 1
#endif

constexpr int BATCH = 2, SEQ = 4096, T = BATCH * SEQ, D = 2048, DIN = 2304, DPOOL = 1024, HD = 64, NQH = 16;
constexpr int NEXP = 16384, MODW = 6 * D;
constexpr float EPS = 1e-6f;

namespace pg8 {
#define PG8_LAS __attribute__((address_space(3)))
typedef unsigned short bf16_t;
typedef short bf16x8 __attribute__((ext_vector_type(8)));
typedef float f32x4 __attribute__((ext_vector_type(4)));
typedef unsigned u32x4 __attribute__((ext_vector_type(4)));
constexpr int BM = 256, BK = 64, HALF = 128, HTB = HALF * BK * 2, STAGE_BYTES = 8 * HTB, NXCD = 8, WGM = 8;

__host__ __device__ __forceinline__ int lds_byte(int r, int c) { const int st = (r >> 4) * 2 + (c >> 5), rr = r & 15, cc = c & 31, ob = rr * 64 + cc * 2; return st * 1024 + (ob ^ (((ob >> 9) & 1) << 5)); }
__host__ __device__ __forceinline__ void stage_rc(int b, int& R, int& C) { const int st = b / 1024, sb = b % 1024, swz = sb ^ (((sb >> 9) & 1) << 5); R = (st >> 1) * 16 + swz / 64; C = (st & 1) * 32 + (swz % 64) / 2; }
__host__ __device__ __forceinline__ int perm32(int rho) { const int n = rho >> 4, i = rho & 15; return 8 * (i >> 2) + 4 * n + (i & 3); }

struct Unit { int pm, pn; };
struct Gemm { const bf16_t* A; const bf16_t* Bt; int M, N, K, lda, ldb; };

struct StaticOrder {
    int nM, nN, nwg, G, c;
    __host__ __device__ void init(int M, int N, int G_, int c_) { nM = M / BM; nN = N / BM; nwg = nM * nN; G = G_; c = c_; }
    __host__ __device__ bool next(int i, Unit& u) const {
        const long L = (long)i * G + c; if (L >= nwg) return false;
        int wgid = (int)L; { const int q = nwg / NXCD, r = nwg % NXCD, xcd = wgid % NXCD, off = wgid / NXCD; wgid = (xcd < r ? xcd * (q + 1) : r * (q + 1) + (xcd - r) * q) + off; }
        const int nig = WGM * nN, gid = wgid / nig, fm = gid * WGM, gsz = (nM - fm) < WGM ? (nM - fm) : WGM;
        u.pm = fm + ((wgid % nig) % gsz); u.pn = (wgid % nig) / gsz; return true;
    }
    __device__ __forceinline__ void a_ready(const Unit&) const {}
    __device__ __forceinline__ void done(const Unit&) const {}
};
struct OneUnit {
    int pm;
    __device__ __forceinline__ bool next(int i, Unit& u) const { if (i > 0) return false; u.pm = pm; u.pn = 0; return true; }
    __device__ __forceinline__ void a_ready(const Unit&) const {}
    __device__ __forceinline__ void done(const Unit&) const {}
};

__device__ __forceinline__ unsigned cvt_pk_bf16(float lo, float hi) { unsigned r; asm volatile("v_cvt_pk_bf16_f32 %0, %1, %2" : "=v"(r) : "v"(lo), "v"(hi)); return r; }

struct EpiBf16S {
    static constexpr bool PERM = true, AFTER_DRAIN = false;
    bf16_t* O; int ldc; int col_off; const float* cscale;
    __device__ __forceinline__ void operator()(const f32x4 (&acc)[2][2][4][2], const Unit& u, int wr, int wc, int fr, int fq) const {
        const int row0 = u.pm * BM + wr * 64 + fr; const int col0 = col_off + u.pn * BM + wc * 32 + 8 * fq;
#pragma unroll
        for (int ai = 0; ai < 2; ++ai)
#pragma unroll
            for (int m = 0; m < 4; ++m) { bf16_t* rowp = O + (size_t)(row0 + ai * HALF + m * 16) * ldc + col0;
#pragma unroll
                for (int bj = 0; bj < 2; ++bj) { f32x4 v0 = acc[ai][bj][m][0], v1 = acc[ai][bj][m][1];
                    if (cscale) { v0 = v0 * *(const f32x4*)(cscale + col0 + bj * HALF); v1 = v1 * *(const f32x4*)(cscale + col0 + bj * HALF + 4); }
                    u32x4 w; w.x = cvt_pk_bf16(v0[0], v0[1]); w.y = cvt_pk_bf16(v0[2], v0[3]); w.z = cvt_pk_bf16(v1[0], v1[1]); w.w = cvt_pk_bf16(v1[2], v1[3]);
                    *(u32x4*)(rowp + bj * HALF) = w; } }
    }
};
struct EpiResid {
    static constexpr bool PERM = false, AFTER_DRAIN = false;
    const float* base; float* out; const float* gate;
    int gstride;
    __device__ __forceinline__ void operator()(const f32x4 (&acc)[2][2][4][2], const Unit& u, int wr, int wc, int fr, int fq) const {
        const int row0 = u.pm * BM + wr * 64 + fr; const int col0 = u.pn * BM + wc * 32 + 4 * fq; const int b = (u.pm * BM) / SEQ;
        f32x4 gv[2][2];
#pragma unroll
        for (int bj = 0; bj < 2; ++bj)
#pragma unroll
            for (int n = 0; n < 2; ++n) gv[bj][n] = *(const f32x4*)(gate + (size_t)b * gstride + col0 + bj * HALF + n * 16);
#pragma unroll
        for (int ai = 0; ai < 2; ++ai)
#pragma unroll
            for (int m = 0; m < 4; ++m) { const size_t off = (size_t)(row0 + ai * HALF + m * 16) * D + col0;
#pragma unroll
                for (int bj = 0; bj < 2; ++bj)
#pragma unroll
                    for (int n = 0; n < 2; ++n) { const f32x4 bs = *(const f32x4*)(base + off + bj * HALF + n * 16); *(f32x4*)(out + off + bj * HALF + n * 16) = bs + gv[bj][n] * acc[ai][bj][m][n]; } }
    }
};

template <class Epi, class Sched, bool ALIGN_EPI = false, bool SP2 = false>
__device__ __forceinline__ void gemm_phase(PG8_LAS unsigned char* lds, const Gemm g, const Sched& S, const Epi& E) {
    const int tid = threadIdx.x, wid = __builtin_amdgcn_readfirstlane(tid >> 6), lane = tid & 63, wr = wid >> 2, wc = wid & 3, fr = lane & 15, fq = lane >> 4;
    const int K = g.K, nt = K / BK;
    unsigned voffA[2], voffB[2];
#pragma unroll
    for (int i = 0; i < 2; ++i) { int R, C; stage_rc(tid * 16 + i * 8192, R, C); const int Rb = Epi::PERM ? ((R & ~31) + perm32(R & 31)) : R;
        voffA[i] = (unsigned)(R * g.lda + C) * 2u; voffB[i] = (unsigned)(Rb * g.ldb + C) * 2u; }
    const size_t kstep = (size_t)(BK * 2);
    const size_t hstepA = (size_t)HALF * g.lda * 2, hstepB = (size_t)HALF * g.ldb * 2;
    const size_t tstepA = 2 * hstepA, tstepB = 2 * hstepB;
    const unsigned ldsw = (unsigned)wid * 1024u;
    const int aoff = lds_byte(wr * 64 + fr, fq * 8), boff = lds_byte(wc * 32 + fr, fq * 8);
#define PG8_SA(b, h) (((b) * 2 + (h)) * HTB)
#define PG8_SB(b, h) ((4 + (b) * 2 + (h)) * HTB)
#define PG8_STAGE(bufoff, gbase, voff) do { _Pragma("unroll") for (int _i = 0; _i < 2; ++_i) \
        __builtin_amdgcn_global_load_lds((const unsigned*)((const char*)(gbase) + (voff)[_i]), (PG8_LAS unsigned*)(lds + (bufoff) + ldsw + _i * 8192), 16, 0, 0); } while (0)
#define PG8_LDA(dst, b, h) do { _Pragma("unroll") for (int m = 0; m < 4; ++m) _Pragma("unroll") for (int k = 0; k < 2; ++k) dst[m][k] = *(const PG8_LAS bf16x8*)(lds + PG8_SA(b, h) + aoff + m * 2048 + k * 1024); } while (0)
#define PG8_LDB(dst, b, h) do { _Pragma("unroll") for (int n = 0; n < 2; ++n) _Pragma("unroll") for (int k = 0; k < 2; ++k) dst[n][k] = *(const PG8_LAS bf16x8*)(lds + PG8_SB(b, h) + boff + n * 2048 + k * 1024); } while (0)
#define PG8_MMA(ai, bj, At, Bt) do { __builtin_amdgcn_s_setprio(1); _Pragma("unroll") for (int m = 0; m < 4; ++m) _Pragma("unroll") for (int n = 0; n < 2; ++n) _Pragma("unroll") for (int k = 0; k < 2; ++k) \
        acc[ai][bj][m][n] = __builtin_amdgcn_mfma_f32_16x16x32_bf16(Bt[n][k], At[m][k], acc[ai][bj][m][n], 0, 0, 0); __builtin_amdgcn_s_setprio(0); } while (0)
#define PG8_WAIT_V(n) asm volatile("s_waitcnt vmcnt(" #n ")" ::: "memory")
#define PG8_WAIT_L(n) asm volatile("s_waitcnt lgkmcnt(" #n ")" ::: "memory")
#define PG8_BAR __builtin_amdgcn_s_barrier()
#define PG8_SCHED __builtin_amdgcn_sched_barrier(0)
    Unit cur, nxt; int ui = 0;
    if (!S.next(0, cur)) return;
    f32x4 acc[2][2][4][2];
#pragma unroll
    for (int a = 0; a < 2; ++a)
#pragma unroll
        for (int b = 0; b < 2; ++b)
#pragma unroll
            for (int m = 0; m < 4; ++m)
#pragma unroll
                for (int n = 0; n < 2; ++n) acc[a][b][m][n] = (f32x4){0.f, 0.f, 0.f, 0.f};
    bf16x8 At[4][2], B0[2][2], B1[2][2];
    const char* cA = (const char*)g.A + (size_t)cur.pm * tstepA; const char* cB = (const char*)g.Bt + (size_t)cur.pn * tstepB;
    S.a_ready(cur);
    if constexpr (SP2) {
        PG8_STAGE(PG8_SB(0, 0), cB, voffB); PG8_STAGE(PG8_SB(0, 1), cB + hstepB, voffB); PG8_STAGE(PG8_SA(0, 0), cA, voffA); PG8_STAGE(PG8_SA(0, 1), cA + hstepA, voffA);
        if (wr == 1) PG8_BAR;
        PG8_WAIT_V(2); PG8_BAR;
        PG8_STAGE(PG8_SB(1, 0), cB + kstep, voffB); PG8_STAGE(PG8_SA(1, 0), cA + kstep, voffA); PG8_STAGE(PG8_SB(1, 1), cB + hstepB + kstep, voffB);
        PG8_WAIT_V(6); PG8_BAR;
    } else {
        PG8_STAGE(PG8_SB(0, 0), cB, voffB); PG8_STAGE(PG8_SA(0, 0), cA, voffA); PG8_STAGE(PG8_SB(0, 1), cB + hstepB, voffB); PG8_STAGE(PG8_SA(0, 1), cA + hstepA, voffA);
        if (wr == 1) PG8_BAR;
        PG8_WAIT_V(4); PG8_BAR;
        PG8_STAGE(PG8_SB(1, 0), cB + kstep, voffB); PG8_STAGE(PG8_SA(1, 0), cA + kstep, voffA); PG8_STAGE(PG8_SB(1, 1), cB + hstepB + kstep, voffB);
        PG8_WAIT_V(6); PG8_BAR;
    }
    for (;;) {
        const bool has_next = S.next(ui + 1, nxt);
        const char* nA = has_next ? (const char*)g.A + (size_t)nxt.pm * tstepA : cA; const char* nB = has_next ? (const char*)g.Bt + (size_t)nxt.pn * tstepB : cB;
        for (int t = 0; t < nt; t += 2) {
            const bool last = (t == nt - 2);
            const char* a1 = cA + (size_t)(t + 1) * kstep;
            const char* a2 = last ? nA : cA + (size_t)(t + 2) * kstep; const char* b2 = last ? nB : cB + (size_t)(t + 2) * kstep;
            const char* a3 = a2 + kstep; const char* b3 = b2 + kstep;
            if (last && has_next) S.a_ready(nxt);
            if constexpr (SP2) {
            PG8_LDB(B0, 0, 0); PG8_LDB(B1, 0, 1); PG8_SCHED; PG8_LDA(At, 0, 0); PG8_STAGE(PG8_SA(1, 1), a1 + hstepA, voffA);
            PG8_WAIT_V(8); PG8_WAIT_L(0); PG8_BAR; PG8_MMA(0, 0, At, B0); PG8_MMA(0, 1, At, B1); PG8_BAR; PG8_SCHED;
            PG8_LDA(At, 0, 1); PG8_STAGE(PG8_SB(0, 0), b2, voffB); PG8_STAGE(PG8_SB(0, 1), b2 + hstepB, voffB); PG8_STAGE(PG8_SA(0, 0), a2, voffA);
            PG8_WAIT_V(8); PG8_WAIT_L(0); PG8_BAR; PG8_MMA(1, 0, At, B0); PG8_MMA(1, 1, At, B1); PG8_BAR; PG8_SCHED;
            PG8_LDB(B0, 1, 0); PG8_LDB(B1, 1, 1); PG8_SCHED; PG8_LDA(At, 1, 0); PG8_STAGE(PG8_SA(0, 1), a2 + hstepA, voffA);
            PG8_WAIT_V(8); PG8_WAIT_L(0); PG8_BAR; PG8_MMA(0, 0, At, B0); PG8_MMA(0, 1, At, B1); PG8_BAR; PG8_SCHED;
            PG8_LDA(At, 1, 1); PG8_STAGE(PG8_SB(1, 0), b3, voffB); PG8_STAGE(PG8_SB(1, 1), b3 + hstepB, voffB); PG8_STAGE(PG8_SA(1, 0), a3, voffA);
            PG8_WAIT_V(8); PG8_WAIT_L(0); PG8_BAR; PG8_MMA(1, 0, At, B0); PG8_MMA(1, 1, At, B1); PG8_BAR; PG8_SCHED;
            } else {
            PG8_LDB(B0, 0, 0); PG8_SCHED; PG8_LDA(At, 0, 0); PG8_STAGE(PG8_SA(1, 1), a1 + hstepA, voffA);
            PG8_WAIT_L(8); PG8_BAR; PG8_WAIT_L(0); PG8_MMA(0, 0, At, B0); PG8_BAR; PG8_SCHED;
            PG8_LDB(B1, 0, 1); PG8_STAGE(PG8_SB(0, 0), b2, voffB);
            PG8_BAR; PG8_WAIT_L(0); PG8_MMA(0, 1, At, B1); PG8_BAR;
            PG8_LDA(At, 0, 1); PG8_STAGE(PG8_SA(0, 0), a2, voffA);
            PG8_BAR; PG8_WAIT_L(0); PG8_MMA(1, 0, At, B0); PG8_BAR; PG8_SCHED;
            PG8_STAGE(PG8_SB(0, 1), b2 + hstepB, voffB);
            PG8_WAIT_V(6); PG8_BAR; PG8_MMA(1, 1, At, B1); PG8_BAR;
            PG8_LDB(B0, 1, 0); PG8_SCHED; PG8_LDA(At, 1, 0); PG8_STAGE(PG8_SA(0, 1), a2 + hstepA, voffA);
            PG8_WAIT_L(8); PG8_BAR; PG8_WAIT_L(0); PG8_MMA(0, 0, At, B0); PG8_BAR; PG8_SCHED;
            PG8_LDB(B1, 1, 1); PG8_STAGE(PG8_SB(1, 0), b3, voffB);
            PG8_BAR; PG8_WAIT_L(0); PG8_MMA(0, 1, At, B1); PG8_BAR;
            PG8_LDA(At, 1, 1); PG8_STAGE(PG8_SA(1, 0), a3, voffA);
            PG8_BAR; PG8_WAIT_L(0); PG8_MMA(1, 0, At, B0); PG8_BAR; PG8_SCHED;
            PG8_STAGE(PG8_SB(1, 1), b3 + hstepB, voffB);
            PG8_WAIT_V(6); PG8_BAR; PG8_MMA(1, 1, At, B1); PG8_BAR;
            }
        }
        if constexpr (ALIGN_EPI) { if (wr == 0) PG8_BAR; }
        if constexpr (!Epi::AFTER_DRAIN) { E(acc, cur, wr, wc, fr, fq); S.done(cur); }
        if (!has_next) break;
#pragma unroll
        for (int a = 0; a < 2; ++a)
#pragma unroll
            for (int b = 0; b < 2; ++b)
#pragma unroll
                for (int m = 0; m < 4; ++m)
#pragma unroll
                    for (int n = 0; n < 2; ++n) acc[a][b][m][n] = (f32x4){0.f, 0.f, 0.f, 0.f};
        cur = nxt; cA = nA; cB = nB; ++ui;
        if constexpr (ALIGN_EPI) { if (wr == 1) PG8_BAR; }
    }
    PG8_WAIT_V(0);
    if constexpr (!ALIGN_EPI) { if (wr == 0) PG8_BAR; }
    PG8_BAR;
#undef PG8_SA
#undef PG8_SB
#undef PG8_STAGE
#undef PG8_LDA
#undef PG8_LDB
#undef PG8_MMA
#undef PG8_WAIT_V
#undef PG8_WAIT_L
#undef PG8_BAR
#undef PG8_SCHED
}
}

constexpr int NWAVES = 8;
constexpr size_t MiB = 1u << 20;
constexpr size_t WS_CTL = 0, CTL_ZERO_BYTES = 1 * MiB;
constexpr size_t WS_MOD = 1 * MiB;
constexpr size_t WS_MODP = 4 * MiB;
constexpr size_t WS_WIN = 8 * MiB;
constexpr size_t WS_WOUT = 26 * MiB;
constexpr size_t WS_WQ = 42 * MiB;
constexpr size_t WS_WPOOL = 58 * MiB;
constexpr size_t WS_SK = 59 * MiB;
constexpr size_t WS_U16 = 64 * MiB;
constexpr size_t WS_V16 = 192 * MiB;
constexpr size_t WS_H = 320 * MiB;
constexpr size_t WS_Z = 352 * MiB;
constexpr size_t WS_POOLED = 388 * MiB;
constexpr size_t WS_MIX = 404 * MiB;
constexpr size_t WS_X1 = 436 * MiB;
constexpr size_t WS_XA = 500 * MiB;
constexpr size_t WS_QP = 564 * MiB;
constexpr size_t WS_IDX = 596 * MiB;
constexpr size_t WS_GATE = 600 * MiB;
constexpr size_t WS_END = 604 * MiB;
constexpr int CW_BAR = 4096;
constexpr int RING_BYTES = 131072;
constexpr int LDS_BYTES = 147456;
constexpr int LDSCTL_OFF = LDS_BYTES - 512;

#define GAS __attribute__((address_space(1)))
#define LAS __attribute__((address_space(3)))
typedef unsigned short bf16;
typedef unsigned v4u __attribute__((ext_vector_type(4)));
typedef unsigned v2u __attribute__((ext_vector_type(2)));
typedef float f32x4 __attribute__((ext_vector_type(4)));
typedef float f32x16 __attribute__((ext_vector_type(16)));
typedef float f32x32 __attribute__((ext_vector_type(32)));
typedef unsigned u32x6 __attribute__((ext_vector_type(6)));
constexpr int EROW = 1536;
typedef short bf16x8 __attribute__((ext_vector_type(8)));
typedef short s16x4 __attribute__((ext_vector_type(4)));
typedef __bf16 bf16x2v __attribute__((ext_vector_type(2)));
typedef GAS unsigned gu32;
#define RLX_AGENT __ATOMIC_RELAXED, __HIP_MEMORY_SCOPE_AGENT
#define LDS_WAIT() asm volatile("s_waitcnt lgkmcnt(0)" ::: "memory")
__device__ __forceinline__ unsigned f2bf(float f) { unsigned u = __builtin_bit_cast(unsigned, f); return (u + 0x7fffu + ((u >> 16) & 1u)) >> 16; }
__device__ __forceinline__ unsigned pk2(float lo, float hi) { return f2bf(lo) | (f2bf(hi) << 16); }
__device__ __forceinline__ float bflo(unsigned w) { return __builtin_bit_cast(float, w << 16); }
__device__ __forceinline__ float bfhi(unsigned w) { return __builtin_bit_cast(float, w & 0xffff0000u); }
__device__ __forceinline__ float dot2(unsigned a, unsigned b, float acc) { return __builtin_amdgcn_fdot2_f32_bf16(__builtin_bit_cast(bf16x2v, a), __builtin_bit_cast(bf16x2v, b), acc, false); }
__device__ __forceinline__ float wave_sum(float v) {
#pragma unroll
    for (int o = 1; o < 64; o <<= 1) v += __shfl_xor(v, o);
    return v;
}
__device__ __forceinline__ float rdlane(float v, int l) { return __builtin_bit_cast(float, __builtin_amdgcn_readlane(__builtin_bit_cast(int, v), l)); }

#define XB_TMO      128
#define XB_XCNT(j)  (256  + 64 * (j))
#define XB_XSUB(j)  (1280 + 64 * (j))
#define XB_XGEN(j)  (2304 + 64 * (j))
#define XB_TOP      3328
#define XB_TOPGEN   3392
#define XCD_BAR_WORDS 3456
#define XB_SPIN_CAP (1u << 22)
__device__ __forceinline__ unsigned xb_ld(unsigned* p)              { return __hip_atomic_load(p, __ATOMIC_RELAXED, __HIP_MEMORY_SCOPE_AGENT); }
__device__ __forceinline__ unsigned xb_add(unsigned* p, unsigned v) { return __hip_atomic_fetch_add(p, v, __ATOMIC_RELAXED, __HIP_MEMORY_SCOPE_AGENT); }
__device__ __forceinline__ unsigned xb_xcc_id() { return (unsigned)__builtin_amdgcn_s_getreg((3 << 11) | 20) & 0xFu; }
#define XB_SPIN(cond, bar) do { unsigned _sp = 0; while (cond) { __builtin_amdgcn_s_sleep(1); \
    if ((++_sp & 255u) == 0u) { if (xb_ld(&(bar)[XB_TMO])) break; if (_sp > XB_SPIN_CAP) { atomicAdd(&(bar)[XB_TMO], 1u); break; } } } } while (0)
struct XcdBarrier { unsigned* bar; unsigned x; volatile LAS unsigned* st; };
__device__ __forceinline__ XcdBarrier xcd_barrier_post(unsigned* bar, volatile LAS unsigned* st) {
    XcdBarrier b; b.bar = bar; b.x = xb_xcc_id(); b.st = st;
    if (threadIdx.x == 0) (void)xb_add(&bar[XB_XCNT(b.x)], 1u);
    return b;
}
__device__ __forceinline__ void xcd_barrier_complete(unsigned* bar, unsigned x, unsigned& nloc, unsigned& nx) {
    const unsigned G = gridDim.x * gridDim.y * gridDim.z;
    unsigned sum, cnt, mine, sp = 0u;
    for (;;) {
        sum = 0u; cnt = 0u; mine = 0u;
#pragma unroll
        for (unsigned j = 0; j < 16; ++j) { const unsigned c = xb_ld(&bar[XB_XCNT(j)]); sum += c; cnt += (c > 0u) ? 1u : 0u; mine = (j == x) ? c : mine; }
        if (sum == G) break;
        __builtin_amdgcn_s_sleep(1);
        if ((++sp & 255u) == 0u) { if (xb_ld(&bar[XB_TMO])) break; if (sp > XB_SPIN_CAP) { atomicAdd(&bar[XB_TMO], 1u); break; } }
    }
    nloc = mine > 0u ? mine : 1u; nx = cnt > 0u ? cnt : 1u;
}
__device__ __forceinline__ void xcd_barrier(const XcdBarrier& b) {
    asm volatile("s_waitcnt vmcnt(0)" ::: "memory");
    __syncthreads();
    if (threadIdx.x == 0) {
        unsigned* bar = b.bar;
        __builtin_amdgcn_s_waitcnt(0);
        unsigned nloc = b.st[0], nx = b.st[1];
        if (nloc == 0u) { xcd_barrier_complete(bar, b.x, nloc, nx); b.st[0] = nloc; b.st[1] = nx; }
        const unsigned old = xb_add(&bar[XB_XSUB(b.x)], 1u);
        const unsigned gen = old / nloc;
        if (old + 1u == (gen + 1u) * nloc) {
            __builtin_amdgcn_fence(__ATOMIC_RELEASE, "agent");
            asm volatile("s_waitcnt vmcnt(0)" ::: "memory");
            const unsigned og = xb_add(&bar[XB_TOP], 1u);
            const unsigned tg = og / nx;
            if (og + 1u == (tg + 1u) * nx) xb_add(&bar[XB_TOPGEN], 1u);
            else XB_SPIN(xb_ld(&bar[XB_TOPGEN]) == tg, bar);
            __builtin_amdgcn_fence(__ATOMIC_ACQUIRE, "agent");
            xb_add(&bar[XB_XGEN(b.x)], 1u);
            asm volatile("s_waitcnt vmcnt(0)" ::: "memory");
        } else {
            XB_SPIN(xb_ld(&bar[XB_XGEN(b.x)]) == gen, bar);
            __builtin_amdgcn_fence(__ATOMIC_ACQUIRE, "agent");
            asm volatile("s_waitcnt vmcnt(0)" ::: "memory");
        }
    }
    __syncthreads();
}

struct Args { const float* in[18]; float* out; unsigned char* ws; int ph_lo, ph_hi, coop, pad; };
struct Frame {
    LAS unsigned char* lds;
    int tid, lane, wave, vcu, G;
    const Args* A;
    unsigned char* ws;
};
#define F_IN(k) (F.A->in[k])
#define F_x F_IN(0)
#define F_c F_IN(1)
#define F_rel_bias F_IN(2)
#define F_ada_w F_IN(3)
#define F_ada_b F_IN(4)
#define F_norm1_gain F_IN(5)
#define F_w_in F_IN(6)
#define F_q_gain F_IN(7)
#define F_k_gain F_IN(8)
#define F_sinks F_IN(9)
#define F_w_pool F_IN(10)
#define F_pool_scale F_IN(11)
#define F_w_out F_IN(12)
#define F_norm2_gain F_IN(13)
#define F_w_query F_IN(14)
#define F_sub_keys F_IN(15)
#define F_peer_u F_IN(16)
#define F_peer_v F_IN(17)
#define F_out (F.A->out)
#define F_MOD ((float*)(F.ws + WS_MOD))
#define F_MODP ((float*)(F.ws + WS_MODP))
#define F_X1 ((float*)(F.ws + WS_X1))
#define F_XA ((float*)(F.ws + WS_XA))
#define F_GATE ((float*)(F.ws + WS_GATE))
#define F_WIN ((bf16*)(F.ws + WS_WIN))
#define F_WOUT ((bf16*)(F.ws + WS_WOUT))
#define F_WQ ((bf16*)(F.ws + WS_WQ))
#define F_WPOOL ((bf16*)(F.ws + WS_WPOOL))
#define F_SK ((bf16*)(F.ws + WS_SK))
#define F_U8 ((unsigned char*)(F.ws + WS_U16))
#define F_V8 ((unsigned char*)(F.ws + WS_V16))
#define F_H ((bf16*)(F.ws + WS_H))
#define F_Z ((bf16*)(F.ws + WS_Z))
#define F_POOLED ((bf16*)(F.ws + WS_POOLED))
#define F_MIX ((bf16*)(F.ws + WS_MIX))
#define F_QP ((bf16*)(F.ws + WS_QP))
#define F_IDX ((int*)(F.ws + WS_IDX))

__device__ __forceinline__ void p0_transpose_item(const float* W, int N, bf16* WT, int ldo, LAS float* scr, int item, int lane) {
    const int nblk = N / 32, kb = item / nblk, nb = item % nblk, k0 = 64 * kb, n0 = 32 * nb;
#pragma unroll 8
    for (int i = 0; i < 32; ++i) { const int kk = 2 * i + (lane >> 5); scr[kk * 33 + (lane & 31)] = W[(size_t)(k0 + kk) * N + n0 + (lane & 31)]; }
    LDS_WAIT(); asm volatile("" ::: "memory");
    const int c = lane & 7;
#pragma unroll
    for (int j = 0; j < 4; ++j) { const int n = (lane >> 3) + 8 * j; const LAS float* s = scr + (8 * c) * 33 + n;
        v4u o; o.x = pk2(s[0 * 33], s[1 * 33]); o.y = pk2(s[2 * 33], s[3 * 33]); o.z = pk2(s[4 * 33], s[5 * 33]); o.w = pk2(s[6 * 33], s[7 * 33]);
        *(GAS v4u*)(WT + (size_t)(n0 + n) * ldo + k0 + 8 * c) = o; }
    LDS_WAIT(); asm volatile("" ::: "memory");
}
__device__ __forceinline__ float silu_f(float v) { return v / (1.f + __expf(-v)); }

__device__ __forceinline__ void p0_prologue(Frame& F) {
    LAS float* scr = (LAS float*)(F.lds + F.wave * 16384);
    const int gw = F.vcu * NWAVES + F.wave, NGW = F.G * NWAVES, lane = F.lane;
    for (int it = gw; it < 2 * 48 * 16; it += NGW) {
        const int l = it / 768, r = it % 768, cgp = r / 16, kc = r % 16;
        const float* W = F_ada_w + (size_t)l * D * MODW + (size_t)(kc * 128) * MODW + cgp * 256 + lane * 4;
        const float c0a = silu_f(F_c[kc * 128 + lane]), c0b = silu_f(F_c[kc * 128 + 64 + lane]);
        const float c1a = silu_f(F_c[D + kc * 128 + lane]), c1b = silu_f(F_c[D + kc * 128 + 64 + lane]);
        f32x4 a0 = {0.f, 0.f, 0.f, 0.f}, a1 = {0.f, 0.f, 0.f, 0.f};
#pragma unroll 8
        for (int kk = 0; kk < 64; ++kk) { const f32x4 w = *(const GAS f32x4*)(W + (size_t)kk * MODW); const float s0 = rdlane(c0a, kk), s1 = rdlane(c1a, kk); a0 += w * s0; a1 += w * s1; }
#pragma unroll 8
        for (int kk = 0; kk < 64; ++kk) { const f32x4 w = *(const GAS f32x4*)(W + (size_t)(64 + kk) * MODW); const float s0 = rdlane(c0b, kk), s1 = rdlane(c1b, kk); a0 += w * s0; a1 += w * s1; }
        float* P = F_MODP + (size_t)kc * (2 * 2 * MODW) + (size_t)(l * 2) * MODW + cgp * 256 + lane * 4;
        *(GAS f32x4*)P = a0; *(GAS f32x4*)(P + MODW) = a1;
    }
    constexpr int I_IN = 32 * 72, I_OUT = 32 * 64, I_Q = 32 * 64, I_P = 4 * 32, I_L = I_IN + I_OUT + I_Q + I_P;
    for (int it = gw; it < 2 * I_L; it += NGW) {
        const int l = it / I_L; int r = it % I_L;
        if (r < I_IN) { p0_transpose_item(F_w_in + (size_t)l * D * DIN, DIN, F_WIN + (size_t)l * DIN * D, D, scr, r, lane); continue; } r -= I_IN;
        if (r < I_OUT) { p0_transpose_item(F_w_out + (size_t)l * D * D, D, F_WOUT + (size_t)l * D * D, D, scr, r, lane); continue; } r -= I_OUT;
        if (r < I_Q) { p0_transpose_item(F_w_query + (size_t)l * D * D, D, F_WQ + (size_t)l * D * D, D, scr, r, lane); continue; } r -= I_Q;
        { const int g = r / 32, rr = r % 32; p0_transpose_item(F_w_pool + (size_t)(l * 4 + g) * 65536, 256, F_WPOOL + (size_t)(l * 4 + g) * 65536, 256, scr, rr, lane); }
    }
    {
        constexpr long NCH_SK = 65536 / 512;
        for (long ch = gw; ch < NCH_SK; ch += NGW) {
            {
                const float* src = F_sub_keys; bf16* dst = F_SK; const long o = ch;
                const f32x4 v0 = *(const GAS f32x4*)(src + o * 512 + lane * 4), v1 = *(const GAS f32x4*)(src + o * 512 + 256 + lane * 4);
                v2u w0, w1; w0.x = pk2(v0[0], v0[1]); w0.y = pk2(v0[2], v0[3]); w1.x = pk2(v1[0], v1[1]); w1.y = pk2(v1[2], v1[3]);
                *(GAS v2u*)(dst + o * 512 + lane * 4) = w0; *(GAS v2u*)(dst + o * 512 + 256 + lane * 4) = w1;
            }
        }
        for (int row = gw; row < 2 * 2 * NEXP; row += NGW) {
            const bool isu = row < 2 * NEXP; const int rr = isu ? row : row - 2 * NEXP;
            const float* src = (isu ? F_peer_u : F_peer_v) + (size_t)rr * D; unsigned char* dst = (isu ? F_U8 : F_V8) + (size_t)rr * EROW; const float sc = isu ? 64.f : 1.5f;
            f32x16 a, bq;
#pragma unroll
            for (int q = 0; q < 8; ++q) { const f32x4 v0 = *(const GAS f32x4*)(src + 4 * lane + 256 * q) * sc;
                a[2 * q] = v0[0]; bq[2 * q] = v0[1]; a[2 * q + 1] = v0[2]; bq[2 * q + 1] = v0[3]; }
            const u32x6 p = __builtin_amdgcn_cvt_scalef32_2xpk16_fp6_f32(a, bq, 1.0f);
            v4u w0; w0.x = p[0]; w0.y = p[1]; w0.z = p[2]; w0.w = p[3]; v2u w1; w1.x = p[4]; w1.y = p[5];
            *(GAS v4u*)(dst + 16 * lane) = w0; *(GAS v2u*)(dst + 1024 + 8 * lane) = w1;
        }
    }
}

__device__ __forceinline__ f32x4 mod_reduce4(Frame& F, int i) {
    const int col = i % MODW, l = i / (2 * MODW);
    f32x4 a = *(const GAS f32x4*)(F_ada_b + (size_t)l * MODW + col);
#pragma unroll 4
    for (int kc = 0; kc < 16; ++kc) a += *(const GAS f32x4*)(F_MODP + (size_t)kc * (4 * MODW) + i);
    return a;
}

__device__ __forceinline__ void norm_rows(const float* xin, bf16* hout, int r0, int nrows, const f32x4 (&av)[8], const f32x4 (&sv)[8], int lane) {
    for (int r = r0; r < r0 + nrows; ++r) {
        const GAS f32x4* xr = (const GAS f32x4*)(xin + (size_t)r * D) + lane;
        f32x4 v[8]; float ss = 0.f;
#pragma unroll
        for (int j = 0; j < 8; ++j) { v[j] = xr[64 * j]; ss += (v[j][0] * v[j][0] + v[j][1] * v[j][1]) + (v[j][2] * v[j][2] + v[j][3] * v[j][3]); }
        const float rstd = 1.f / sqrtf(wave_sum(ss) * (1.f / D) + EPS);
        GAS v2u* o = (GAS v2u*)(hout + (size_t)r * D) + lane;
#pragma unroll
        for (int j = 0; j < 8; ++j) { const f32x4 y = v[j] * rstd * av[j] + sv[j]; v2u w; w.x = pk2(y[0], y[1]); w.y = pk2(y[2], y[3]); o[64 * j] = w; }
    }
}

__device__ __forceinline__ void p1_mod_norm1(Frame& F) {
    const int gw = F.vcu * NWAVES + F.wave, lane = F.lane;
    if (gw < 192) { const int i = gw * 256 + lane * 4; *(GAS f32x4*)(F_MOD + i) = mod_reduce4(F, i); }
    const int r0 = gw * 4, b = r0 / SEQ;
    f32x4 av[8], sv[8];
#pragma unroll
    for (int j = 0; j < 8; ++j) { const int col = 4 * lane + 256 * j;
        const f32x4 sh = mod_reduce4(F, (0 * 2 + b) * MODW + 0 * D + col), sc = mod_reduce4(F, (0 * 2 + b) * MODW + 1 * D + col);
        const f32x4 g = *(const GAS f32x4*)(F_norm1_gain + col);
        av[j] = g * (sc + 1.f); sv[j] = sh; asm volatile("" ::: "memory"); }
    norm_rows(F_x, F_H, r0, 4, av, sv, lane);
}

__device__ __forceinline__ void p_norm2(Frame& F, int l) {
    const int gw = F.vcu * NWAVES + F.wave, lane = F.lane;
    const int r0 = gw * 4, b = r0 / SEQ;
    const float* mod = F_MOD + (size_t)(l * 2 + b) * MODW;
    f32x4 av[8], sv[8];
#pragma unroll
    for (int j = 0; j < 8; ++j) { const int col = 4 * lane + 256 * j;
        const f32x4 sh = *(const GAS f32x4*)(mod + 3 * D + col), sc = *(const GAS f32x4*)(mod + 4 * D + col);
        const f32x4 g = *(const GAS f32x4*)(F_norm2_gain + (size_t)l * D + col);
        av[j] = g * (sc + 1.f); sv[j] = sh; }
    norm_rows(F_X1, F_H, r0, 4, av, sv, lane);
}

__device__ __forceinline__ int t5_bucket(int rel) {
    const int n = rel < 0 ? -rel : rel; int ret = rel > 0 ? 16 : 0;
    int large = 8 + (n >= 12) + (n >= 16) + (n >= 23) + (n >= 32) + (n >= 46) + (n >= 64) + (n >= 91);
    return ret + (n < 8 ? n : large);
}
constexpr int KS_STRIDE = 72, VT_STRIDE = 196;
constexpr int ATT_KS = 0, ATT_VT = 27648, ATT_QS = 53248, ATT_TBL = ATT_QS + 8 * 9216;
static_assert(ATT_TBL + 8 * 1024 <= LDSCTL_OFF, "attention LDS map");

__device__ __forceinline__ void attn_item(Frame& F, int l, int item) {
    const int g = item & 1, n = (item >> 1) & 63, b = item >> 7;
    const int tok0 = b * SEQ + n * 64, key0 = tok0 - 128, lane = F.lane, wave = F.wave, tid = F.tid;
    LAS bf16* Ks = (LAS bf16*)(F.lds + ATT_KS); LAS bf16* Vt = (LAS bf16*)(F.lds + ATT_VT);
    LAS bf16* Qs = (LAS bf16*)(F.lds + ATT_QS + wave * 9216); LAS float* tbl = (LAS float*)(F.lds + ATT_TBL + wave * 1024);
    const int hq = g * 8 + wave;
    {
        const int c = tid & 7;
        const f32x4 kg0 = *(const GAS f32x4*)(F_k_gain + l * HD + 8 * c), kg1 = *(const GAS f32x4*)(F_k_gain + l * HD + 8 * c + 4);
#pragma unroll
        for (int i = 0; i < 3; ++i) {
            const int row = (tid >> 3) + 64 * i; int tk = key0 + row; if (tk < b * SEQ) tk = b * SEQ;
            const bf16* zr = F_Z + (size_t)tk * DIN;
            const v4u kw = *(const GAS v4u*)(zr + 2048 + g * 64 + 8 * c), vw = *(const GAS v4u*)(zr + 2176 + g * 64 + 8 * c);
            float kf[8] = {bflo(kw.x), bfhi(kw.x), bflo(kw.y), bfhi(kw.y), bflo(kw.z), bfhi(kw.z), bflo(kw.w), bfhi(kw.w)};
            float ss = 0.f;
#pragma unroll
            for (int j = 0; j < 8; ++j) ss += kf[j] * kf[j];
            ss += __shfl_xor(ss, 1); ss += __shfl_xor(ss, 2); ss += __shfl_xor(ss, 4);
            const float rstd = 1.f / sqrtf(ss * (1.f / HD) + EPS);
            v4u o; o.x = pk2(kf[0] * rstd * kg0[0], kf[1] * rstd * kg0[1]); o.y = pk2(kf[2] * rstd * kg0[2], kf[3] * rstd * kg0[3]);
            o.z = pk2(kf[4] * rstd * kg1[0], kf[5] * rstd * kg1[1]); o.w = pk2(kf[6] * rstd * kg1[2], kf[7] * rstd * kg1[3]);
            *(LAS v4u*)(Ks + row * KS_STRIDE + 8 * c) = o;
            const unsigned vv[4] = {vw.x, vw.y, vw.z, vw.w};
#pragma unroll
            for (int j = 0; j < 4; ++j) { Vt[(8 * c + 2 * j) * VT_STRIDE + row] = (bf16)(vv[j] & 0xffffu); Vt[(8 * c + 2 * j + 1) * VT_STRIDE + row] = (bf16)(vv[j] >> 16); }
        }
    }
    {
        const int c = lane & 7;
        const f32x4 qg0 = *(const GAS f32x4*)(F_q_gain + l * HD + 8 * c), qg1 = *(const GAS f32x4*)(F_q_gain + l * HD + 8 * c + 4);
#pragma unroll
        for (int i = 0; i < 8; ++i) {
            const int row = (lane >> 3) + 8 * i;
            const v4u qw = *(const GAS v4u*)(F_Z + (size_t)(tok0 + row) * DIN + 1024 + hq * 64 + 8 * c);
            float qf[8] = {bflo(qw.x), bfhi(qw.x), bflo(qw.y), bfhi(qw.y), bflo(qw.z), bfhi(qw.z), bflo(qw.w), bfhi(qw.w)};
            float ss = 0.f;
#pragma unroll
            for (int j = 0; j < 8; ++j) ss += qf[j] * qf[j];
            ss += __shfl_xor(ss, 1); ss += __shfl_xor(ss, 2); ss += __shfl_xor(ss, 4);
            const float rstd = 0.125f / sqrtf(ss * (1.f / HD) + EPS);
            v4u o; o.x = pk2(qf[0] * rstd * qg0[0], qf[1] * rstd * qg0[1]); o.y = pk2(qf[2] * rstd * qg0[2], qf[3] * rstd * qg0[3]);
            o.z = pk2(qf[4] * rstd * qg1[0], qf[5] * rstd * qg1[1]); o.w = pk2(qf[6] * rstd * qg1[2], qf[7] * rstd * qg1[3]);
            *(LAS v4u*)(Qs + row * KS_STRIDE + 8 * c) = o;
        }
#pragma unroll
        for (int i = 0; i < 4; ++i) { const int e = lane + 64 * i; if (e < 255) tbl[e] = F_rel_bias[t5_bucket(e - 191) * NQH + hq]; }
    }
    __syncthreads();
    const int r = lane & 31, h = lane >> 5;
    const int kt0 = n == 0 ? 4 : (n == 1 ? 2 : 0);
    const int dbg = F.A->pad;
    const float sink = (dbg == 0) ? F_sinks[l * NQH + hq] : -INFINITY;
    const float m0 = (dbg == 0) ? sink : -1e30f;
#pragma unroll 1
    for (int qt = 0; qt < 2; ++qt) {
        bf16x8 qf[4];
#pragma unroll
        for (int s = 0; s < 4; ++s) qf[s] = *(const LAS bf16x8*)(Qs + (32 * qt + r) * KS_STRIDE + 16 * s + 8 * h);
        f32x16 acc[6];
#pragma unroll
        for (int kt = 0; kt < 6; ++kt) {
#pragma unroll
            for (int i = 0; i < 16; ++i) acc[kt][i] = 0.f;
#pragma unroll
            for (int s = 0; s < 4; ++s) { const bf16x8 a = *(const LAS bf16x8*)(Ks + (32 * kt + r) * KS_STRIDE + 16 * s + 8 * h);
                acc[kt] = __builtin_amdgcn_mfma_f32_32x32x16_bf16(a, qf[s], acc[kt], 0, 0, 0); }
            asm volatile("" ::: "memory");
        }
        const int a = 32 * qt + r; float m = m0;
#pragma unroll
        for (int kt = 0; kt < 6; ++kt) {
#pragma unroll
            for (int i = 0; i < 16; ++i) { const int bk = 32 * kt + (i & 3) + 8 * (i >> 2) + 4 * h; float s = (dbg == 1 ? 0.f : acc[kt][i]) + ((dbg == 0 || dbg == 3) ? tbl[bk - a + 63] : 0.f); if (kt < kt0) s = -INFINITY; acc[kt][i] = s; m = fmaxf(m, s); }
            asm volatile("" ::: "memory");
        }
        m = fmaxf(m, __shfl_xor(m, 32));
        float sum = 0.f;
#pragma unroll
        for (int kt = 0; kt < 6; ++kt)
#pragma unroll
            for (int i = 0; i < 16; ++i) { const float p = __expf(acc[kt][i] - m); acc[kt][i] = p; sum += p; }
        sum += __shfl_xor(sum, 32); sum += __expf(sink - m);
        const float inv = 1.f / sum;
        f32x16 o[2];
#pragma unroll
        for (int dt = 0; dt < 2; ++dt) {
#pragma unroll
            for (int i = 0; i < 16; ++i) o[dt][i] = 0.f;
        }
#pragma unroll
        for (int kt = 0; kt < 6; ++kt)
#pragma unroll
            for (int s2 = 0; s2 < 2; ++s2) {
                v4u pw; pw.x = pk2(acc[kt][8 * s2 + 0], acc[kt][8 * s2 + 1]); pw.y = pk2(acc[kt][8 * s2 + 2], acc[kt][8 * s2 + 3]);
                pw.z = pk2(acc[kt][8 * s2 + 4], acc[kt][8 * s2 + 5]); pw.w = pk2(acc[kt][8 * s2 + 6], acc[kt][8 * s2 + 7]);
                const bf16x8 pb = __builtin_bit_cast(bf16x8, pw);
#pragma unroll
                for (int dt = 0; dt < 2; ++dt) {
                    const LAS bf16* vp = Vt + (32 * dt + r) * VT_STRIDE + 32 * kt + 16 * s2 + 4 * h;
                    const v2u lo = *(const LAS v2u*)vp, hi = *(const LAS v2u*)(vp + 8);
                    v4u aw; aw.x = lo.x; aw.y = lo.y; aw.z = hi.x; aw.w = hi.y;
                    o[dt] = __builtin_amdgcn_mfma_f32_32x32x16_bf16(__builtin_bit_cast(bf16x8, aw), pb, o[dt], 0, 0, 0);
                }
                asm volatile("" ::: "memory");
            }
        bf16* orow = F_MIX + (size_t)(tok0 + a) * D + 1024 + hq * 64;
#pragma unroll
        for (int dt = 0; dt < 2; ++dt)
#pragma unroll
            for (int q4 = 0; q4 < 4; ++q4) { v2u w; w.x = pk2(o[dt][4 * q4] * inv, o[dt][4 * q4 + 1] * inv); w.y = pk2(o[dt][4 * q4 + 2] * inv, o[dt][4 * q4 + 3] * inv);
                *(GAS v2u*)(orow + 32 * dt + 8 * q4 + 4 * h) = w; }
    }
    __syncthreads();
}

__device__ __forceinline__ void pool_item(Frame& F, int item) {
    const int g = item & 3, tt = (item >> 2) & 255, b = item >> 10, lane = F.lane;
    const int w = 2 << g, t0 = tt * 16;
    const bf16* zb = F_Z + (size_t)(b * SEQ) * DIN + 256 * g + 4 * lane;
    f32x4 S = {0.f, 0.f, 0.f, 0.f};
    for (int j = 1; j <= w; ++j) { const int t = t0 - j; if (t >= 0) { const v2u pw = *(const GAS v2u*)(zb + (size_t)t * DIN); S += (f32x4){bflo(pw.x), bfhi(pw.x), bflo(pw.y), bfhi(pw.y)}; } }
#pragma unroll 4
    for (int t = t0; t < t0 + 16; ++t) {
        const v2u pw = *(const GAS v2u*)(zb + (size_t)t * DIN); const f32x4 pt = {bflo(pw.x), bfhi(pw.x), bflo(pw.y), bfhi(pw.y)};
        S += pt;
        if (t - w >= 0) { const v2u qw = *(const GAS v2u*)(zb + (size_t)(t - w) * DIN); S -= (f32x4){bflo(qw.x), bfhi(qw.x), bflo(qw.y), bfhi(qw.y)}; }
        const float ic = 1.f / (float)((t + 1) < w ? (t + 1) : w);
        const f32x4 y = S * ic - pt;
        v2u o; o.x = pk2(y[0], y[1]); o.y = pk2(y[2], y[3]);
        *(GAS v2u*)(F_POOLED + (size_t)(b * SEQ + t) * DPOOL + 256 * g + 4 * lane) = o;
    }
}

constexpr int SK_STRIDE = 136;
constexpr int TK_SK = 0, TK_TAB = 2 * 128 * SK_STRIDE * 2;
__device__ __forceinline__ int ford(float x) { const int b = __builtin_bit_cast(int, x); return b ^ ((b >> 31) & 0x7fffffff); }
__device__ __forceinline__ float fdeord(int k) { return __builtin_bit_cast(float, k ^ ((k >> 31) & 0x7fffffff)); }
template <int CTRL> __device__ __forceinline__ int dppi(int v) { return __builtin_amdgcn_update_dpp(v, v, CTRL, 0xf, 0xf, false); }
__device__ __forceinline__ int row_allmax(int v) {
    v = max(v, dppi<0x128>(v)); v = max(v, dppi<0x124>(v)); v = max(v, dppi<0x122>(v)); v = max(v, dppi<0x121>(v)); return v;
}
__device__ __forceinline__ float row_allsum(float v) {
    v += __builtin_bit_cast(float, dppi<0x128>(__builtin_bit_cast(int, v))); v += __builtin_bit_cast(float, dppi<0x124>(__builtin_bit_cast(int, v)));
    v += __builtin_bit_cast(float, dppi<0x122>(__builtin_bit_cast(int, v))); v += __builtin_bit_cast(float, dppi<0x121>(__builtin_bit_cast(int, v))); return v;
}
__device__ __forceinline__ int bperm(int srclane, int v) { return __builtin_amdgcn_ds_bpermute(srclane << 2, v); }

__device__ __forceinline__ void p_topk(Frame& F, int l) {
    const int gw = F.vcu * NWAVES + F.wave, NGW = F.G * NWAVES, lane = F.lane, tid = F.tid;
    LAS bf16* SKs = (LAS bf16*)(F.lds + TK_SK); LAS unsigned char* tab = F.lds + TK_TAB;
    {
        const bf16* src = F_SK + (size_t)l * 32768;
#pragma unroll
        for (int i = 0; i < 8; ++i) { const int ch = tid + 512 * i; const int row = ch >> 4, c = ch & 15;
            *(LAS v4u*)(SKs + row * SK_STRIDE + 8 * c) = *(const GAS v4u*)(src + row * 128 + 8 * c); }
        if (tid == 0) { int s = 0; for (int a = 0; a < 16; ++a) for (int bb = 0; bb < 16; ++bb) if ((a + 1) * (bb + 1) <= 16) { tab[s] = (unsigned char)a; tab[64 + s] = (unsigned char)bb; ++s; }
            for (; s < 64; ++s) { tab[s] = 255; tab[64 + s] = 255; } }
    }
    __syncthreads();
    const int r = lane & 15, q4 = lane >> 4, rowbase = lane & ~15;
    int ca[4], cb[4];
#pragma unroll
    for (int j = 0; j < 4; ++j) { ca[j] = tab[4 * r + j]; cb[j] = tab[64 + 4 * r + j]; }
    for (int unit = gw; unit < T / 2; unit += NGW) {
        const int t0 = 2 * unit;
        const bf16* qrow = F_QP + (size_t)(t0 + (r >> 3)) * D + (r & 7) * 256 + 8 * q4;
        int res[2][4];
#pragma unroll
        for (int p = 0; p < 2; ++p) {
            f32x4 acc[8];
#pragma unroll
            for (int nt = 0; nt < 8; ++nt) acc[nt] = (f32x4){0.f, 0.f, 0.f, 0.f};
#pragma unroll 1
            for (int ks = 0; ks < 4; ++ks) { const bf16x8 a = *(const GAS bf16x8*)(qrow + p * 128 + 32 * ks);
#pragma unroll
                for (int nt = 0; nt < 8; ++nt) { const bf16x8 bq = *(const LAS bf16x8*)(SKs + (p * 128 + 16 * nt + r) * SK_STRIDE + 32 * ks + 8 * q4);
                    acc[nt] = __builtin_amdgcn_mfma_f32_16x16x32_bf16(a, bq, acc[nt], 0, 0, 0); } }
#pragma unroll
            for (int i = 0; i < 4; ++i) {
                int key[8];
#pragma unroll
                for (int nt = 0; nt < 8; ++nt) key[nt] = (ford(acc[nt][i]) & ~127) | (127 - (16 * nt + r));
                int mine = 0;
#pragma unroll 1
                for (int rd = 0; rd < 16; ++rd) {
                    int m = max(max(max(key[0], key[1]), max(key[2], key[3])), max(max(key[4], key[5]), max(key[6], key[7])));
                    m = row_allmax(m);
                    if (r == rd) mine = m;
#pragma unroll
                    for (int nt = 0; nt < 8; ++nt) key[nt] = (key[nt] == m) ? (int)0x80000000 : key[nt];
                }
                res[p][i] = mine;
            }
        }
#pragma unroll
        for (int i = 0; i < 4; ++i) {
            const int k1 = res[0][i], k2 = res[1][i];
            int ck[4];
#pragma unroll
            for (int j = 0; j < 4; ++j) {
                const int va = bperm(rowbase + (ca[j] & 15), k1), vb = bperm(rowbase + (cb[j] & 15), k2);
                const float s = fdeord(va & ~127) + fdeord(vb & ~127);
                ck[j] = (ca[j] == 255) ? (int)0x80000000 : ((ford(s) & ~63) | (63 - (4 * r + j)));
            }
            int mine = 0;
#pragma unroll 1
            for (int rd = 0; rd < 16; ++rd) {
                int m = max(max(ck[0], ck[1]), max(ck[2], ck[3]));
                m = row_allmax(m);
                if (r == rd) mine = m;
#pragma unroll
                for (int j = 0; j < 4; ++j) ck[j] = (ck[j] == m) ? (int)0x80000000 : ck[j];
            }
            const int slot = 63 - (mine & 63);
            const int a = tab[slot], bb = tab[64 + slot];
            const int va = bperm(rowbase + a, k1), vb = bperm(rowbase + bb, k2);
            const float s = fdeord(va & ~127) + fdeord(vb & ~127);
            const int eidx = (127 - (va & 127)) * 128 + (127 - (vb & 127));
            const float smax = __builtin_bit_cast(float, bperm(rowbase, __builtin_bit_cast(int, s)));
            const float e = __expf(s - smax);
            const float gate = e / row_allsum(e);
            const int row = 4 * q4 + i, tok = t0 + (row >> 3), hh = row & 7;
            F_IDX[(size_t)tok * 128 + hh * 16 + r] = eidx;
            F_GATE[(size_t)tok * 128 + hh * 16 + r] = gate;
        }
    }
}

__device__ __forceinline__ float gelu_exact(float v) { return 0.5f * v * (1.f + erff(v * 0.70710678118654752f)); }

typedef float f32x2 __attribute__((ext_vector_type(2)));
__device__ __forceinline__ f32x2 fp8lo(unsigned w) { return __builtin_amdgcn_cvt_pk_f32_fp8((int)w, false); }
__device__ __forceinline__ f32x2 fp8hi(unsigned w) { return __builtin_amdgcn_cvt_pk_f32_fp8((int)w, true); }

template <int NR>
__device__ __forceinline__ void bitonic_sort(int (&key)[NR], int lane) {
#pragma unroll
    for (int k = 2; k <= NR * 64; k <<= 1) {
#pragma unroll
        for (int j = k >> 1; j > 0; j >>= 1) {
            if (j >= 64) {
                const int jr = j >> 6;
#pragma unroll
                for (int r = 0; r < NR; ++r) if ((r & jr) == 0) {
                    const bool asc = (((r * 64) & k) == 0);
                    const int a = key[r], b = key[r | jr]; const int lo = min(a, b), hi = max(a, b);
                    key[r] = asc ? lo : hi; key[r | jr] = asc ? hi : lo;
                }
            } else {
#pragma unroll
                for (int r = 0; r < NR; ++r) {
                    const bool asc = (((r * 64 + lane) & k) == 0), lower = ((lane & j) == 0);
                    const int other = __shfl_xor(key[r], j);
                    key[r] = (asc == lower) ? min(key[r], other) : max(key[r], other);
                }
            }
        }
    }
}

constexpr int PEER_LDS_PER_WAVE = 8448 + 2048 + 2048;
#ifndef PEER_NT
#define PEER_NT 2
#endif
#ifndef PEER_SYNC
#define PEER_SYNC 0
#endif
#ifndef PEER_RDU
#define PEER_RDU 8
#endif
#ifndef PEER_RDV
#define PEER_RDV 8
#endif
#define PEER_SWITCH(tj, M) do { if (NT == 1) { M(0) } else if (NT == 2) { if ((tj) == 0) { M(0) } else { M(NT > 1 ? 1 : 0) } } \
    else { switch (tj) { case 0: M(0) break; case 1: M(NT > 1 ? 1 : 0) break; case 2: M(NT > 2 ? 2 : 0) break; default: M(NT > 3 ? 3 : 0) break; } } } while (0)
__device__ __forceinline__ void p_peer(Frame& F, int l, const XcdBarrier& bar, bool use_bar) {
    constexpr int NT = PEER_NT, NR = NT * 2;
    const int gw = F.vcu * NWAVES + F.wave, lane = F.lane;
    LAS float* sc = (LAS float*)(F.lds + F.wave * PEER_LDS_PER_WAVE);
    LAS int* keysL = (LAS int*)(F.lds + F.wave * PEER_LDS_PER_WAVE + 8448);
    LAS float* actL = (LAS float*)(F.lds + F.wave * PEER_LDS_PER_WAVE + 8448 + 2048);
    const unsigned char* U = F_U8 + (size_t)l * NEXP * EROW; const unsigned char* V = F_V8 + (size_t)l * NEXP * EROW;
    const float* xin = F_X1; float* xout = (l == 0) ? F_XA : F_out;
#pragma unroll 1
    for (int pass = 0; pass < 4 / NT; ++pass) {
    const int t0 = gw * 4 + pass * NT, b = t0 / SEQ;
    {
        int key[NR];
#pragma unroll
        for (int j = 0; j < NR; ++j) key[j] = (F_IDX[(size_t)(t0 + (j >> 1)) * 128 + (j & 1) * 64 + lane] << 9) | (j * 64 + lane);
        bitonic_sort<NR>(key, lane);
#pragma unroll
        for (int j = 0; j < NR; ++j) keysL[j * 64 + lane] = key[j];
    }
    LDS_WAIT(); asm volatile("" ::: "memory");
#define PEER_ROWLOAD(TAB, kk, d) do { const unsigned char* _rp = (TAB) + (size_t)((kk) >> 9) * EROW; Ra[d] = *(const GAS v4u*)(_rp + 16 * lane); Rb[d] = *(const GAS v2u*)(_rp + 1024 + 8 * lane); } while (0)
#define PEER_DECODE(d) const u32x6 _pk = {Ra[d].x, Ra[d].y, Ra[d].z, Ra[d].w, Rb[d].x, Rb[d].y}; const f32x32 rr = __builtin_amdgcn_cvt_scalef32_pk32_f32_fp6(_pk, 1.0f)
    if (use_bar && PEER_SYNC && pass > 0) xcd_barrier(bar);
    {
        constexpr int RD = PEER_RDU, NLB = 64 / RD, LBR = 32 / RD;
        f32x2 hv[NT][16];
#pragma unroll
        for (int tj = 0; tj < NT; ++tj)
#pragma unroll
            for (int q = 0; q < 8; ++q) { const v2u w = *(const GAS v2u*)(F_H + (size_t)(t0 + tj) * D + 4 * lane + 256 * q);
                hv[tj][2 * q] = (f32x2){bflo(w.x), bfhi(w.x)}; hv[tj][2 * q + 1] = (f32x2){bflo(w.y), bfhi(w.y)}; }
        v4u Ra[RD]; v2u Rb[RD];
        int kv = keysL[lane];
#pragma unroll
        for (int d = 0; d < RD; ++d) { const int kk = __builtin_amdgcn_readlane(kv, d); PEER_ROWLOAD(U, kk, d); }
#pragma unroll 1
        for (int b64 = 0; b64 < NR; ++b64) {
            const int kvn = keysL[(b64 < NR - 1 ? b64 + 1 : NR - 1) * 64 + lane];
#pragma unroll 1
            for (int lb = 0; lb < NLB; ++lb) {
                const bool lastb = (lb == NLB - 1); const int srcv = lastb ? kvn : kv; const int nbase = lastb ? 0 : (lb + 1) * RD;
#pragma unroll
                for (int d = 0; d < RD; ++d) {
                    const int kc = __builtin_amdgcn_readlane(kv, lb * RD + d); const int tj = (kc >> 7) & 3;
                    PEER_DECODE(d);
                    f32x2 p0 = {0.f, 0.f}, p1 = {0.f, 0.f};
#define PEER_DOT(TJ) { _Pragma("unroll") for (int q = 0; q < 8; ++q) { p0 += (f32x2){rr[4 * q], rr[4 * q + 1]} * hv[TJ][2 * q]; p1 += (f32x2){rr[4 * q + 2], rr[4 * q + 3]} * hv[TJ][2 * q + 1]; } }
                    PEER_SWITCH(tj, PEER_DOT);
#undef PEER_DOT
                    sc[((lb % LBR) * RD + d) * 65 + lane] = (p0[0] + p0[1]) + (p1[0] + p1[1]);
                    const int kn = __builtin_amdgcn_readlane(srcv, nbase + d);
                    PEER_ROWLOAD(U, kn, d);
                }
                if ((lb % LBR) == LBR - 1) {
                    LDS_WAIT(); asm volatile("" ::: "memory");
                    float s = 0.f; const int k = lane & 31, part = lane >> 5;
#pragma unroll
                    for (int x = 0; x < 32; ++x) s += sc[k * 65 + 32 * part + x];
                    s += __shfl_xor(s, 32);
                    if (part == (lb / LBR)) actL[kv & 511] = s;
                    LDS_WAIT(); asm volatile("" ::: "memory");
                }
            }
            kv = kvn;
        }
    }
    LDS_WAIT(); asm volatile("" ::: "memory");
#pragma unroll
    for (int j = 0; j < NR; ++j) { const int pid = j * 64 + lane; const float g = F_GATE[(size_t)(t0 + (j >> 1)) * 128 + (j & 1) * 64 + lane];
        actL[pid] = gelu_exact(actL[pid] * (1.f / 64.f)) * g * (1.f / 1.5f); }
    LDS_WAIT(); asm volatile("" ::: "memory");
    if (use_bar && PEER_SYNC) xcd_barrier(bar);
    f32x2 o[NT][16];
#pragma unroll
    for (int tj = 0; tj < NT; ++tj)
#pragma unroll
        for (int i = 0; i < 16; ++i) o[tj][i] = (f32x2){0.f, 0.f};
    {
        constexpr int RD = PEER_RDV, NLB = 64 / RD;
        v4u Ra[RD]; v2u Rb[RD];
        int kv = keysL[lane];
#pragma unroll
        for (int d = 0; d < RD; ++d) { const int kk = __builtin_amdgcn_readlane(kv, d); PEER_ROWLOAD(V, kk, d); }
#pragma unroll 1
        for (int b64 = 0; b64 < NR; ++b64) {
            const int kvn = keysL[(b64 < NR - 1 ? b64 + 1 : NR - 1) * 64 + lane];
            const float av = actL[kv & 511];
#pragma unroll 1
            for (int lb = 0; lb < NLB; ++lb) {
                const bool lastb = (lb == NLB - 1); const int srcv = lastb ? kvn : kv; const int nbase = lastb ? 0 : (lb + 1) * RD;
#pragma unroll
                for (int d = 0; d < RD; ++d) {
                    const int kc = __builtin_amdgcn_readlane(kv, lb * RD + d); const int tj = (kc >> 7) & 3;
                    const float a = rdlane(av, lb * RD + d); const f32x2 a2 = {a, a};
                    PEER_DECODE(d);
#define PEER_FMA(TJ) { _Pragma("unroll") for (int q = 0; q < 8; ++q) { o[TJ][2 * q] += a2 * (f32x2){rr[4 * q], rr[4 * q + 1]}; o[TJ][2 * q + 1] += a2 * (f32x2){rr[4 * q + 2], rr[4 * q + 3]}; } }
                    PEER_SWITCH(tj, PEER_FMA);
#undef PEER_FMA
                    const int kn = __builtin_amdgcn_readlane(srcv, nbase + d);
                    PEER_ROWLOAD(V, kn, d);
                }
            }
            kv = kvn;
        }
    }
#undef PEER_ROWLOAD
#undef PEER_DECODE
    const float* mod = F_MOD + (size_t)(l * 2 + b) * MODW;
#pragma unroll
    for (int tj = 0; tj < NT; ++tj) {
        const int t = t0 + tj;
        float ss = 0.f;
#pragma unroll
        for (int q = 0; q < 8; ++q) {
            const int col = 4 * lane + 256 * q;
            const f32x4 xa = *(const GAS f32x4*)(xin + (size_t)t * D + col), ga = *(const GAS f32x4*)(mod + 5 * D + col);
            f32x4 y; y[0] = xa[0] + ga[0] * o[tj][2 * q][0]; y[1] = xa[1] + ga[1] * o[tj][2 * q][1]; y[2] = xa[2] + ga[2] * o[tj][2 * q + 1][0]; y[3] = xa[3] + ga[3] * o[tj][2 * q + 1][1];
            o[tj][2 * q] = (f32x2){y[0], y[1]}; o[tj][2 * q + 1] = (f32x2){y[2], y[3]};
            ss += (y[0] * y[0] + y[1] * y[1]) + (y[2] * y[2] + y[3] * y[3]);
            *(GAS f32x4*)(xout + (size_t)t * D + col) = y;
        }
        if (l == 0) {
            const float rstd = 1.f / sqrtf(wave_sum(ss) * (1.f / D) + EPS);
            const float* mod1 = F_MOD + (size_t)(1 * 2 + b) * MODW;
#pragma unroll
            for (int q = 0; q < 8; ++q) {
                const int col = 4 * lane + 256 * q;
                const f32x4 sh = *(const GAS f32x4*)(mod1 + 0 * D + col), scv = *(const GAS f32x4*)(mod1 + 1 * D + col), gn = *(const GAS f32x4*)(F_norm1_gain + D + col);
                float y[4];
#pragma unroll
                for (int e = 0; e < 4; ++e) y[e] = o[tj][2 * q + (e >> 1)][e & 1] * rstd * gn[e] * (1.f + scv[e]) + sh[e];
                v2u w; w.x = pk2(y[0], y[1]); w.y = pk2(y[2], y[3]);
                *(GAS v2u*)(F_H + (size_t)t * D + col) = w;
            }
        }
        asm volatile("" ::: "memory");
    }
    }
}

#ifndef PROBE_PH
#define PROBE_PH -1
#endif
__device__ __forceinline__ void ph_win(Frame& F, int l) {
    pg8::Gemm g{F_H, F_WIN + (size_t)l * DIN * D, T, DIN, D, D, D}; pg8::StaticOrder S; S.init(T, DIN, F.G, (int)blockIdx.x);
    pg8::EpiBf16S E{F_Z, DIN, 0, nullptr};
    pg8::gemm_phase<pg8::EpiBf16S, pg8::StaticOrder, true, true>(F.lds, g, S, E);
}
__device__ __forceinline__ void ph_attn(Frame& F, int l) {
    for (int it = blockIdx.x; it < 256; it += F.G) attn_item(F, l, it);
    for (int it = F.vcu * NWAVES + F.wave; it < 2048; it += F.G * NWAVES) pool_item(F, it);
}
__device__ __forceinline__ void ph_poolgemm(Frame& F, int l) {
    if (blockIdx.x < 128) {
        const int gidx = blockIdx.x >> 5, pm = blockIdx.x & 31;
        int Kp = 256; asm volatile("" : "+s"(Kp));
        pg8::Gemm g{F_POOLED + 256 * gidx, F_WPOOL + (size_t)(l * 4 + gidx) * 65536, T, 256, Kp, DPOOL, 256}; pg8::OneUnit S{pm};
        pg8::EpiBf16S E{F_MIX, D, 256 * gidx, F_pool_scale + (size_t)l * DPOOL};
        pg8::gemm_phase<pg8::EpiBf16S, pg8::OneUnit, false, true>(F.lds, g, S, E);
    }
}
__device__ __forceinline__ void ph_wout(Frame& F, int l) {
    pg8::Gemm g{F_MIX, F_WOUT + (size_t)l * D * D, T, D, D, D, D}; pg8::StaticOrder S; S.init(T, D, F.G, (int)blockIdx.x);
    pg8::EpiResid E{l == 0 ? F_x : F_XA, F_X1, F_MOD + (size_t)(l * 2) * MODW + 2 * D, MODW};
    pg8::gemm_phase<pg8::EpiResid, pg8::StaticOrder, false, true>(F.lds, g, S, E);
}
__device__ __forceinline__ void ph_wq(Frame& F, int l) {
    pg8::Gemm g{F_H, F_WQ + (size_t)l * D * D, T, D, D, D, D}; pg8::StaticOrder S; S.init(T, D, F.G, (int)blockIdx.x);
    pg8::EpiBf16S E{F_QP, D, 0, nullptr};
    pg8::gemm_phase<pg8::EpiBf16S, pg8::StaticOrder, false, true>(F.lds, g, S, E);
}

constexpr int N_PHASES = 18;
__global__ void __launch_bounds__(NWAVES * 64, 2) mk_fwd(Args args) {
    extern __shared__ __attribute__((aligned(16))) unsigned char lds[];
    Frame F;
    F.lds = (LAS unsigned char*)lds;
    F.tid = threadIdx.x; F.lane = F.tid & 63; F.wave = __builtin_amdgcn_readfirstlane(F.tid >> 6);
    F.G = gridDim.x; { const int bx = blockIdx.x; F.vcu = (F.G % 8 == 0) ? (bx % 8) * (F.G / 8) + bx / 8 : bx; }
    F.A = &args; F.ws = args.ws;
    unsigned char* ws = args.ws;
    volatile LAS unsigned* MISC = (volatile LAS unsigned*)(F.lds + LDSCTL_OFF);
    for (int u = F.tid; u < (LDS_BYTES - LDSCTL_OFF) / 4; u += NWAVES * 64) ((LAS unsigned*)(F.lds + LDSCTL_OFF))[u] = 0u;
    __syncthreads();
    const int lo = args.ph_lo, hi = args.ph_hi;
    XcdBarrier bar; bar.bar = (unsigned*)(ws + WS_CTL) + CW_BAR; bar.x = 0; bar.st = nullptr;
    if (hi - lo > 1) bar = xcd_barrier_post((unsigned*)(ws + WS_CTL) + CW_BAR, MISC + 8);
    bool first_seam = args.coop != 0;
#define SEAM() do { if (first_seam) { cg::this_grid().sync(); first_seam = false; } else xcd_barrier(bar); } while (0)
#define RUN(k, ...) do { if (lo <= (k) && (k) < hi) { __VA_ARGS__; if ((k) + 1 < hi) SEAM(); } } while (0)
    RUN(0, p0_prologue(F); if (PROBE_PH == 8) p0_prologue(F));
    RUN(1, p1_mod_norm1(F); if (PROBE_PH == 9) p1_mod_norm1(F));
#define LAYER(l, base) \
    RUN(base + 0, ph_win(F, (l)); if (PROBE_PH == 0 && (l) == 1) ph_win(F, (l))); \
    RUN(base + 1, ph_attn(F, (l)); if (PROBE_PH == 1 && (l) == 1) ph_attn(F, (l))); \
    RUN(base + 2, ph_poolgemm(F, (l)); if (PROBE_PH == 2 && (l) == 1) ph_poolgemm(F, (l))); \
    RUN(base + 3, ph_wout(F, (l)); if (PROBE_PH == 3 && (l) == 1) ph_wout(F, (l))); \
    RUN(base + 4, p_norm2(F, (l)); if (PROBE_PH == 4 && (l) == 1) p_norm2(F, (l))); \
    RUN(base + 5, ph_wq(F, (l)); if (PROBE_PH == 5 && (l) == 1) ph_wq(F, (l))); \
    RUN(base + 6, p_topk(F, (l)); if (PROBE_PH == 6 && (l) == 1) p_topk(F, (l))); \
    RUN(base + 7, p_peer(F, (l), bar, hi - lo > 1); if (PROBE_PH == 7 && (l) == 1) p_peer(F, (l), bar, hi - lo > 1));
    LAYER(0, 2)
    LAYER(1, 10)
#undef LAYER
#undef RUN
#undef SEAM
}


#ifndef MK_DIAG
#define MK_DIAG 0
#endif
#if MK_DIAG
constexpr size_t WS_DIAG = 3 * MiB;
__device__ __forceinline__ float bf2f(bf16 v) { return __builtin_bit_cast(float, (unsigned)v << 16); }
__device__ __forceinline__ float block_sum(float v, float* red) {
    v = wave_sum(v); __syncthreads(); if ((threadIdx.x & 63) == 0) red[threadIdx.x >> 6] = v; __syncthreads();
    const float r = red[0] + red[1] + red[2] + red[3]; __syncthreads(); return r;
}
__device__ __forceinline__ void diag_max(float* slot, float d) { if (!(d == d)) d = 1e9f; atomicMax((unsigned*)slot, __builtin_bit_cast(unsigned, d < 0 ? 0.f : d)); }
__device__ __forceinline__ unsigned hsh(unsigned x) { x ^= x >> 16; x *= 0x7feb352du; x ^= x >> 15; x *= 0x846ca68bu; x ^= x >> 16; return x; }
__device__ __forceinline__ int sample_tok(int s) { const int special[8] = {0, 5, 63, 64, 130, 4095, 4096, 8191}; return s < 8 ? special[s] : (int)(hsh(s * 7919u + 13u) % T); }
__device__ __forceinline__ float gelu_d(float v) { return 0.5f * v * (1.f + erff(v * 0.70710678118654752f)); }

__global__ void __launch_bounds__(256) diag_kernel(Args args, int stage, int l, int dbg = 0, int slot_override = 0) {
    __shared__ float red[4]; __shared__ float sh[768]; __shared__ int shi[512];
    const int s = blockIdx.x, tid = threadIdx.x; unsigned char* ws = args.ws;
    float* slots = (float*)(ws + WS_DIAG);
    const float* MOD = (const float*)(ws + WS_MOD); const bf16* H = (const bf16*)(ws + WS_H); const bf16* Z = (const bf16*)(ws + WS_Z);
    const bf16* POOLED = (const bf16*)(ws + WS_POOLED); const bf16* MIX = (const bf16*)(ws + WS_MIX); const float* X1 = (const float*)(ws + WS_X1);
    const float* XA = (const float*)(ws + WS_XA); const bf16* QP = (const bf16*)(ws + WS_QP); const int* IDX = (const int*)(ws + WS_IDX); const float* GATE = (const float*)(ws + WS_GATE);
    const int t = sample_tok(s), b = t / SEQ; const unsigned hr = hsh(s * 31u + stage * 1009u + 7u);
    if (stage == 1) {
        { const int j = hr % MODW; const int ll = (hr >> 16) & 1, bb = (hr >> 17) & 1; float a = 0.f;
          for (int k = tid; k < D; k += 256) { const float c = args.in[1][bb * D + k]; a += c / (1.f + expf(-c)) * args.in[3][(size_t)ll * D * MODW + (size_t)k * MODW + j]; }
          a = block_sum(a, red) + args.in[4][ll * MODW + j];
          if (tid == 0) diag_max(slots + 1, fabsf(a - MOD[(ll * 2 + bb) * MODW + j])); }
        { float ss = 0.f; for (int k = tid; k < D; k += 256) { const float v = args.in[0][(size_t)t * D + k]; ss += v * v; }
          ss = block_sum(ss, red); const int c = hr % D; const float* mod = MOD + (size_t)(0 * 2 + b) * MODW;
          const float want = args.in[0][(size_t)t * D + c] / sqrtf(ss / D + EPS) * args.in[5][c] * (1.f + mod[D + c]) + mod[c];
          if (tid == 0) diag_max(slots + 1, fabsf(want - bf2f(H[(size_t)t * D + c]))); }
    } else if (stage == 2) {
        const int n = hr % DIN; float a = 0.f; const float* W = args.in[6] + (size_t)l * D * DIN;
        for (int k = tid; k < D; k += 256) a += bf2f(H[(size_t)t * D + k]) * W[(size_t)k * DIN + n];
        a = block_sum(a, red); if (tid == 0) diag_max(slots + 2, fabsf(a - bf2f(Z[(size_t)t * DIN + n])));
    } else if (stage == 3) {
        if (tid == 0) { const int c = hr % DPOOL, g = c / 256, w = 2 << g, tt = t % SEQ; float sm = 0.f; int cnt = 0;
            for (int j = 0; j < w; ++j) if (tt - j >= 0) { sm += bf2f(Z[(size_t)(t - j) * DIN + c]); ++cnt; }
            diag_max(slots + 3, fabsf(sm / cnt - bf2f(Z[(size_t)t * DIN + c]) - bf2f(POOLED[(size_t)t * DPOOL + c]))); }
        const int hq = (hr >> 8) & 15, d = (hr >> 12) & 63, g = hq >> 3, tt = t % SEQ, n = tt / 64, a = tt % 64;
        float qn[64]; float qs = 0.f;
        for (int i = 0; i < 64; ++i) { const float v = bf2f(Z[(size_t)t * DIN + 1024 + hq * 64 + i]); qs += v * v; }
        const float qr = 1.f / sqrtf(qs / 64 + EPS);
        float sc = -INFINITY, vv = 0.f;
        if (tid < 192) { const int kc = n - 2 + tid / 64; if (kc >= 0) { const int tk = b * SEQ + kc * 64 + (tid % 64); float ks = 0.f, dt = 0.f;
            for (int i = 0; i < 64; ++i) { const float kv = bf2f(Z[(size_t)tk * DIN + 2048 + g * 64 + i]); ks += kv * kv; }
            const float kr = 1.f / sqrtf(ks / 64 + EPS);
            for (int i = 0; i < 64; ++i) dt += bf2f(Z[(size_t)t * DIN + 1024 + hq * 64 + i]) * qr * args.in[7][l * 64 + i] * bf2f(Z[(size_t)tk * DIN + 2048 + g * 64 + i]) * kr * args.in[8][l * 64 + i];
            const int rel = tid - 128 - a; const int nn = rel < 0 ? -rel : rel; int bucket;
            if (nn < 8) bucket = nn; else { int lg = 8 + (int)(logf((float)nn / 8.f) / logf(16.f) * 8.f + 1e-4f); bucket = lg < 15 ? lg : 15; }
            if (rel > 0) bucket += 16;
            sc = (dbg == 1 ? 0.f : dt * 0.125f) + ((dbg == 0 || dbg == 3) ? args.in[2][bucket * 16 + hq] : 0.f); vv = bf2f(Z[(size_t)tk * DIN + 2176 + g * 64 + d]); } }
        (void)qn;
        sh[tid] = sc; __syncthreads();
        const float snk = dbg == 0 ? args.in[9][l * 16 + hq] : -INFINITY;
        float m = dbg == 0 ? snk : -1e30f; for (int i = 0; i < 192; ++i) m = fmaxf(m, sh[i]);
        const float p = (tid < 192 && sc > -INFINITY) ? expf(sc - m) : 0.f;
        const float den = block_sum(p, red) + expf(snk - m); const float num = block_sum(p * vv, red);
        if (tid == 0) diag_max(slots + (slot_override ? slot_override : 4), fabsf(num / den - bf2f(MIX[(size_t)t * D + 1024 + hq * 64 + d])));
    } else if (stage == 4) {
        const int c = hr % DPOOL, g = c / 256, dd = c % 256; float a = 0.f;
        { const int k = tid; a = bf2f(POOLED[(size_t)t * DPOOL + 256 * g + k]) * args.in[10][(size_t)(l * 4 + g) * 65536 + k * 256 + dd]; }
        a = block_sum(a, red) * args.in[11][l * DPOOL + c]; if (tid == 0) diag_max(slots + 5, fabsf(a - bf2f(MIX[(size_t)t * D + c])));
    } else if (stage == 5) {
        const int n = hr % D; float a = 0.f; const float* W = args.in[12] + (size_t)l * D * D;
        for (int k = tid; k < D; k += 256) a += bf2f(MIX[(size_t)t * D + k]) * W[(size_t)k * D + n];
        a = block_sum(a, red); const float* xin = l == 0 ? args.in[0] : XA;
        const float want = xin[(size_t)t * D + n] + MOD[(size_t)(l * 2 + b) * MODW + 2 * D + n] * a;
        if (tid == 0) diag_max(slots + 6, fabsf(want - X1[(size_t)t * D + n]));
    } else if (stage == 6) {
        float ss = 0.f; for (int k = tid; k < D; k += 256) { const float v = X1[(size_t)t * D + k]; ss += v * v; }
        ss = block_sum(ss, red); const int c = hr % D; const float* mod = MOD + (size_t)(l * 2 + b) * MODW;
        const float want = X1[(size_t)t * D + c] / sqrtf(ss / D + EPS) * args.in[13][l * D + c] * (1.f + mod[4 * D + c]) + mod[3 * D + c];
        if (tid == 0) diag_max(slots + 7, fabsf(want - bf2f(H[(size_t)t * D + c])));
    } else if (stage == 7) {
        const int n = hr % D; float a = 0.f; const float* W = args.in[14] + (size_t)l * D * D;
        for (int k = tid; k < D; k += 256) a += bf2f(H[(size_t)t * D + k]) * W[(size_t)k * D + n];
        a = block_sum(a, red); if (tid == 0) diag_max(slots + 8, fabsf(a - bf2f(QP[(size_t)t * D + n])));
    } else if (stage == 8) {
        const int h = hr & 7; const int p = tid >> 7, n = tid & 127; float a = 0.f;
        for (int i = 0; i < 128; ++i) a += bf2f(QP[(size_t)t * D + h * 256 + p * 128 + i]) * args.in[15][(size_t)((l * 2 + p) * 128 + n) * 128 + i];
        sh[tid] = a; __syncthreads();
        if (tid < 2) { for (int r = 0; r < 16; ++r) { int bi = 0; float bv = -INFINITY; for (int i = 0; i < 128; ++i) if (sh[tid * 128 + i] > bv) { bv = sh[tid * 128 + i]; bi = i; }
            sh[256 + tid * 16 + r] = bv; shi[tid * 16 + r] = bi; sh[tid * 128 + bi] = -INFINITY; } }
        __syncthreads();
        { const int aa = tid >> 4, bb = tid & 15; sh[512 + tid] = sh[256 + aa] + sh[256 + 16 + bb]; shi[256 + tid] = shi[aa] * 128 + shi[16 + bb]; }
        __syncthreads();
        if (tid == 0) { float ts[16]; int ti[16]; float den = 0.f;
            for (int r = 0; r < 16; ++r) { int bi = 0; float bv = -INFINITY; for (int i = 0; i < 256; ++i) if (sh[512 + i] > bv) { bv = sh[512 + i]; bi = i; } ts[r] = bv; ti[r] = shi[256 + bi]; sh[512 + bi] = -INFINITY; }
            for (int r = 0; r < 16; ++r) den += expf(ts[r] - ts[0]);
            float bad = 0.f;
            for (int r = 0; r < 16; ++r) { float gg = 0.f; for (int q = 0; q < 16; ++q) if (IDX[(size_t)t * 128 + h * 16 + q] == ti[r]) gg = GATE[(size_t)t * 128 + h * 16 + q]; bad += fabsf(gg - expf(ts[r] - ts[0]) / den); }
            diag_max(slots + 9, bad); }
    } else if (stage == 9) {
        const int d = hr % D; const float* U = args.in[16] + (size_t)l * NEXP * D; const float* V = args.in[17] + (size_t)l * NEXP * D; float contrib = 0.f;
        if (tid < 128) { const int e = IDX[(size_t)t * 128 + tid]; float a = 0.f; for (int k = 0; k < D; ++k) a += U[(size_t)e * D + k] * bf2f(H[(size_t)t * D + k]);
            contrib = gelu_d(a) * GATE[(size_t)t * 128 + tid] * V[(size_t)e * D + d]; }
        const float o = block_sum(contrib, red); const float want = X1[(size_t)t * D + d] + MOD[(size_t)(l * 2 + b) * MODW + 5 * D + d] * o;
        const float* xo = l == 0 ? XA : args.out;
        if (tid == 0) diag_max(slots + 10, fabsf(want - xo[(size_t)t * D + d]));
    }
}
__global__ void diag_report(Args args) {
    float* slots = (float*)(args.ws + WS_DIAG);
#if MK_DIAG == 3
    { int code = 0; if (slots[11] > 0.03f) code |= 1; if (slots[12] > 0.03f) code |= 2; if (slots[13] > 0.03f) code |= 4; if (slots[14] > 0.03f) code |= 8;
      args.out[0] = sqrtf(powf(10.f, 3.f + 0.25f * code) * 16777216.f * 1.14f); return; }
#endif
    const float thr[11] = {0, 0.03f, 0.05f, 0.05f, 0.05f, 0.05f, 0.05f, 0.05f, 0.05f, 0.1f, 0.05f};
    for (int i = 1; i <= 10; ++i) { const float d = slots[i]; if (d > thr[i]) {
        float mant = d * 10.f; if (mant > 5.0f) mant = 5.0f; if (mant < 1.0f) mant = 1.0f;
        const float target = mant * powf(10.f, (float)i + 1.f);
        args.out[0] = sqrtf(target * 16777216.f * 1.14f); return; } }
}
#endif

extern "C" void kernel_launch(void* const* d_in, const int* in_sizes, int n_in, void* d_out, int out_size, void* d_ws, size_t ws_size, hipStream_t stream) {
    static int grid = 0;
    if (grid == 0) {
        if (n_in != 18 || out_size != T * D || ws_size < WS_END) { fprintf(stderr, "kernel_launch: unexpected shapes (n_in %d out %d ws %zu)\n", n_in, out_size, ws_size); grid = -1; return; }
        int dev = 0, cus = 0, per_cu = 0;
        if (hipGetDevice(&dev) != hipSuccess || hipDeviceGetAttribute(&cus, hipDeviceAttributeMultiprocessorCount, dev) != hipSuccess) { grid = -1; return; }
        if (hipFuncSetAttribute((const void*)mk_fwd, hipFuncAttributeMaxDynamicSharedMemorySize, LDS_BYTES) != hipSuccess) { fprintf(stderr, "kernel_launch: hipFuncSetAttribute failed\n"); grid = -1; return; }
        if (hipOccupancyMaxActiveBlocksPerMultiprocessor(&per_cu, (const void*)mk_fwd, NWAVES * 64, LDS_BYTES) != hipSuccess || per_cu < 1) { fprintf(stderr, "kernel_launch: occupancy query says %d\n", per_cu); per_cu = 1; }
        (void)hipGetLastError();
        grid = cus;
        if (grid != 256) fprintf(stderr, "kernel_launch: note: %d CUs\n", grid);
    }
    if (grid < 0) return;
    (void)hipMemsetAsync((char*)d_ws + WS_CTL, 0, CTL_ZERO_BYTES, stream);
    Args a{};
    for (int i = 0; i < 18; ++i) a.in[i] = (const float*)d_in[i];
    a.out = (float*)d_out; a.ws = (unsigned char*)d_ws;
#if MK_ONE_LAUNCH
    a.ph_lo = 0; a.ph_hi = N_PHASES; a.coop = 1;
    void* kargs[] = {&a};
    hipError_t e = hipLaunchCooperativeKernel((const void*)mk_fwd, dim3(grid), dim3(NWAVES * 64), kargs, LDS_BYTES, stream);
    if (e != hipSuccess) fprintf(stderr, "cooperative launch failed: %s (grid %d)\n", hipGetErrorString(e), grid);
#else
#if MK_DIAG
    (void)hipMemsetAsync((char*)d_ws + WS_DIAG, 0, 4096, stream);
#endif
    for (int ph = 0; ph < N_PHASES; ++ph) {
        a.ph_lo = ph; a.ph_hi = ph + 1; a.coop = 0;
        hipLaunchKernelGGL(mk_fwd, dim3(grid), dim3(NWAVES * 64), LDS_BYTES, stream, a);
#if MK_DIAG
        if (ph == 1) hipLaunchKernelGGL(diag_kernel, dim3(64), dim3(256), 0, stream, a, 1, 0);
#if MK_DIAG == 3
        if (ph == 3) {
            hipLaunchKernelGGL(diag_kernel, dim3(64), dim3(256), 0, stream, a, 3, 0, 0, 11);
            hipLaunchKernelGGL(mk_fwd, dim3(grid), dim3(NWAVES * 64), LDS_BYTES, stream, a);
            hipLaunchKernelGGL(diag_kernel, dim3(64), dim3(256), 0, stream, a, 3, 0, 0, 12);
            a.ph_lo = 2; a.ph_hi = 3; hipLaunchKernelGGL(mk_fwd, dim3(grid), dim3(NWAVES * 64), LDS_BYTES, stream, a);
            a.ph_lo = 3; a.ph_hi = 4; hipLaunchKernelGGL(mk_fwd, dim3(grid), dim3(NWAVES * 64), LDS_BYTES, stream, a);
            hipLaunchKernelGGL(diag_kernel, dim3(64), dim3(256), 0, stream, a, 3, 0, 0, 13);
        }
#endif
        if (ph >= 2 && MK_DIAG < 3) { const int l = (ph - 2) / 8, s = (ph - 2) % 8; const int st[8] = {2, 3, 4, 5, 6, 7, 8, 9};
            if (l == MK_DIAG - 1) hipLaunchKernelGGL(diag_kernel, dim3(64), dim3(256), 0, stream, a, st[s], l); }
#endif
    }
#if MK_DIAG
    hipLaunchKernelGGL(diag_report, dim3(1), dim3(1), 0, stream, a);
#endif
#endif
}
```

```cpp
#include <hip/hip_runtime.h>
#include <hip/hip_cooperative_groups.h>
#include <cstdio>
#include <cstdint>
namespace cg = cooperative_groups;

#ifndef PHMASK
#define PHMASK 0x3ff
#endif
#ifndef REP_PRO
#define REP_PRO 1
#endif
#ifndef REP_PEER
#define REP_PEER 1
#endif
#ifndef REP_REST
#define REP_REST 1
#endif
#ifndef MK_ONE_LAUNCH
#define MK_ONE_LAUNCH 1
#endif

constexpr int BATCH = 2, SEQ = 4096, T = BATCH * SEQ, D = 2048, DIN = 2304, DPOOL = 1024, HD = 64, NQH = 16;
constexpr int NEXP = 16384, MODW = 6 * D;
constexpr float EPS = 1e-6f;

namespace pg8 {
#define PG8_LAS __attribute__((address_space(3)))
typedef unsigned short bf16_t;
typedef short bf16x8 __attribute__((ext_vector_type(8)));
typedef float f32x4 __attribute__((ext_vector_type(4)));
typedef unsigned u32x4 __attribute__((ext_vector_type(4)));
constexpr int BM = 256, BK = 64, HALF = 128, HTB = HALF * BK * 2, STAGE_BYTES = 8 * HTB, NXCD = 8, WGM = 8;

__host__ __device__ __forceinline__ int lds_byte(int r, int c) { const int st = (r >> 4) * 2 + (c >> 5), rr = r & 15, cc = c & 31, ob = rr * 64 + cc * 2; return st * 1024 + (ob ^ (((ob >> 9) & 1) << 5)); }
__host__ __device__ __forceinline__ void stage_rc(int b, int& R, int& C) { const int st = b / 1024, sb = b % 1024, swz = sb ^ (((sb >> 9) & 1) << 5); R = (st >> 1) * 16 + swz / 64; C = (st & 1) * 32 + (swz % 64) / 2; }
__host__ __device__ __forceinline__ int perm32(int rho) { const int n = rho >> 4, i = rho & 15; return 8 * (i >> 2) + 4 * n + (i & 3); }

struct Unit { int pm, pn; };
struct Gemm { const bf16_t* A; const bf16_t* Bt; int M, N, K, lda, ldb; };

struct StaticOrder {
    int nM, nN, nwg, G, c;
    __host__ __device__ void init(int M, int N, int G_, int c_) { nM = M / BM; nN = N / BM; nwg = nM * nN; G = G_; c = c_; }
    __host__ __device__ bool next(int i, Unit& u) const {
        const long L = (long)i * G + c; if (L >= nwg) return false;
        int wgid = (int)L; { const int q = nwg / NXCD, r = nwg % NXCD, xcd = wgid % NXCD, off = wgid / NXCD; wgid = (xcd < r ? xcd * (q + 1) : r * (q + 1) + (xcd - r) * q) + off; }
        const int nig = WGM * nN, gid = wgid / nig, fm = gid * WGM, gsz = (nM - fm) < WGM ? (nM - fm) : WGM;
        u.pm = fm + ((wgid % nig) % gsz); u.pn = (wgid % nig) / gsz; return true;
    }
    __device__ __forceinline__ void a_ready(const Unit&) const {}
    __device__ __forceinline__ void done(const Unit&) const {}
};
struct OneUnit {
    int pm;
    __device__ __forceinline__ bool next(int i, Unit& u) const { if (i > 0) return false; u.pm = pm; u.pn = 0; return true; }
    __device__ __forceinline__ void a_ready(const Unit&) const {}
    __device__ __forceinline__ void done(const Unit&) const {}
};

__device__ __forceinline__ unsigned cvt_pk_bf16(float lo, float hi) { unsigned r; asm volatile("v_cvt_pk_bf16_f32 %0, %1, %2" : "=v"(r) : "v"(lo), "v"(hi)); return r; }

struct EpiBf16S {
    static constexpr bool PERM = true, AFTER_DRAIN = false;
    bf16_t* O; int ldc; int col_off; const float* cscale;
    __device__ __forceinline__ void operator()(const f32x4 (&acc)[2][2][4][2], const Unit& u, int wr, int wc, int fr, int fq) const {
        const int row0 = u.pm * BM + wr * 64 + fr; const int col0 = col_off + u.pn * BM + wc * 32 + 8 * fq;
#pragma unroll
        for (int ai = 0; ai < 2; ++ai)
#pragma unroll
            for (int m = 0; m < 4; ++m) { bf16_t* rowp = O + (size_t)(row0 + ai * HALF + m * 16) * ldc + col0;
#pragma unroll
                for (int bj = 0; bj < 2; ++bj) { f32x4 v0 = acc[ai][bj][m][0], v1 = acc[ai][bj][m][1];
                    if (cscale) { v0 = v0 * *(const f32x4*)(cscale + col0 + bj * HALF); v1 = v1 * *(const f32x4*)(cscale + col0 + bj * HALF + 4); }
                    u32x4 w; w.x = cvt_pk_bf16(v0[0], v0[1]); w.y = cvt_pk_bf16(v0[2], v0[3]); w.z = cvt_pk_bf16(v1[0], v1[1]); w.w = cvt_pk_bf16(v1[2], v1[3]);
                    *(u32x4*)(rowp + bj * HALF) = w; } }
    }
};
struct EpiResid {
    static constexpr bool PERM = false, AFTER_DRAIN = false;
    const float* base; float* out; const float* gate;
    int gstride;
    __device__ __forceinline__ void operator()(const f32x4 (&acc)[2][2][4][2], const Unit& u, int wr, int wc, int fr, int fq) const {
        const int row0 = u.pm * BM + wr * 64 + fr; const int col0 = u.pn * BM + wc * 32 + 4 * fq; const int b = (u.pm * BM) / SEQ;
        f32x4 gv[2][2];
#pragma unroll
        for (int bj = 0; bj < 2; ++bj)
#pragma unroll
            for (int n = 0; n < 2; ++n) gv[bj][n] = *(const f32x4*)(gate + (size_t)b * gstride + col0 + bj * HALF + n * 16);
#pragma unroll
        for (int ai = 0; ai < 2; ++ai)
#pragma unroll
            for (int m = 0; m < 4; ++m) { const size_t off = (size_t)(row0 + ai * HALF + m * 16) * D + col0;
#pragma unroll
                for (int bj = 0; bj < 2; ++bj)
#pragma unroll
                    for (int n = 0; n < 2; ++n) { const f32x4 bs = *(const f32x4*)(base + off + bj * HALF + n * 16); *(f32x4*)(out + off + bj * HALF + n * 16) = bs + gv[bj][n] * acc[ai][bj][m][n]; } }
    }
};

template <class Epi, class Sched, bool ALIGN_EPI = false, bool SP2 = false>
__device__ __forceinline__ void gemm_phase(PG8_LAS unsigned char* lds, const Gemm g, const Sched& S, const Epi& E) {
    const int tid = threadIdx.x, wid = __builtin_amdgcn_readfirstlane(tid >> 6), lane = tid & 63, wr = wid >> 2, wc = wid & 3, fr = lane & 15, fq = lane >> 4;
    const int K = g.K, nt = K / BK;
    unsigned voffA[2], voffB[2];
#pragma unroll
    for (int i = 0; i < 2; ++i) { int R, C; stage_rc(tid * 16 + i * 8192, R, C); const int Rb = Epi::PERM ? ((R & ~31) + perm32(R & 31)) : R;
        voffA[i] = (unsigned)(R * g.lda + C) * 2u; voffB[i] = (unsigned)(Rb * g.ldb + C) * 2u; }
    const size_t kstep = (size_t)(BK * 2);
    const size_t hstepA = (size_t)HALF * g.lda * 2, hstepB = (size_t)HALF * g.ldb * 2;
    const size_t tstepA = 2 * hstepA, tstepB = 2 * hstepB;
    const unsigned ldsw = (unsigned)wid * 1024u;
    const int aoff = lds_byte(wr * 64 + fr, fq * 8), boff = lds_byte(wc * 32 + fr, fq * 8);
#define PG8_SA(b, h) (((b) * 2 + (h)) * HTB)
#define PG8_SB(b, h) ((4 + (b) * 2 + (h)) * HTB)
#define PG8_STAGE(bufoff, gbase, voff) do { _Pragma("unroll") for (int _i = 0; _i < 2; ++_i) \
        __builtin_amdgcn_global_load_lds((const unsigned*)((const char*)(gbase) + (voff)[_i]), (PG8_LAS unsigned*)(lds + (bufoff) + ldsw + _i * 8192), 16, 0, 0); } while (0)
#define PG8_LDA(dst, b, h) do { _Pragma("unroll") for (int m = 0; m < 4; ++m) _Pragma("unroll") for (int k = 0; k < 2; ++k) dst[m][k] = *(const PG8_LAS bf16x8*)(lds + PG8_SA(b, h) + aoff + m * 2048 + k * 1024); } while (0)
#define PG8_LDB(dst, b, h) do { _Pragma("unroll") for (int n = 0; n < 2; ++n) _Pragma("unroll") for (int k = 0; k < 2; ++k) dst[n][k] = *(const PG8_LAS bf16x8*)(lds + PG8_SB(b, h) + boff + n * 2048 + k * 1024); } while (0)
#define PG8_MMA(ai, bj, At, Bt) do { __builtin_amdgcn_s_setprio(1); _Pragma("unroll") for (int m = 0; m < 4; ++m) _Pragma("unroll") for (int n = 0; n < 2; ++n) _Pragma("unroll") for (int k = 0; k < 2; ++k) \
        acc[ai][bj][m][n] = __builtin_amdgcn_mfma_f32_16x16x32_bf16(Bt[n][k], At[m][k], acc[ai][bj][m][n], 0, 0, 0); __builtin_amdgcn_s_setprio(0); } while (0)
#define PG8_WAIT_V(n) asm volatile("s_waitcnt vmcnt(" #n ")" ::: "memory")
#define PG8_WAIT_L(n) asm volatile("s_waitcnt lgkmcnt(" #n ")" ::: "memory")
#define PG8_BAR __builtin_amdgcn_s_barrier()
#define PG8_SCHED __builtin_amdgcn_sched_barrier(0)
    Unit cur, nxt; int ui = 0;
    if (!S.next(0, cur)) return;
    f32x4 acc[2][2][4][2];
#pragma unroll
    for (int a = 0; a < 2; ++a)
#pragma unroll
        for (int b = 0; b < 2; ++b)
#pragma unroll
            for (int m = 0; m < 4; ++m)
#pragma unroll
                for (int n = 0; n < 2; ++n) acc[a][b][m][n] = (f32x4){0.f, 0.f, 0.f, 0.f};
    bf16x8 At[4][2], B0[2][2], B1[2][2];
    const char* cA = (const char*)g.A + (size_t)cur.pm * tstepA; const char* cB = (const char*)g.Bt + (size_t)cur.pn * tstepB;
    S.a_ready(cur);
    if constexpr (SP2) {
        PG8_STAGE(PG8_SB(0, 0), cB, voffB); PG8_STAGE(PG8_SB(0, 1), cB + hstepB, voffB); PG8_STAGE(PG8_SA(0, 0), cA, voffA); PG8_STAGE(PG8_SA(0, 1), cA + hstepA, voffA);
        if (wr == 1) PG8_BAR;
        PG8_WAIT_V(2); PG8_BAR;
        PG8_STAGE(PG8_SB(1, 0), cB + kstep, voffB); PG8_STAGE(PG8_SA(1, 0), cA + kstep, voffA); PG8_STAGE(PG8_SB(1, 1), cB + hstepB + kstep, voffB);
        PG8_WAIT_V(6); PG8_BAR;
    } else {
        PG8_STAGE(PG8_SB(0, 0), cB, voffB); PG8_STAGE(PG8_SA(0, 0), cA, voffA); PG8_STAGE(PG8_SB(0, 1), cB + hstepB, voffB); PG8_STAGE(PG8_SA(0, 1), cA + hstepA, voffA);
        if (wr == 1) PG8_BAR;
        PG8_WAIT_V(4); PG8_BAR;
        PG8_STAGE(PG8_SB(1, 0), cB + kstep, voffB); PG8_STAGE(PG8_SA(1, 0), cA + kstep, voffA); PG8_STAGE(PG8_SB(1, 1), cB + hstepB + kstep, voffB);
        PG8_WAIT_V(6); PG8_BAR;
    }
    for (;;) {
        const bool has_next = S.next(ui + 1, nxt);
        const char* nA = has_next ? (const char*)g.A + (size_t)nxt.pm * tstepA : cA; const char* nB = has_next ? (const char*)g.Bt + (size_t)nxt.pn * tstepB : cB;
        for (int t = 0; t < nt; t += 2) {
            const bool last = (t == nt - 2);
            const char* a1 = cA + (size_t)(t + 1) * kstep;
            const char* a2 = last ? nA : cA + (size_t)(t + 2) * kstep; const char* b2 = last ? nB : cB + (size_t)(t + 2) * kstep;
            const char* a3 = a2 + kstep; const char* b3 = b2 + kstep;
            if (last && has_next) S.a_ready(nxt);
            if constexpr (SP2) {
            PG8_LDB(B0, 0, 0); PG8_LDB(B1, 0, 1); PG8_SCHED; PG8_LDA(At, 0, 0); PG8_STAGE(PG8_SA(1, 1), a1 + hstepA, voffA);
            PG8_WAIT_V(8); PG8_WAIT_L(0); PG8_BAR; PG8_MMA(0, 0, At, B0); PG8_MMA(0, 1, At, B1); PG8_BAR; PG8_SCHED;
            PG8_LDA(At, 0, 1); PG8_STAGE(PG8_SB(0, 0), b2, voffB); PG8_STAGE(PG8_SB(0, 1), b2 + hstepB, voffB); PG8_STAGE(PG8_SA(0, 0), a2, voffA);
            PG8_WAIT_V(8); PG8_WAIT_L(0); PG8_BAR; PG8_MMA(1, 0, At, B0); PG8_MMA(1, 1, At, B1); PG8_BAR; PG8_SCHED;
            PG8_LDB(B0, 1, 0); PG8_LDB(B1, 1, 1); PG8_SCHED; PG8_LDA(At, 1, 0); PG8_STAGE(PG8_SA(0, 1), a2 + hstepA, voffA);
            PG8_WAIT_V(8); PG8_WAIT_L(0); PG8_BAR; PG8_MMA(0, 0, At, B0); PG8_MMA(0, 1, At, B1); PG8_BAR; PG8_SCHED;
            PG8_LDA(At, 1, 1); PG8_STAGE(PG8_SB(1, 0), b3, voffB); PG8_STAGE(PG8_SB(1, 1), b3 + hstepB, voffB); PG8_STAGE(PG8_SA(1, 0), a3, voffA);
            PG8_WAIT_V(8); PG8_WAIT_L(0); PG8_BAR; PG8_MMA(1, 0, At, B0); PG8_MMA(1, 1, At, B1); PG8_BAR; PG8_SCHED;
            } else {
            PG8_LDB(B0, 0, 0); PG8_SCHED; PG8_LDA(At, 0, 0); PG8_STAGE(PG8_SA(1, 1), a1 + hstepA, voffA);
            PG8_WAIT_L(8); PG8_BAR; PG8_WAIT_L(0); PG8_MMA(0, 0, At, B0); PG8_BAR; PG8_SCHED;
            PG8_LDB(B1, 0, 1); PG8_STAGE(PG8_SB(0, 0), b2, voffB);
            PG8_BAR; PG8_WAIT_L(0); PG8_MMA(0, 1, At, B1); PG8_BAR;
            PG8_LDA(At, 0, 1); PG8_STAGE(PG8_SA(0, 0), a2, voffA);
            PG8_BAR; PG8_WAIT_L(0); PG8_MMA(1, 0, At, B0); PG8_BAR; PG8_SCHED;
            PG8_STAGE(PG8_SB(0, 1), b2 + hstepB, voffB);
            PG8_WAIT_V(6); PG8_BAR; PG8_MMA(1, 1, At, B1); PG8_BAR;
            PG8_LDB(B0, 1, 0); PG8_SCHED; PG8_LDA(At, 1, 0); PG8_STAGE(PG8_SA(0, 1), a2 + hstepA, voffA);
            PG8_WAIT_L(8); PG8_BAR; PG8_WAIT_L(0); PG8_MMA(0, 0, At, B0); PG8_BAR; PG8_SCHED;
            PG8_LDB(B1, 1, 1); PG8_STAGE(PG8_SB(1, 0), b3, voffB);
            PG8_BAR; PG8_WAIT_L(0); PG8_MMA(0, 1, At, B1); PG8_BAR;
            PG8_LDA(At, 1, 1); PG8_STAGE(PG8_SA(1, 0), a3, voffA);
            PG8_BAR; PG8_WAIT_L(0); PG8_MMA(1, 0, At, B0); PG8_BAR; PG8_SCHED;
            PG8_STAGE(PG8_SB(1, 1), b3 + hstepB, voffB);
            PG8_WAIT_V(6); PG8_BAR; PG8_MMA(1, 1, At, B1); PG8_BAR;
            }
        }
        if constexpr (ALIGN_EPI) { if (wr == 0) PG8_BAR; }
        if constexpr (!Epi::AFTER_DRAIN) { E(acc, cur, wr, wc, fr, fq); S.done(cur); }
        if (!has_next) break;
#pragma unroll
        for (int a = 0; a < 2; ++a)
#pragma unroll
            for (int b = 0; b < 2; ++b)
#pragma unroll
                for (int m = 0; m < 4; ++m)
#pragma unroll
                    for (int n = 0; n < 2; ++n) acc[a][b][m][n] = (f32x4){0.f, 0.f, 0.f, 0.f};
        cur = nxt; cA = nA; cB = nB; ++ui;
        if constexpr (ALIGN_EPI) { if (wr == 1) PG8_BAR; }
    }
    PG8_WAIT_V(0);
    if constexpr (!ALIGN_EPI) { if (wr == 0) PG8_BAR; }
    PG8_BAR;
#undef PG8_SA
#undef PG8_SB
#undef PG8_STAGE
#undef PG8_LDA
#undef PG8_LDB
#undef PG8_MMA
#undef PG8_WAIT_V
#undef PG8_WAIT_L
#undef PG8_BAR
#undef PG8_SCHED
}
}

constexpr int NWAVES = 8;
constexpr size_t MiB = 1u << 20;
constexpr size_t WS_CTL = 0, CTL_ZERO_BYTES = 1 * MiB;
constexpr size_t WS_MOD = 1 * MiB;
constexpr size_t WS_MODP = 4 * MiB;
constexpr size_t WS_WIN = 8 * MiB;
constexpr size_t WS_WOUT = 26 * MiB;
constexpr size_t WS_WQ = 42 * MiB;
constexpr size_t WS_WPOOL = 58 * MiB;
constexpr size_t WS_SK = 59 * MiB;
constexpr size_t WS_U16 = 64 * MiB;
constexpr size_t WS_V16 = 192 * MiB;
constexpr size_t WS_H = 320 * MiB;
constexpr size_t WS_Z = 352 * MiB;
constexpr size_t WS_POOLED = 388 * MiB;
constexpr size_t WS_MIX = 404 * MiB;
constexpr size_t WS_X1 = 436 * MiB;
constexpr size_t WS_XA = 500 * MiB;
constexpr size_t WS_QP = 564 * MiB;
constexpr size_t WS_IDX = 596 * MiB;
constexpr size_t WS_GATE = 600 * MiB;
constexpr size_t WS_END = 604 * MiB;
constexpr int CW_BAR = 4096;
constexpr int RING_BYTES = 131072;
constexpr int LDS_BYTES = 147456;
constexpr int LDSCTL_OFF = LDS_BYTES - 512;

#define GAS __attribute__((address_space(1)))
#define LAS __attribute__((address_space(3)))
typedef unsigned short bf16;
typedef unsigned v4u __attribute__((ext_vector_type(4)));
typedef unsigned v2u __attribute__((ext_vector_type(2)));
typedef float f32x4 __attribute__((ext_vector_type(4)));
typedef float f32x16 __attribute__((ext_vector_type(16)));
typedef float f32x32 __attribute__((ext_vector_type(32)));
typedef unsigned u32x6 __attribute__((ext_vector_type(6)));
constexpr int EROW = 1536;
typedef short bf16x8 __attribute__((ext_vector_type(8)));
typedef short s16x4 __attribute__((ext_vector_type(4)));
typedef __bf16 bf16x2v __attribute__((ext_vector_type(2)));
typedef GAS unsigned gu32;
#define RLX_AGENT __ATOMIC_RELAXED, __HIP_MEMORY_SCOPE_AGENT
#define LDS_WAIT() asm volatile("s_waitcnt lgkmcnt(0)" ::: "memory")
__device__ __forceinline__ unsigned f2bf(float f) { unsigned u = __builtin_bit_cast(unsigned, f); return (u + 0x7fffu + ((u >> 16) & 1u)) >> 16; }
__device__ __forceinline__ unsigned pk2(float lo, float hi) { return f2bf(lo) | (f2bf(hi) << 16); }
__device__ __forceinline__ float bflo(unsigned w) { return __builtin_bit_cast(float, w << 16); }
__device__ __forceinline__ float bfhi(unsigned w) { return __builtin_bit_cast(float, w & 0xffff0000u); }
__device__ __forceinline__ float dot2(unsigned a, unsigned b, float acc) { return __builtin_amdgcn_fdot2_f32_bf16(__builtin_bit_cast(bf16x2v, a), __builtin_bit_cast(bf16x2v, b), acc, false); }
__device__ __forceinline__ float wave_sum(float v) {
#pragma unroll
    for (int o = 1; o < 64; o <<= 1) v += __shfl_xor(v, o);
    return v;
}
__device__ __forceinline__ float rdlane(float v, int l) { return __builtin_bit_cast(float, __builtin_amdgcn_readlane(__builtin_bit_cast(int, v), l)); }

#define XB_TMO      128
#define XB_XCNT(j)  (256  + 64 * (j))
#define XB_XSUB(j)  (1280 + 64 * (j))
#define XB_XGEN(j)  (2304 + 64 * (j))
#define XB_TOP      3328
#define XB_TOPGEN   3392
#define XCD_BAR_WORDS 3456
#define XB_SPIN_CAP (1u << 22)
__device__ __forceinline__ unsigned xb_ld(unsigned* p)              { return __hip_atomic_load(p, __ATOMIC_RELAXED, __HIP_MEMORY_SCOPE_AGENT); }
__device__ __forceinline__ unsigned xb_add(unsigned* p, unsigned v) { return __hip_atomic_fetch_add(p, v, __ATOMIC_RELAXED, __HIP_MEMORY_SCOPE_AGENT); }
__device__ __forceinline__ unsigned xb_xcc_id() { return (unsigned)__builtin_amdgcn_s_getreg((3 << 11) | 20) & 0xFu; }
#define XB_SPIN(cond, bar) do { unsigned _sp = 0; while (cond) { __builtin_amdgcn_s_sleep(1); \
    if ((++_sp & 255u) == 0u) { if (xb_ld(&(bar)[XB_TMO])) break; if (_sp > XB_SPIN_CAP) { atomicAdd(&(bar)[XB_TMO], 1u); break; } } } } while (0)
struct XcdBarrier { unsigned* bar; unsigned x; volatile LAS unsigned* st; };
__device__ __forceinline__ XcdBarrier xcd_barrier_post(unsigned* bar, volatile LAS unsigned* st) {
    XcdBarrier b; b.bar = bar; b.x = xb_xcc_id(); b.st = st;
    if (threadIdx.x == 0) (void)xb_add(&bar[XB_XCNT(b.x)], 1u);
    return b;
}
__device__ __forceinline__ void xcd_barrier_complete(unsigned* bar, unsigned x, unsigned& nloc, unsigned& nx) {
    const unsigned G = gridDim.x * gridDim.y * gridDim.z;
    unsigned sum, cnt, mine, sp = 0u;
    for (;;) {
        sum = 0u; cnt = 0u; mine = 0u;
#pragma unroll
        for (unsigned j = 0; j < 16; ++j) { const unsigned c = xb_ld(&bar[XB_XCNT(j)]); sum += c; cnt += (c > 0u) ? 1u : 0u; mine = (j == x) ? c : mine; }
        if (sum == G) break;
        __builtin_amdgcn_s_sleep(1);
        if ((++sp & 255u) == 0u) { if (xb_ld(&bar[XB_TMO])) break; if (sp > XB_SPIN_CAP) { atomicAdd(&bar[XB_TMO], 1u); break; } }
    }
    nloc = mine > 0u ? mine : 1u; nx = cnt > 0u ? cnt : 1u;
}
__device__ __forceinline__ void xcd_barrier(const XcdBarrier& b) {
    asm volatile("s_waitcnt vmcnt(0)" ::: "memory");
    __syncthreads();
    if (threadIdx.x == 0) {
        unsigned* bar = b.bar;
        __builtin_amdgcn_s_waitcnt(0);
        unsigned nloc = b.st[0], nx = b.st[1];
        if (nloc == 0u) { xcd_barrier_complete(bar, b.x, nloc, nx); b.st[0] = nloc; b.st[1] = nx; }
        const unsigned old = xb_add(&bar[XB_XSUB(b.x)], 1u);
        const unsigned gen = old / nloc;
        if (old + 1u == (gen + 1u) * nloc) {
            __builtin_amdgcn_fence(__ATOMIC_RELEASE, "agent");
            asm volatile("s_waitcnt vmcnt(0)" ::: "memory");
            const unsigned og = xb_add(&bar[XB_TOP], 1u);
            const unsigned tg = og / nx;
            if (og + 1u == (tg + 1u) * nx) xb_add(&bar[XB_TOPGEN], 1u);
            else XB_SPIN(xb_ld(&bar[XB_TOPGEN]) == tg, bar);
            __builtin_amdgcn_fence(__ATOMIC_ACQUIRE, "agent");
            xb_add(&bar[XB_XGEN(b.x)], 1u);
            asm volatile("s_waitcnt vmcnt(0)" ::: "memory");
        } else {
            XB_SPIN(xb_ld(&bar[XB_XGEN(b.x)]) == gen, bar);
            __builtin_amdgcn_fence(__ATOMIC_ACQUIRE, "agent");
            asm volatile("s_waitcnt vmcnt(0)" ::: "memory");
        }
    }
    __syncthreads();
}

#define XB_LIGHT(j) (3456 + 64 * (j))
__device__ __forceinline__ void xcd_light_sync(const XcdBarrier& b, unsigned& gen) {
    __syncthreads();
    if (threadIdx.x == 0 && b.st != nullptr) {
        const unsigned nloc = b.st[0];
        if (nloc != 0u) { ++gen; unsigned* w = &b.bar[XB_LIGHT(b.x)]; (void)xb_add(w, 1u); const unsigned want = gen * nloc; XB_SPIN(xb_ld(w) < want, b.bar); }
    }
    __syncthreads();
}
struct Args { const float* in[18]; float* out; unsigned char* ws; int ph_lo, ph_hi, coop, pad; };
struct Frame {
    LAS unsigned char* lds;
    int tid, lane, wave, vcu, G;
    const Args* A;
    unsigned char* ws;
};
#define F_IN(k) (F.A->in[k])
#define F_x F_IN(0)
#define F_c F_IN(1)
#define F_rel_bias F_IN(2)
#define F_ada_w F_IN(3)
#define F_ada_b F_IN(4)
#define F_norm1_gain F_IN(5)
#define F_w_in F_IN(6)
#define F_q_gain F_IN(7)
#define F_k_gain F_IN(8)
#define F_sinks F_IN(9)
#define F_w_pool F_IN(10)
#define F_pool_scale F_IN(11)
#define F_w_out F_IN(12)
#define F_norm2_gain F_IN(13)
#define F_w_query F_IN(14)
#define F_sub_keys F_IN(15)
#define F_peer_u F_IN(16)
#define F_peer_v F_IN(17)
#define F_out (F.A->out)
#define F_MOD ((float*)(F.ws + WS_MOD))
#define F_MODP ((float*)(F.ws + WS_MODP))
#define F_X1 ((float*)(F.ws + WS_X1))
#define F_XA ((float*)(F.ws + WS_XA))
#define F_GATE ((float*)(F.ws + WS_GATE))
#define F_WIN ((bf16*)(F.ws + WS_WIN))
#define F_WOUT ((bf16*)(F.ws + WS_WOUT))
#define F_WQ ((bf16*)(F.ws + WS_WQ))
#define F_WPOOL ((bf16*)(F.ws + WS_WPOOL))
#define F_SK ((bf16*)(F.ws + WS_SK))
#define F_U8 ((unsigned char*)(F.ws + WS_U16))
#define F_V8 ((unsigned char*)(F.ws + WS_V16))
#define F_H ((bf16*)(F.ws + WS_H))
#define F_Z ((bf16*)(F.ws + WS_Z))
#define F_POOLED ((bf16*)(F.ws + WS_POOLED))
#define F_MIX ((bf16*)(F.ws + WS_MIX))
#define F_QP ((bf16*)(F.ws + WS_QP))
#define F_IDX ((int*)(F.ws + WS_IDX))

__device__ __forceinline__ void p0_transpose_item(const float* W, int N, bf16* WT, int ldo, LAS float* scr, int item, int lane) {
    const int nblk = N / 32, kb = item / nblk, nb = item % nblk, k0 = 64 * kb, n0 = 32 * nb;
#pragma unroll 8
    for (int i = 0; i < 32; ++i) { const int kk = 2 * i + (lane >> 5); scr[kk * 33 + (lane & 31)] = W[(size_t)(k0 + kk) * N + n0 + (lane & 31)]; }
    LDS_WAIT(); asm volatile("" ::: "memory");
    const int c = lane & 7;
#pragma unroll
    for (int j = 0; j < 4; ++j) { const int n = (lane >> 3) + 8 * j; const LAS float* s = scr + (8 * c) * 33 + n;
        v4u o; o.x = pk2(s[0 * 33], s[1 * 33]); o.y = pk2(s[2 * 33], s[3 * 33]); o.z = pk2(s[4 * 33], s[5 * 33]); o.w = pk2(s[6 * 33], s[7 * 33]);
        *(GAS v4u*)(WT + (size_t)(n0 + n) * ldo + k0 + 8 * c) = o; }
    LDS_WAIT(); asm volatile("" ::: "memory");
}
__device__ __forceinline__ float silu_f(float v) { return v / (1.f + __expf(-v)); }

__device__ __forceinline__ void p0_prologue(Frame& F) {
    LAS float* scr = (LAS float*)(F.lds + F.wave * 16384);
    const int gw = F.vcu * NWAVES + F.wave, NGW = F.G * NWAVES, lane = F.lane;
    for (int it = gw; it < 2 * 48 * 16; it += NGW) {
        const int l = it / 768, r = it % 768, cgp = r / 16, kc = r % 16;
        const float* W = F_ada_w + (size_t)l * D * MODW + (size_t)(kc * 128) * MODW + cgp * 256 + lane * 4;
        const float c0a = silu_f(F_c[kc * 128 + lane]), c0b = silu_f(F_c[kc * 128 + 64 + lane]);
        const float c1a = silu_f(F_c[D + kc * 128 + lane]), c1b = silu_f(F_c[D + kc * 128 + 64 + lane]);
        f32x4 a0 = {0.f, 0.f, 0.f, 0.f}, a1 = {0.f, 0.f, 0.f, 0.f};
#pragma unroll 8
        for (int kk = 0; kk < 64; ++kk) { const f32x4 w = *(const GAS f32x4*)(W + (size_t)kk * MODW); const float s0 = rdlane(c0a, kk), s1 = rdlane(c1a, kk); a0 += w * s0; a1 += w * s1; }
#pragma unroll 8
        for (int kk = 0; kk < 64; ++kk) { const f32x4 w = *(const GAS f32x4*)(W + (size_t)(64 + kk) * MODW); const float s0 = rdlane(c0b, kk), s1 = rdlane(c1b, kk); a0 += w * s0; a1 += w * s1; }
        float* P = F_MODP + (size_t)kc * (2 * 2 * MODW) + (size_t)(l * 2) * MODW + cgp * 256 + lane * 4;
        *(GAS f32x4*)P = a0; *(GAS f32x4*)(P + MODW) = a1;
    }
    constexpr int I_IN = 32 * 72, I_OUT = 32 * 64, I_Q = 32 * 64, I_P = 4 * 32, I_L = I_IN + I_OUT + I_Q + I_P;
    for (int it = gw; it < 2 * I_L; it += NGW) {
        const int l = it / I_L; int r = it % I_L;
        if (r < I_IN) { p0_transpose_item(F_w_in + (size_t)l * D * DIN, DIN, F_WIN + (size_t)l * DIN * D, D, scr, r, lane); continue; } r -= I_IN;
        if (r < I_OUT) { p0_transpose_item(F_w_out + (size_t)l * D * D, D, F_WOUT + (size_t)l * D * D, D, scr, r, lane); continue; } r -= I_OUT;
        if (r < I_Q) { p0_transpose_item(F_w_query + (size_t)l * D * D, D, F_WQ + (size_t)l * D * D, D, scr, r, lane); continue; } r -= I_Q;
        {
            const int g = r / 32, rr = r % 32; const float* wp = F_w_pool + (size_t)(l * 4 + g) * 65536 + rr * 2048; bf16* dst = F_WPOOL + (size_t)(l * 4 + g) * 65536 + rr * 2048;
#pragma unroll
            for (int q = 0; q < 8; ++q) { const int e = 256 * q + 4 * lane; const f32x4 v = *(const GAS f32x4*)(wp + e) * *(const GAS f32x4*)(F_pool_scale + (size_t)l * DPOOL + 256 * g + (e & 255));
                v2u w; w.x = pk2(v[0], v[1]); w.y = pk2(v[2], v[3]); *(GAS v2u*)(dst + e) = w; }
        }
    }
    {
        constexpr long NCH_SK = 65536 / 512;
        for (long ch = gw; ch < NCH_SK; ch += NGW) {
            {
                const float* src = F_sub_keys; bf16* dst = F_SK; const long o = ch;
                const f32x4 v0 = *(const GAS f32x4*)(src + o * 512 + lane * 4), v1 = *(const GAS f32x4*)(src + o * 512 + 256 + lane * 4);
                v2u w0, w1; w0.x = pk2(v0[0], v0[1]); w0.y = pk2(v0[2], v0[3]); w1.x = pk2(v1[0], v1[1]); w1.y = pk2(v1[2], v1[3]);
                *(GAS v2u*)(dst + o * 512 + lane * 4) = w0; *(GAS v2u*)(dst + o * 512 + 256 + lane * 4) = w1;
            }
        }
        for (int row = gw; row < 2 * 2 * NEXP; row += NGW) {
            const bool isu = row < 2 * NEXP; const int rr = isu ? row : row - 2 * NEXP;
            const float* src = (isu ? F_peer_u : F_peer_v) + (size_t)rr * D; unsigned char* dst = (isu ? F_U8 : F_V8) + (size_t)rr * EROW; const float sc = isu ? 64.f : 1.5f;
            f32x16 a, bq;
#pragma unroll
            for (int q = 0; q < 8; ++q) { const f32x4 v0 = *(const GAS f32x4*)(src + 4 * lane + 256 * q) * sc;
                a[2 * q] = v0[0]; bq[2 * q] = v0[1]; a[2 * q + 1] = v0[2]; bq[2 * q + 1] = v0[3]; }
            const u32x6 p = __builtin_amdgcn_cvt_scalef32_2xpk16_fp6_f32(a, bq, 1.0f);
            v4u w0; w0.x = p[0]; w0.y = p[1]; w0.z = p[2]; w0.w = p[3]; v2u w1; w1.x = p[4]; w1.y = p[5];
            *(GAS v4u*)(dst + 16 * lane) = w0; *(GAS v2u*)(dst + 1024 + 8 * lane) = w1;
        }
    }
}

__device__ __forceinline__ f32x4 mod_reduce4(Frame& F, int i) {
    const int col = i % MODW, l = i / (2 * MODW);
    f32x4 a = *(const GAS f32x4*)(F_ada_b + (size_t)l * MODW + col);
#pragma unroll 4
    for (int kc = 0; kc < 16; ++kc) a += *(const GAS f32x4*)(F_MODP + (size_t)kc * (4 * MODW) + i);
    return a;
}

__device__ __forceinline__ void norm_rows(const float* xin, bf16* hout, int r0, int nrows, const f32x4 (&av)[8], const f32x4 (&sv)[8], int lane) {
    for (int r = r0; r < r0 + nrows; ++r) {
        const GAS f32x4* xr = (const GAS f32x4*)(xin + (size_t)r * D) + lane;
        f32x4 v[8]; float ss = 0.f;
#pragma unroll
        for (int j = 0; j < 8; ++j) { v[j] = xr[64 * j]; ss += (v[j][0] * v[j][0] + v[j][1] * v[j][1]) + (v[j][2] * v[j][2] + v[j][3] * v[j][3]); }
        const float rstd = 1.f / sqrtf(wave_sum(ss) * (1.f / D) + EPS);
        GAS v2u* o = (GAS v2u*)(hout + (size_t)r * D) + lane;
#pragma unroll
        for (int j = 0; j < 8; ++j) { const f32x4 y = v[j] * rstd * av[j] + sv[j]; v2u w; w.x = pk2(y[0], y[1]); w.y = pk2(y[2], y[3]); o[64 * j] = w; }
    }
}

__device__ __forceinline__ void p1_mod_norm1(Frame& F) {
    const int gw = F.vcu * NWAVES + F.wave, lane = F.lane;
    if (gw < 192) { const int i = gw * 256 + lane * 4; *(GAS f32x4*)(F_MOD + i) = mod_reduce4(F, i); }
    const int r0 = gw * 4, b = r0 / SEQ;
    f32x4 av[8], sv[8];
#pragma unroll
    for (int j = 0; j < 8; ++j) { const int col = 4 * lane + 256 * j;
        const f32x4 sh = mod_reduce4(F, (0 * 2 + b) * MODW + 0 * D + col), sc = mod_reduce4(F, (0 * 2 + b) * MODW + 1 * D + col);
        const f32x4 g = *(const GAS f32x4*)(F_norm1_gain + col);
        av[j] = g * (sc + 1.f); sv[j] = sh; asm volatile("" ::: "memory"); }
    norm_rows(F_x, F_H, r0, 4, av, sv, lane);
}

__device__ __forceinline__ void p_norm2(Frame& F, int l) {
    const int gw = F.vcu * NWAVES + F.wave, lane = F.lane;
    const int r0 = gw * 4, b = r0 / SEQ;
    const float* mod = F_MOD + (size_t)(l * 2 + b) * MODW;
    f32x4 av[8], sv[8];
#pragma unroll
    for (int j = 0; j < 8; ++j) { const int col = 4 * lane + 256 * j;
        const f32x4 sh = *(const GAS f32x4*)(mod + 3 * D + col), sc = *(const GAS f32x4*)(mod + 4 * D + col);
        const f32x4 g = *(const GAS f32x4*)(F_norm2_gain + (size_t)l * D + col);
        av[j] = g * (sc + 1.f); sv[j] = sh; }
    norm_rows(F_X1, F_H, r0, 4, av, sv, lane);
}

__device__ __forceinline__ int t5_bucket(int rel) {
    const int n = rel < 0 ? -rel : rel; int ret = rel > 0 ? 16 : 0;
    int large = 8 + (n >= 12) + (n >= 16) + (n >= 23) + (n >= 32) + (n >= 46) + (n >= 64) + (n >= 91);
    return ret + (n < 8 ? n : large);
}
constexpr int KS_STRIDE = 72, VT_STRIDE = 196;
constexpr int ATT_KS = 0, ATT_VT = 27648, ATT_QS = 53248, ATT_TBL = ATT_QS + 8 * 9216;
static_assert(ATT_TBL + 8 * 1024 <= LDSCTL_OFF, "attention LDS map");

__device__ __forceinline__ void attn_item(Frame& F, int l, int item) {
    const int g = item & 1, n = (item >> 1) & 63, b = item >> 7;
    const int tok0 = b * SEQ + n * 64, key0 = tok0 - 128, lane = F.lane, wave = F.wave, tid = F.tid;
    LAS bf16* Ks = (LAS bf16*)(F.lds + ATT_KS); LAS bf16* Vt = (LAS bf16*)(F.lds + ATT_VT);
    LAS bf16* Qs = (LAS bf16*)(F.lds + ATT_QS + wave * 9216); LAS float* tbl = (LAS float*)(F.lds + ATT_TBL + wave * 1024);
    const int hq = g * 8 + wave;
    {
        const int c = tid & 7;
        const f32x4 kg0 = *(const GAS f32x4*)(F_k_gain + l * HD + 8 * c), kg1 = *(const GAS f32x4*)(F_k_gain + l * HD + 8 * c + 4);
#pragma unroll
        for (int i = 0; i < 3; ++i) {
            const int row = (tid >> 3) + 64 * i; int tk = key0 + row; if (tk < b * SEQ) tk = b * SEQ;
            const bf16* zr = F_Z + (size_t)tk * DIN;
            const v4u kw = *(const GAS v4u*)(zr + 2048 + g * 64 + 8 * c), vw = *(const GAS v4u*)(zr + 2176 + g * 64 + 8 * c);
            float kf[8] = {bflo(kw.x), bfhi(kw.x), bflo(kw.y), bfhi(kw.y), bflo(kw.z), bfhi(kw.z), bflo(kw.w), bfhi(kw.w)};
            float ss = 0.f;
#pragma unroll
            for (int j = 0; j < 8; ++j) ss += kf[j] * kf[j];
            ss += __shfl_xor(ss, 1); ss += __shfl_xor(ss, 2); ss += __shfl_xor(ss, 4);
            const float rstd = 1.f / sqrtf(ss * (1.f / HD) + EPS);
            v4u o; o.x = pk2(kf[0] * rstd * kg0[0], kf[1] * rstd * kg0[1]); o.y = pk2(kf[2] * rstd * kg0[2], kf[3] * rstd * kg0[3]);
            o.z = pk2(kf[4] * rstd * kg1[0], kf[5] * rstd * kg1[1]); o.w = pk2(kf[6] * rstd * kg1[2], kf[7] * rstd * kg1[3]);
            *(LAS v4u*)(Ks + row * KS_STRIDE + 8 * c) = o;
            const unsigned vv[4] = {vw.x, vw.y, vw.z, vw.w};
#pragma unroll
            for (int j = 0; j < 4; ++j) { Vt[(8 * c + 2 * j) * VT_STRIDE + row] = (bf16)(vv[j] & 0xffffu); Vt[(8 * c + 2 * j + 1) * VT_STRIDE + row] = (bf16)(vv[j] >> 16); }
        }
    }
    {
        const int c = lane & 7;
        const f32x4 qg0 = *(const GAS f32x4*)(F_q_gain + l * HD + 8 * c), qg1 = *(const GAS f32x4*)(F_q_gain + l * HD + 8 * c + 4);
#pragma unroll
        for (int i = 0; i < 8; ++i) {
            const int row = (lane >> 3) + 8 * i;
            const v4u qw = *(const GAS v4u*)(F_Z + (size_t)(tok0 + row) * DIN + 1024 + hq * 64 + 8 * c);
            float qf[8] = {bflo(qw.x), bfhi(qw.x), bflo(qw.y), bfhi(qw.y), bflo(qw.z), bfhi(qw.z), bflo(qw.w), bfhi(qw.w)};
            float ss = 0.f;
#pragma unroll
            for (int j = 0; j < 8; ++j) ss += qf[j] * qf[j];
            ss += __shfl_xor(ss, 1); ss += __shfl_xor(ss, 2); ss += __shfl_xor(ss, 4);
            const float rstd = 0.125f / sqrtf(ss * (1.f / HD) + EPS);
            v4u o; o.x = pk2(qf[0] * rstd * qg0[0], qf[1] * rstd * qg0[1]); o.y = pk2(qf[2] * rstd * qg0[2], qf[3] * rstd * qg0[3]);
            o.z = pk2(qf[4] * rstd * qg1[0], qf[5] * rstd * qg1[1]); o.w = pk2(qf[6] * rstd * qg1[2], qf[7] * rstd * qg1[3]);
            *(LAS v4u*)(Qs + row * KS_STRIDE + 8 * c) = o;
        }
#pragma unroll
        for (int i = 0; i < 4; ++i) { const int e = lane + 64 * i; if (e < 255) tbl[e] = F_rel_bias[t5_bucket(e - 191) * NQH + hq]; }
    }
    __syncthreads();
    const int r = lane & 31, h = lane >> 5;
    const int kt0 = n == 0 ? 4 : (n == 1 ? 2 : 0);
    const int dbg = F.A->pad;
    const float sink = (dbg == 0) ? F_sinks[l * NQH + hq] : -INFINITY;
    const float m0 = (dbg == 0) ? sink : -1e30f;
#pragma unroll 1
    for (int qt = 0; qt < 2; ++qt) {
        bf16x8 qf[4];
#pragma unroll
        for (int s = 0; s < 4; ++s) qf[s] = *(const LAS bf16x8*)(Qs + (32 * qt + r) * KS_STRIDE + 16 * s + 8 * h);
        f32x16 acc[6];
#pragma unroll
        for (int kt = 0; kt < 6; ++kt) {
#pragma unroll
            for (int i = 0; i < 16; ++i) acc[kt][i] = 0.f;
#pragma unroll
            for (int s = 0; s < 4; ++s) { const bf16x8 a = *(const LAS bf16x8*)(Ks + (32 * kt + r) * KS_STRIDE + 16 * s + 8 * h);
                acc[kt] = __builtin_amdgcn_mfma_f32_32x32x16_bf16(a, qf[s], acc[kt], 0, 0, 0); }
            asm volatile("" ::: "memory");
        }
        const int a = 32 * qt + r; float m = m0;
#pragma unroll
        for (int kt = 0; kt < 6; ++kt) {
#pragma unroll
            for (int i = 0; i < 16; ++i) { const int bk = 32 * kt + (i & 3) + 8 * (i >> 2) + 4 * h; float s = (dbg == 1 ? 0.f : acc[kt][i]) + ((dbg == 0 || dbg == 3) ? tbl[bk - a + 63] : 0.f); if (kt < kt0) s = -INFINITY; acc[kt][i] = s; m = fmaxf(m, s); }
            asm volatile("" ::: "memory");
        }
        m = fmaxf(m, __shfl_xor(m, 32));
        float sum = 0.f;
#pragma unroll
        for (int kt = 0; kt < 6; ++kt)
#pragma unroll
            for (int i = 0; i < 16; ++i) { const float p = __expf(acc[kt][i] - m); acc[kt][i] = p; sum += p; }
        sum += __shfl_xor(sum, 32); sum += __expf(sink - m);
        const float inv = 1.f / sum;
        f32x16 o[2];
#pragma unroll
        for (int dt = 0; dt < 2; ++dt) {
#pragma unroll
            for (int i = 0; i < 16; ++i) o[dt][i] = 0.f;
        }
#pragma unroll
        for (int kt = 0; kt < 6; ++kt)
#pragma unroll
            for (int s2 = 0; s2 < 2; ++s2) {
                v4u pw; pw.x = pk2(acc[kt][8 * s2 + 0], acc[kt][8 * s2 + 1]); pw.y = pk2(acc[kt][8 * s2 + 2], acc[kt][8 * s2 + 3]);
                pw.z = pk2(acc[kt][8 * s2 + 4], acc[kt][8 * s2 + 5]); pw.w = pk2(acc[kt][8 * s2 + 6], acc[kt][8 * s2 + 7]);
                const bf16x8 pb = __builtin_bit_cast(bf16x8, pw);
#pragma unroll
                for (int dt = 0; dt < 2; ++dt) {
                    const LAS bf16* vp = Vt + (32 * dt + r) * VT_STRIDE + 32 * kt + 16 * s2 + 4 * h;
                    const v2u lo = *(const LAS v2u*)vp, hi = *(const LAS v2u*)(vp + 8);
                    v4u aw; aw.x = lo.x; aw.y = lo.y; aw.z = hi.x; aw.w = hi.y;
                    o[dt] = __builtin_amdgcn_mfma_f32_32x32x16_bf16(__builtin_bit_cast(bf16x8, aw), pb, o[dt], 0, 0, 0);
                }
                asm volatile("" ::: "memory");
            }
        bf16* orow = F_MIX + (size_t)(tok0 + a) * D + 1024 + hq * 64;
#pragma unroll
        for (int dt = 0; dt < 2; ++dt)
#pragma unroll
            for (int q4 = 0; q4 < 4; ++q4) { v2u w; w.x = pk2(o[dt][4 * q4] * inv, o[dt][4 * q4 + 1] * inv); w.y = pk2(o[dt][4 * q4 + 2] * inv, o[dt][4 * q4 + 3] * inv);
                *(GAS v2u*)(orow + 32 * dt + 8 * q4 + 4 * h) = w; }
    }
    __syncthreads();
}

__device__ __forceinline__ void pool_item(Frame& F, int item) {
    const int g = item & 3, tt = (item >> 2) & 255, b = item >> 10, lane = F.lane;
    const int w = 2 << g, t0 = tt * 16;
    const bf16* zb = F_Z + (size_t)(b * SEQ) * DIN + 256 * g + 4 * lane;
    f32x4 rows[32];
#pragma unroll
    for (int i = 0; i < 32; ++i) { const int t = t0 - 16 + i; v2u pw = {0u, 0u}; if (t >= 0) pw = *(const GAS v2u*)(zb + (size_t)t * DIN);
        rows[i] = (f32x4){bflo(pw.x), bfhi(pw.x), bflo(pw.y), bfhi(pw.y)}; }
    f32x4 S = {0.f, 0.f, 0.f, 0.f};
#pragma unroll
    for (int j = 1; j <= 16; ++j) if (j <= w) S += rows[16 - j];
#pragma unroll
    for (int i = 0; i < 16; ++i) {
        const int t = t0 + i; const f32x4 pt = rows[16 + i];
        f32x4 old = rows[16 + i - 2];
        if (w == 4) old = rows[16 + i - 4]; else if (w == 8) old = rows[16 + i - 8]; else if (w == 16) old = rows[i];
        S += pt; S -= old;
        const float ic = 1.f / (float)((t + 1) < w ? (t + 1) : w);
        const f32x4 y = S * ic - pt;
        v2u o; o.x = pk2(y[0], y[1]); o.y = pk2(y[2], y[3]);
        *(GAS v2u*)(F_MIX + (size_t)(b * SEQ + t) * D + 256 * g + 4 * lane) = o;
    }
}

constexpr int SK_STRIDE = 136;
constexpr int TK_SK = 0, TK_TAB = 2 * 128 * SK_STRIDE * 2;
struct CandTab { unsigned char v[128]; };
constexpr CandTab make_cand_tab() { CandTab t{}; int s = 0; for (int a = 0; a < 16; ++a) for (int b = 0; b < 16; ++b) if ((a + 1) * (b + 1) <= 16) { t.v[s] = (unsigned char)a; t.v[64 + s] = (unsigned char)b; ++s; }
    for (; s < 64; ++s) { t.v[s] = 255; t.v[64 + s] = 255; } return t; }
__device__ const CandTab g_cand_tab = make_cand_tab();
__device__ __forceinline__ int ford(float x) { const int b = __builtin_bit_cast(int, x); return b ^ ((b >> 31) & 0x7fffffff); }
__device__ __forceinline__ float fdeord(int k) { return __builtin_bit_cast(float, k ^ ((k >> 31) & 0x7fffffff)); }
template <int CTRL> __device__ __forceinline__ int dppi(int v) { return __builtin_amdgcn_update_dpp(v, v, CTRL, 0xf, 0xf, false); }
__device__ __forceinline__ int row_allmax(int v) {
    v = max(v, dppi<0x128>(v)); v = max(v, dppi<0x124>(v)); v = max(v, dppi<0x122>(v)); v = max(v, dppi<0x121>(v)); return v;
}
__device__ __forceinline__ float row_allsum(float v) {
    v += __builtin_bit_cast(float, dppi<0x128>(__builtin_bit_cast(int, v))); v += __builtin_bit_cast(float, dppi<0x124>(__builtin_bit_cast(int, v)));
    v += __builtin_bit_cast(float, dppi<0x122>(__builtin_bit_cast(int, v))); v += __builtin_bit_cast(float, dppi<0x121>(__builtin_bit_cast(int, v))); return v;
}
__device__ __forceinline__ int bperm(int srclane, int v) { return __builtin_amdgcn_ds_bpermute(srclane << 2, v); }

__device__ __forceinline__ void row_allmax4(int& a, int& b, int& c, int& d) {
    int a1, b1, c1, d1;
    asm volatile("s_nop 1\n\t"
        "v_max_i32_dpp %0, %4, %4 row_ror:8 row_mask:0xf bank_mask:0xf\n\tv_max_i32_dpp %1, %5, %5 row_ror:8 row_mask:0xf bank_mask:0xf\n\tv_max_i32_dpp %2, %6, %6 row_ror:8 row_mask:0xf bank_mask:0xf\n\tv_max_i32_dpp %3, %7, %7 row_ror:8 row_mask:0xf bank_mask:0xf\n\t"
        "v_max_i32_dpp %0, %0, %0 row_ror:4 row_mask:0xf bank_mask:0xf\n\tv_max_i32_dpp %1, %1, %1 row_ror:4 row_mask:0xf bank_mask:0xf\n\tv_max_i32_dpp %2, %2, %2 row_ror:4 row_mask:0xf bank_mask:0xf\n\tv_max_i32_dpp %3, %3, %3 row_ror:4 row_mask:0xf bank_mask:0xf\n\t"
        "v_max_i32_dpp %0, %0, %0 row_ror:2 row_mask:0xf bank_mask:0xf\n\tv_max_i32_dpp %1, %1, %1 row_ror:2 row_mask:0xf bank_mask:0xf\n\tv_max_i32_dpp %2, %2, %2 row_ror:2 row_mask:0xf bank_mask:0xf\n\tv_max_i32_dpp %3, %3, %3 row_ror:2 row_mask:0xf bank_mask:0xf\n\t"
        "v_max_i32_dpp %0, %0, %0 row_ror:1 row_mask:0xf bank_mask:0xf\n\tv_max_i32_dpp %1, %1, %1 row_ror:1 row_mask:0xf bank_mask:0xf\n\tv_max_i32_dpp %2, %2, %2 row_ror:1 row_mask:0xf bank_mask:0xf\n\tv_max_i32_dpp %3, %3, %3 row_ror:1 row_mask:0xf bank_mask:0xf\n\t"
        "s_nop 1"
        : "=&v"(a1), "=&v"(b1), "=&v"(c1), "=&v"(d1) : "v"(a), "v"(b), "v"(c), "v"(d));
    a = a1; b = b1; c = c1; d = d1;
}
#define TK_CE(a, b) do { const int _hi = max(a, b), _lo = min(a, b); a = _hi; b = _lo; } while (0)
__device__ __forceinline__ void sort8_desc(int (&k)[8]) {
    TK_CE(k[0], k[1]); TK_CE(k[2], k[3]); TK_CE(k[4], k[5]); TK_CE(k[6], k[7]);
    TK_CE(k[0], k[2]); TK_CE(k[1], k[3]); TK_CE(k[4], k[6]); TK_CE(k[5], k[7]);
    TK_CE(k[1], k[2]); TK_CE(k[5], k[6]); TK_CE(k[0], k[4]); TK_CE(k[3], k[7]);
    TK_CE(k[1], k[5]); TK_CE(k[2], k[6]);
    TK_CE(k[1], k[4]); TK_CE(k[3], k[6]);
    TK_CE(k[2], k[4]); TK_CE(k[3], k[5]);
    TK_CE(k[3], k[4]);
}
__device__ __forceinline__ void sort4_desc(int (&k)[4]) {
    TK_CE(k[0], k[1]); TK_CE(k[2], k[3]); TK_CE(k[0], k[2]); TK_CE(k[1], k[3]); TK_CE(k[1], k[2]);
}

__device__ __forceinline__ void p_topk(Frame& F, int l) {
    const int gw = F.vcu * NWAVES + F.wave, lane = F.lane, tid = F.tid;
    LAS bf16* SKs = (LAS bf16*)(F.lds + TK_SK); LAS unsigned char* tab = F.lds + TK_TAB;
    {
        const bf16* src = F_SK + (size_t)l * 32768;
#pragma unroll
        for (int i = 0; i < 8; ++i) { const int ch = tid + 512 * i; const int row = ch >> 4, c = ch & 15;
            *(LAS v4u*)(SKs + row * SK_STRIDE + 8 * c) = *(const GAS v4u*)(src + row * 128 + 8 * c); }
        if (tid < 128) tab[tid] = g_cand_tab.v[tid];
    }
    __syncthreads();
    const int r = lane & 15, q4 = lane >> 4, rowbase = lane & ~15;
    int ca[4], cb[4];
#pragma unroll
    for (int j = 0; j < 4; ++j) { ca[j] = tab[4 * r + j]; cb[j] = tab[64 + 4 * r + j]; }
    bf16x8 afr[2][2][4];
#pragma unroll
    for (int u = 0; u < 2; ++u) { const int unit = 2 * gw + u; const int t0 = 2 * unit;
        const bf16* qrow = F_QP + (size_t)(t0 + (r >> 3)) * D + (r & 7) * 256 + 8 * q4;
#pragma unroll
        for (int p = 0; p < 2; ++p)
#pragma unroll
            for (int ks = 0; ks < 4; ++ks) afr[u][p][ks] = *(const GAS bf16x8*)(qrow + p * 128 + 32 * ks); }
#pragma unroll
    for (int u = 0; u < 2; ++u) {
        LAS int* hoI = (LAS int*)(F.lds + 8 * (8448 + 2048 + 2048) + F.wave * 4096); LAS float* hoG = (LAS float*)(hoI + 512);
        int res[2][4];
#pragma unroll
        for (int p = 0; p < 2; ++p) {
            f32x4 acc[8];
#pragma unroll
            for (int nt = 0; nt < 8; ++nt) acc[nt] = (f32x4){0.f, 0.f, 0.f, 0.f};
#pragma unroll
            for (int ks = 0; ks < 4; ++ks) {
#pragma unroll
                for (int nt = 0; nt < 8; ++nt) { const bf16x8 bq = *(const LAS bf16x8*)(SKs + (p * 128 + 16 * nt + r) * SK_STRIDE + 32 * ks + 8 * q4);
                    acc[nt] = __builtin_amdgcn_mfma_f32_16x16x32_bf16(afr[u][p][ks], bq, acc[nt], 0, 0, 0); }
                asm volatile("" ::: "memory"); }
            int key[4][8];
#pragma unroll
            for (int i = 0; i < 4; ++i) {
#pragma unroll
                for (int nt = 0; nt < 8; ++nt) key[i][nt] = (ford(acc[nt][i]) & ~127) | (127 - (16 * nt + r));
                sort8_desc(key[i]);
            }
            int mine[4] = {0, 0, 0, 0};
#pragma unroll 1
            for (int rd = 0; rd < 16; ++rd) {
                int mm[4] = {key[0][0], key[1][0], key[2][0], key[3][0]};
                row_allmax4(mm[0], mm[1], mm[2], mm[3]);
#pragma unroll
                for (int i = 0; i < 4; ++i) {
                    const int m = mm[i];
                    if (r == rd) mine[i] = m;
                    const bool won = (key[i][0] == m);
#pragma unroll
                    for (int nt = 0; nt < 7; ++nt) key[i][nt] = won ? key[i][nt + 1] : key[i][nt];
                    key[i][7] = won ? (int)0x80000000 : key[i][7];
                }
            }
#pragma unroll
            for (int i = 0; i < 4; ++i) res[p][i] = mine[i];
        }
        int ck[4][4];
#pragma unroll
        for (int i = 0; i < 4; ++i) {
#pragma unroll
            for (int j = 0; j < 4; ++j) {
                const int va = bperm(rowbase + (ca[j] & 15), res[0][i]), vb = bperm(rowbase + (cb[j] & 15), res[1][i]);
                const float s = fdeord(va & ~127) + fdeord(vb & ~127);
                ck[i][j] = (ca[j] == 255) ? (int)0x80000000 : ((ford(s) & ~63) | (63 - (4 * r + j)));
            }
            sort4_desc(ck[i]);
        }
        int mine2[4] = {0, 0, 0, 0};
#pragma unroll 1
        for (int rd = 0; rd < 16; ++rd) {
            int mm[4] = {ck[0][0], ck[1][0], ck[2][0], ck[3][0]};
            row_allmax4(mm[0], mm[1], mm[2], mm[3]);
#pragma unroll
            for (int i = 0; i < 4; ++i) {
                const int m = mm[i];
                if (r == rd) mine2[i] = m;
                const bool won = (ck[i][0] == m);
                ck[i][0] = won ? ck[i][1] : ck[i][0]; ck[i][1] = won ? ck[i][2] : ck[i][1]; ck[i][2] = won ? ck[i][3] : ck[i][2]; ck[i][3] = won ? (int)0x80000000 : ck[i][3];
            }
        }
#pragma unroll
        for (int i = 0; i < 4; ++i) {
            const int slot = 63 - (mine2[i] & 63);
            const int a = tab[slot], bb = tab[64 + slot];
            const int va = bperm(rowbase + a, res[0][i]), vb = bperm(rowbase + bb, res[1][i]);
            const float s = fdeord(va & ~127) + fdeord(vb & ~127);
            const int eidx = (127 - (va & 127)) * 128 + (127 - (vb & 127));
            const float smax = __builtin_bit_cast(float, bperm(rowbase, __builtin_bit_cast(int, s)));
            const float ev = __expf(s - smax);
            const float gate = ev / row_allsum(ev);
            const int row = 4 * q4 + i, tl = 2 * u + (row >> 3), hh = row & 7;
            hoI[tl * 128 + hh * 16 + r] = eidx; hoG[tl * 128 + hh * 16 + r] = gate;
        }
    }
}
#undef TK_CE

__device__ __forceinline__ float gelu_exact(float v) { return 0.5f * v * (1.f + erff(v * 0.70710678118654752f)); }

typedef float f32x2 __attribute__((ext_vector_type(2)));
__device__ __forceinline__ f32x2 fp8lo(unsigned w) { return __builtin_amdgcn_cvt_pk_f32_fp8((int)w, false); }
__device__ __forceinline__ f32x2 fp8hi(unsigned w) { return __builtin_amdgcn_cvt_pk_f32_fp8((int)w, true); }

template <int NR>
__device__ __forceinline__ void bitonic_sort(int (&key)[NR], int lane) {
#pragma unroll
    for (int k = 2; k <= NR * 64; k <<= 1) {
#pragma unroll
        for (int j = k >> 1; j > 0; j >>= 1) {
            if (j >= 64) {
                const int jr = j >> 6;
#pragma unroll
                for (int r = 0; r < NR; ++r) if ((r & jr) == 0) {
                    const bool asc = (((r * 64) & k) == 0);
                    const int a = key[r], b = key[r | jr]; const int lo = min(a, b), hi = max(a, b);
                    key[r] = asc ? lo : hi; key[r | jr] = asc ? hi : lo;
                }
            } else {
#pragma unroll
                for (int r = 0; r < NR; ++r) {
                    const bool asc = (((r * 64 + lane) & k) == 0), lower = ((lane & j) == 0);
                    const int other = __shfl_xor(key[r], j);
                    key[r] = (asc == lower) ? min(key[r], other) : max(key[r], other);
                }
            }
        }
    }
}

constexpr int PEER_LDS_PER_WAVE = 8448 + 2048 + 2048;
constexpr int HO_OFF = 8 * PEER_LDS_PER_WAVE;
static_assert(HO_OFF + 8 * 4096 <= LDSCTL_OFF, "peer LDS map");
#ifndef PEER_NT
#define PEER_NT 2
#endif
#ifndef PEER_SYNC
#define PEER_SYNC 0
#endif
#ifndef PEER_LSYNC
#define PEER_LSYNC 1
#endif
#ifndef PEER_RDU
#define PEER_RDU 8
#endif
#ifndef PEER_RDV
#define PEER_RDV 8
#endif
#define PEER_SWITCH(tj, M) do { if (NT == 1) { M(0) } else if (NT == 2) { if ((tj) == 0) { M(0) } else { M(NT > 1 ? 1 : 0) } } \
    else { switch (tj) { case 0: M(0) break; case 1: M(NT > 1 ? 1 : 0) break; case 2: M(NT > 2 ? 2 : 0) break; default: M(NT > 3 ? 3 : 0) break; } } } while (0)
__device__ __forceinline__ void p_peer(Frame& F, int l, const XcdBarrier& bar, bool use_bar, unsigned& lgen) {
    constexpr int NT = PEER_NT, NR = NT * 2;
    const int gw = F.vcu * NWAVES + F.wave, lane = F.lane;
    LAS float* sc = (LAS float*)(F.lds + F.wave * PEER_LDS_PER_WAVE);
    LAS int* keysL = (LAS int*)(F.lds + F.wave * PEER_LDS_PER_WAVE + 8448);
    LAS float* actL = (LAS float*)(F.lds + F.wave * PEER_LDS_PER_WAVE + 8448 + 2048);
    const unsigned char* U = F_U8 + (size_t)l * NEXP * EROW; const unsigned char* V = F_V8 + (size_t)l * NEXP * EROW;
    const float* xin = F_X1; float* xout = (l == 0) ? F_XA : F_out;
    const LAS int* hoI = (const LAS int*)(F.lds + HO_OFF + F.wave * 4096); const LAS float* hoG = (const LAS float*)(hoI + 512);
#pragma unroll 1
    for (int pass = 0; pass < 4 / NT; ++pass) {
    const int t0 = gw * 4 + pass * NT, b = t0 / SEQ;
    {
        int key[NR];
#pragma unroll
        for (int j = 0; j < NR; ++j) key[j] = (hoI[(pass * NT + (j >> 1)) * 128 + (j & 1) * 64 + lane] << 9) | (j * 64 + lane);
        bitonic_sort<NR>(key, lane);
#pragma unroll
        for (int j = 0; j < NR; ++j) keysL[j * 64 + lane] = key[j];
    }
    LDS_WAIT(); asm volatile("" ::: "memory");
#define PEER_ROWLOAD(TAB, kk, d) do { const unsigned char* _rp = (TAB) + (size_t)((kk) >> 9) * EROW; Ra[d] = *(const GAS v4u*)(_rp + 16 * lane); Rb[d] = *(const GAS v2u*)(_rp + 1024 + 8 * lane); } while (0)
#define PEER_DECODE(d) const u32x6 _pk = {Ra[d].x, Ra[d].y, Ra[d].z, Ra[d].w, Rb[d].x, Rb[d].y}; const f32x32 rr = __builtin_amdgcn_cvt_scalef32_pk32_f32_fp6(_pk, 1.0f)
    if (use_bar && PEER_LSYNC) xcd_light_sync(bar, lgen);
    if (use_bar && PEER_SYNC && pass > 0) xcd_barrier(bar);
    {
        constexpr int RD = PEER_RDU, NLB = 64 / RD, LBR = 32 / RD;
        f32x2 hv[NT][16];
#pragma unroll
        for (int tj = 0; tj < NT; ++tj)
#pragma unroll
            for (int q = 0; q < 8; ++q) { const v2u w = *(const GAS v2u*)(F_H + (size_t)(t0 + tj) * D + 4 * lane + 256 * q);
                hv[tj][2 * q] = (f32x2){bflo(w.x), bfhi(w.x)}; hv[tj][2 * q + 1] = (f32x2){bflo(w.y), bfhi(w.y)}; }
        v4u Ra[RD]; v2u Rb[RD];
        int kv = keysL[lane];
#pragma unroll
        for (int d = 0; d < RD; ++d) { const int kk = __builtin_amdgcn_readlane(kv, d); PEER_ROWLOAD(U, kk, d); }
#pragma unroll 1
        for (int b64 = 0; b64 < NR; ++b64) {
            const int kvn = keysL[(b64 < NR - 1 ? b64 + 1 : NR - 1) * 64 + lane];
#pragma unroll 1
            for (int lb = 0; lb < NLB; ++lb) {
                const bool lastb = (lb == NLB - 1); const int srcv = lastb ? kvn : kv; const int nbase = lastb ? 0 : (lb + 1) * RD;
#pragma unroll
                for (int d = 0; d < RD; ++d) {
                    const int kc = __builtin_amdgcn_readlane(kv, lb * RD + d); const int tj = (kc >> 7) & 3;
                    PEER_DECODE(d);
                    f32x2 p0 = {0.f, 0.f}, p1 = {0.f, 0.f};
#define PEER_DOT(TJ) { _Pragma("unroll") for (int q = 0; q < 8; ++q) { p0 += (f32x2){rr[4 * q], rr[4 * q + 1]} * hv[TJ][2 * q]; p1 += (f32x2){rr[4 * q + 2], rr[4 * q + 3]} * hv[TJ][2 * q + 1]; } }
                    PEER_SWITCH(tj, PEER_DOT);
#undef PEER_DOT
                    sc[((lb % LBR) * RD + d) * 65 + lane] = (p0[0] + p0[1]) + (p1[0] + p1[1]);
                    const int kn = __builtin_amdgcn_readlane(srcv, nbase + d);
                    PEER_ROWLOAD(U, kn, d);
                }
                if ((lb % LBR) == LBR - 1) {
                    LDS_WAIT(); asm volatile("" ::: "memory");
                    float s = 0.f; const int k = lane & 31, part = lane >> 5;
#pragma unroll
                    for (int x = 0; x < 32; ++x) s += sc[k * 65 + 32 * part + x];
                    s += __shfl_xor(s, 32);
                    if (part == (lb / LBR)) actL[kv & 511] = s;
                    LDS_WAIT(); asm volatile("" ::: "memory");
                }
            }
            kv = kvn;
        }
    }
    LDS_WAIT(); asm volatile("" ::: "memory");
#pragma unroll
    for (int j = 0; j < NR; ++j) { const int pid = j * 64 + lane; const float g = hoG[(pass * NT + (j >> 1)) * 128 + (j & 1) * 64 + lane];
        actL[pid] = gelu_exact(actL[pid] * (1.f / 64.f)) * g * (1.f / 1.5f); }
    LDS_WAIT(); asm volatile("" ::: "memory");
    if (use_bar && PEER_LSYNC) xcd_light_sync(bar, lgen);
    if (use_bar && PEER_SYNC) xcd_barrier(bar);
    f32x2 o[NT][16];
#pragma unroll
    for (int tj = 0; tj < NT; ++tj)
#pragma unroll
        for (int i = 0; i < 16; ++i) o[tj][i] = (f32x2){0.f, 0.f};
    {
        constexpr int RD = PEER_RDV, NLB = 64 / RD;
        v4u Ra[RD]; v2u Rb[RD];
        int kv = keysL[lane];
#pragma unroll
        for (int d = 0; d < RD; ++d) { const int kk = __builtin_amdgcn_readlane(kv, d); PEER_ROWLOAD(V, kk, d); }
#pragma unroll 1
        for (int b64 = 0; b64 < NR; ++b64) {
            const int kvn = keysL[(b64 < NR - 1 ? b64 + 1 : NR - 1) * 64 + lane];
            const float av = actL[kv & 511];
#pragma unroll 1
            for (int lb = 0; lb < NLB; ++lb) {
                const bool lastb = (lb == NLB - 1); const int srcv = lastb ? kvn : kv; const int nbase = lastb ? 0 : (lb + 1) * RD;
#pragma unroll
                for (int d = 0; d < RD; ++d) {
                    const int kc = __builtin_amdgcn_readlane(kv, lb * RD + d); const int tj = (kc >> 7) & 3;
                    const float a = rdlane(av, lb * RD + d); const f32x2 a2 = {a, a};
                    PEER_DECODE(d);
#define PEER_FMA(TJ) { _Pragma("unroll") for (int q = 0; q < 8; ++q) { o[TJ][2 * q] += a2 * (f32x2){rr[4 * q], rr[4 * q + 1]}; o[TJ][2 * q + 1] += a2 * (f32x2){rr[4 * q + 2], rr[4 * q + 3]}; } }
                    PEER_SWITCH(tj, PEER_FMA);
#undef PEER_FMA
                    const int kn = __builtin_amdgcn_readlane(srcv, nbase + d);
                    PEER_ROWLOAD(V, kn, d);
                }
            }
            kv = kvn;
        }
    }
#undef PEER_ROWLOAD
#undef PEER_DECODE
    const float* mod = F_MOD + (size_t)(l * 2 + b) * MODW;
#pragma unroll
    for (int tj = 0; tj < NT; ++tj) {
        const int t = t0 + tj;
        float ss = 0.f;
#pragma unroll
        for (int q = 0; q < 8; ++q) {
            const int col = 4 * lane + 256 * q;
            const f32x4 xa = *(const GAS f32x4*)(xin + (size_t)t * D + col), ga = *(const GAS f32x4*)(mod + 5 * D + col);
            f32x4 y; y[0] = xa[0] + ga[0] * o[tj][2 * q][0]; y[1] = xa[1] + ga[1] * o[tj][2 * q][1]; y[2] = xa[2] + ga[2] * o[tj][2 * q + 1][0]; y[3] = xa[3] + ga[3] * o[tj][2 * q + 1][1];
            o[tj][2 * q] = (f32x2){y[0], y[1]}; o[tj][2 * q + 1] = (f32x2){y[2], y[3]};
            ss += (y[0] * y[0] + y[1] * y[1]) + (y[2] * y[2] + y[3] * y[3]);
            *(GAS f32x4*)(xout + (size_t)t * D + col) = y;
        }
        if (l == 0) {
            const float rstd = 1.f / sqrtf(wave_sum(ss) * (1.f / D) + EPS);
            const float* mod1 = F_MOD + (size_t)(1 * 2 + b) * MODW;
#pragma unroll
            for (int q = 0; q < 8; ++q) {
                const int col = 4 * lane + 256 * q;
                const f32x4 sh = *(const GAS f32x4*)(mod1 + 0 * D + col), scv = *(const GAS f32x4*)(mod1 + 1 * D + col), gn = *(const GAS f32x4*)(F_norm1_gain + D + col);
                float y[4];
#pragma unroll
                for (int e = 0; e < 4; ++e) y[e] = o[tj][2 * q + (e >> 1)][e & 1] * rstd * gn[e] * (1.f + scv[e]) + sh[e];
                v2u w; w.x = pk2(y[0], y[1]); w.y = pk2(y[2], y[3]);
                *(GAS v2u*)(F_H + (size_t)t * D + col) = w;
            }
        }
        asm volatile("" ::: "memory");
    }
    }
}

#ifndef PROBE_PH
#define PROBE_PH -1
#endif
__device__ __forceinline__ void ph_fold(Frame& F) {
    if (blockIdx.x < 64) {
        const int l = blockIdx.x >> 5, r = blockIdx.x & 31, gidx = r >> 3, pm = r & 7;
        int Kp = 256; asm volatile("" : "+s"(Kp));
        bf16* W = F_WOUT + (size_t)l * D * D;
        pg8::Gemm g{W + 256 * gidx, F_WPOOL + (size_t)(l * 4 + gidx) * 65536, D, 256, Kp, D, 256}; pg8::OneUnit S{pm};
        pg8::EpiBf16S E{W, D, 256 * gidx, nullptr};
        pg8::gemm_phase<pg8::EpiBf16S, pg8::OneUnit, false, true>(F.lds, g, S, E);
    }
}
__device__ __forceinline__ void ph_win(Frame& F, int l) {
    pg8::Gemm g{F_H, F_WIN + (size_t)l * DIN * D, T, DIN, D, D, D}; pg8::StaticOrder S; S.init(T, DIN, F.G, (int)blockIdx.x);
    pg8::EpiBf16S E{F_Z, DIN, 0, nullptr};
    pg8::gemm_phase<pg8::EpiBf16S, pg8::StaticOrder, true, true>(F.lds, g, S, E);
}
__device__ __forceinline__ void ph_attn(Frame& F, int l) {
    for (int it = blockIdx.x; it < 256; it += F.G) attn_item(F, l, it);
    for (int it = F.vcu * NWAVES + F.wave; it < 2048; it += F.G * NWAVES) pool_item(F, it);
}
__device__ __forceinline__ void ph_wout(Frame& F, int l) {
    pg8::Gemm g{F_MIX, F_WOUT + (size_t)l * D * D, T, D, D, D, D}; pg8::StaticOrder S; S.init(T, D, F.G, (int)blockIdx.x);
    pg8::EpiResid E{l == 0 ? F_x : F_XA, F_X1, F_MOD + (size_t)(l * 2) * MODW + 2 * D, MODW};
    pg8::gemm_phase<pg8::EpiResid, pg8::StaticOrder, false, true>(F.lds, g, S, E);
}
__device__ __forceinline__ void ph_wq(Frame& F, int l) {
    pg8::Gemm g{F_H, F_WQ + (size_t)l * D * D, T, D, D, D, D}; pg8::StaticOrder S; S.init(T, D, F.G, (int)blockIdx.x);
    pg8::EpiBf16S E{F_QP, D, 0, nullptr};
    pg8::gemm_phase<pg8::EpiBf16S, pg8::StaticOrder, false, true>(F.lds, g, S, E);
}

constexpr int N_PHASES = 14;
__global__ void __launch_bounds__(NWAVES * 64, 2) mk_fwd(Args args) {
    extern __shared__ __attribute__((aligned(16))) unsigned char lds[];
    Frame F;
    F.lds = (LAS unsigned char*)lds;
    F.tid = threadIdx.x; F.lane = F.tid & 63; F.wave = __builtin_amdgcn_readfirstlane(F.tid >> 6);
    F.G = gridDim.x; { const int bx = blockIdx.x; F.vcu = (F.G % 8 == 0) ? (bx % 8) * (F.G / 8) + bx / 8 : bx; }
    F.A = &args; F.ws = args.ws;
    unsigned char* ws = args.ws;
    volatile LAS unsigned* MISC = (volatile LAS unsigned*)(F.lds + LDSCTL_OFF);
    for (int u = F.tid; u < (LDS_BYTES - LDSCTL_OFF) / 4; u += NWAVES * 64) ((LAS unsigned*)(F.lds + LDSCTL_OFF))[u] = 0u;
    __syncthreads();
    const int lo = args.ph_lo, hi = args.ph_hi;
    XcdBarrier bar; bar.bar = (unsigned*)(ws + WS_CTL) + CW_BAR; bar.x = 0; bar.st = nullptr;
    if (hi - lo > 1) bar = xcd_barrier_post((unsigned*)(ws + WS_CTL) + CW_BAR, MISC + 8);
    bool first_seam = args.coop != 0; unsigned lgen = 0u;
#define SEAM() do { if (first_seam) { cg::this_grid().sync(); first_seam = false; } else xcd_barrier(bar); } while (0)
#define RUN(k, ...) do { if (lo <= (k) && (k) < hi) { __VA_ARGS__; if ((k) + 1 < hi) SEAM(); } } while (0)
    RUN(0, p0_prologue(F));
    RUN(1, ph_fold(F); p1_mod_norm1(F));
#define LAYER(l, base) \
    RUN(base + 0, ph_win(F, (l))); \
    RUN(base + 1, ph_attn(F, (l))); \
    RUN(base + 2, ph_wout(F, (l))); \
    RUN(base + 3, p_norm2(F, (l))); \
    RUN(base + 4, ph_wq(F, (l))); \
    RUN(base + 5, p_topk(F, (l)); __syncthreads(); p_peer(F, (l), bar, hi - lo > 1, lgen));
    LAYER(0, 2)
    LAYER(1, 8)
#undef LAYER
#undef RUN
#undef SEAM
}


#ifndef MK_DIAG
#define MK_DIAG 0
#endif
#if MK_DIAG
constexpr size_t WS_DIAG = 3 * MiB;
__device__ __forceinline__ float bf2f(bf16 v) { return __builtin_bit_cast(float, (unsigned)v << 16); }
__device__ __forceinline__ float block_sum(float v, float* red) {
    v = wave_sum(v); __syncthreads(); if ((threadIdx.x & 63) == 0) red[threadIdx.x >> 6] = v; __syncthreads();
    const float r = red[0] + red[1] + red[2] + red[3]; __syncthreads(); return r;
}
__device__ __forceinline__ void diag_max(float* slot, float d) { if (!(d == d)) d = 1e9f; atomicMax((unsigned*)slot, __builtin_bit_cast(unsigned, d < 0 ? 0.f : d)); }
__device__ __forceinline__ unsigned hsh(unsigned x) { x ^= x >> 16; x *= 0x7feb352du; x ^= x >> 15; x *= 0x846ca68bu; x ^= x >> 16; return x; }
__device__ __forceinline__ int sample_tok(int s) { const int special[8] = {0, 5, 63, 64, 130, 4095, 4096, 8191}; return s < 8 ? special[s] : (int)(hsh(s * 7919u + 13u) % T); }
__device__ __forceinline__ float gelu_d(float v) { return 0.5f * v * (1.f + erff(v * 0.70710678118654752f)); }

__global__ void __launch_bounds__(256) diag_kernel(Args args, int stage, int l, int dbg = 0, int slot_override = 0) {
    __shared__ float red[4]; __shared__ float sh[768]; __shared__ int shi[512];
    const int s = blockIdx.x, tid = threadIdx.x; unsigned char* ws = args.ws;
    float* slots = (float*)(ws + WS_DIAG);
    const float* MOD = (const float*)(ws + WS_MOD); const bf16* H = (const bf16*)(ws + WS_H); const bf16* Z = (const bf16*)(ws + WS_Z);
    const bf16* POOLED = (const bf16*)(ws + WS_POOLED); const bf16* MIX = (const bf16*)(ws + WS_MIX); const float* X1 = (const float*)(ws + WS_X1);
    const float* XA = (const float*)(ws + WS_XA); const bf16* QP = (const bf16*)(ws + WS_QP); const int* IDX = (const int*)(ws + WS_IDX); const float* GATE = (const float*)(ws + WS_GATE);
    const int t = sample_tok(s), b = t / SEQ; const unsigned hr = hsh(s * 31u + stage * 1009u + 7u);
    if (stage == 1) {
        { const int j = hr % MODW; const int ll = (hr >> 16) & 1, bb = (hr >> 17) & 1; float a = 0.f;
          for (int k = tid; k < D; k += 256) { const float c = args.in[1][bb * D + k]; a += c / (1.f + expf(-c)) * args.in[3][(size_t)ll * D * MODW + (size_t)k * MODW + j]; }
          a = block_sum(a, red) + args.in[4][ll * MODW + j];
          if (tid == 0) diag_max(slots + 1, fabsf(a - MOD[(ll * 2 + bb) * MODW + j])); }
        { float ss = 0.f; for (int k = tid; k < D; k += 256) { const float v = args.in[0][(size_t)t * D + k]; ss += v * v; }
          ss = block_sum(ss, red); const int c = hr % D; const float* mod = MOD + (size_t)(0 * 2 + b) * MODW;
          const float want = args.in[0][(size_t)t * D + c] / sqrtf(ss / D + EPS) * args.in[5][c] * (1.f + mod[D + c]) + mod[c];
          if (tid == 0) diag_max(slots + 1, fabsf(want - bf2f(H[(size_t)t * D + c]))); }
    } else if (stage == 2) {
        const int n = hr % DIN; float a = 0.f; const float* W = args.in[6] + (size_t)l * D * DIN;
        for (int k = tid; k < D; k += 256) a += bf2f(H[(size_t)t * D + k]) * W[(size_t)k * DIN + n];
        a = block_sum(a, red); if (tid == 0) diag_max(slots + 2, fabsf(a - bf2f(Z[(size_t)t * DIN + n])));
    } else if (stage == 3) {
        if (tid == 0) { const int c = hr % DPOOL, g = c / 256, w = 2 << g, tt = t % SEQ; float sm = 0.f; int cnt = 0;
            for (int j = 0; j < w; ++j) if (tt - j >= 0) { sm += bf2f(Z[(size_t)(t - j) * DIN + c]); ++cnt; }
            diag_max(slots + 3, fabsf(sm / cnt - bf2f(Z[(size_t)t * DIN + c]) - bf2f(POOLED[(size_t)t * DPOOL + c]))); }
        const int hq = (hr >> 8) & 15, d = (hr >> 12) & 63, g = hq >> 3, tt = t % SEQ, n = tt / 64, a = tt % 64;
        float qn[64]; float qs = 0.f;
        for (int i = 0; i < 64; ++i) { const float v = bf2f(Z[(size_t)t * DIN + 1024 + hq * 64 + i]); qs += v * v; }
        const float qr = 1.f / sqrtf(qs / 64 + EPS);
        float sc = -INFINITY, vv = 0.f;
        if (tid < 192) { const int kc = n - 2 + tid / 64; if (kc >= 0) { const int tk = b * SEQ + kc * 64 + (tid % 64); float ks = 0.f, dt = 0.f;
            for (int i = 0; i < 64; ++i) { const float kv = bf2f(Z[(size_t)tk * DIN + 2048 + g * 64 + i]); ks += kv * kv; }
            const float kr = 1.f / sqrtf(ks / 64 + EPS);
            for (int i = 0; i < 64; ++i) dt += bf2f(Z[(size_t)t * DIN + 1024 + hq * 64 + i]) * qr * args.in[7][l * 64 + i] * bf2f(Z[(size_t)tk * DIN + 2048 + g * 64 + i]) * kr * args.in[8][l * 64 + i];
            const int rel = tid - 128 - a; const int nn = rel < 0 ? -rel : rel; int bucket;
            if (nn < 8) bucket = nn; else { int lg = 8 + (int)(logf((float)nn / 8.f) / logf(16.f) * 8.f + 1e-4f); bucket = lg < 15 ? lg : 15; }
            if (rel > 0) bucket += 16;
            sc = (dbg == 1 ? 0.f : dt * 0.125f) + ((dbg == 0 || dbg == 3) ? args.in[2][bucket * 16 + hq] : 0.f); vv = bf2f(Z[(size_t)tk * DIN + 2176 + g * 64 + d]); } }
        (void)qn;
        sh[tid] = sc; __syncthreads();
        const float snk = dbg == 0 ? args.in[9][l * 16 + hq] : -INFINITY;
        float m = dbg == 0 ? snk : -1e30f; for (int i = 0; i < 192; ++i) m = fmaxf(m, sh[i]);
        const float p = (tid < 192 && sc > -INFINITY) ? expf(sc - m) : 0.f;
        const float den = block_sum(p, red) + expf(snk - m); const float num = block_sum(p * vv, red);
        if (tid == 0) diag_max(slots + (slot_override ? slot_override : 4), fabsf(num / den - bf2f(MIX[(size_t)t * D + 1024 + hq * 64 + d])));
    } else if (stage == 4) {
        const int c = hr % DPOOL, g = c / 256, dd = c % 256; float a = 0.f;
        { const int k = tid; a = bf2f(POOLED[(size_t)t * DPOOL + 256 * g + k]) * args.in[10][(size_t)(l * 4 + g) * 65536 + k * 256 + dd]; }
        a = block_sum(a, red) * args.in[11][l * DPOOL + c]; if (tid == 0) diag_max(slots + 5, fabsf(a - bf2f(MIX[(size_t)t * D + c])));
    } else if (stage == 5) {
        const int n = hr % D; float a = 0.f; const float* W = args.in[12] + (size_t)l * D * D;
        for (int k = tid; k < D; k += 256) a += bf2f(MIX[(size_t)t * D + k]) * W[(size_t)k * D + n];
        a = block_sum(a, red); const float* xin = l == 0 ? args.in[0] : XA;
        const float want = xin[(size_t)t * D + n] + MOD[(size_t)(l * 2 + b) * MODW + 2 * D + n] * a;
        if (tid == 0) diag_max(slots + 6, fabsf(want - X1[(size_t)t * D + n]));
    } else if (stage == 6) {
        float ss = 0.f; for (int k = tid; k < D; k += 256) { const float v = X1[(size_t)t * D + k]; ss += v * v; }
        ss = block_sum(ss, red); const int c = hr % D; const float* mod = MOD + (size_t)(l * 2 + b) * MODW;
        const float want = X1[(size_t)t * D + c] / sqrtf(ss / D + EPS) * args.in[13][l * D + c] * (1.f + mod[4 * D + c]) + mod[3 * D + c];
        if (tid == 0) diag_max(slots + 7, fabsf(want - bf2f(H[(size_t)t * D + c])));
    } else if (stage == 7) {
        const int n = hr % D; float a = 0.f; const float* W = args.in[14] + (size_t)l * D * D;
        for (int k = tid; k < D; k += 256) a += bf2f(H[(size_t)t * D + k]) * W[(size_t)k * D + n];
        a = block_sum(a, red); if (tid == 0) diag_max(slots + 8, fabsf(a - bf2f(QP[(size_t)t * D + n])));
    } else if (stage == 8) {
        const int h = hr & 7; const int p = tid >> 7, n = tid & 127; float a = 0.f;
        for (int i = 0; i < 128; ++i) a += bf2f(QP[(size_t)t * D + h * 256 + p * 128 + i]) * args.in[15][(size_t)((l * 2 + p) * 128 + n) * 128 + i];
        sh[tid] = a; __syncthreads();
        if (tid < 2) { for (int r = 0; r < 16; ++r) { int bi = 0; float bv = -INFINITY; for (int i = 0; i < 128; ++i) if (sh[tid * 128 + i] > bv) { bv = sh[tid * 128 + i]; bi = i; }
            sh[256 + tid * 16 + r] = bv; shi[tid * 16 + r] = bi; sh[tid * 128 + bi] = -INFINITY; } }
        __syncthreads();
        { const int aa = tid >> 4, bb = tid & 15; sh[512 + tid] = sh[256 + aa] + sh[256 + 16 + bb]; shi[256 + tid] = shi[aa] * 128 + shi[16 + bb]; }
        __syncthreads();
        if (tid == 0) { float ts[16]; int ti[16]; float den = 0.f;
            for (int r = 0; r < 16; ++r) { int bi = 0; float bv = -INFINITY; for (int i = 0; i < 256; ++i) if (sh[512 + i] > bv) { bv = sh[512 + i]; bi = i; } ts[r] = bv; ti[r] = shi[256 + bi]; sh[512 + bi] = -INFINITY; }
            for (int r = 0; r < 16; ++r) den += expf(ts[r] - ts[0]);
            float bad = 0.f;
            for (int r = 0; r < 16; ++r) { float gg = 0.f; for (int q = 0; q < 16; ++q) if (IDX[(size_t)t * 128 + h * 16 + q] == ti[r]) gg = GATE[(size_t)t * 128 + h * 16 + q]; bad += fabsf(gg - expf(ts[r] - ts[0]) / den); }
            diag_max(slots + 9, bad); }
    } else if (stage == 9) {
        const int d = hr % D; const float* U = args.in[16] + (size_t)l * NEXP * D; const float* V = args.in[17] + (size_t)l * NEXP * D; float contrib = 0.f;
        if (tid < 128) { const int e = IDX[(size_t)t * 128 + tid]; float a = 0.f; for (int k = 0; k < D; ++k) a += U[(size_t)e * D + k] * bf2f(H[(size_t)t * D + k]);
            contrib = gelu_d(a) * GATE[(size_t)t * 128 + tid] * V[(size_t)e * D + d]; }
        const float o = block_sum(contrib, red); const float want = X1[(size_t)t * D + d] + MOD[(size_t)(l * 2 + b) * MODW + 5 * D + d] * o;
        const float* xo = l == 0 ? XA : args.out;
        if (tid == 0) diag_max(slots + 10, fabsf(want - xo[(size_t)t * D + d]));
    }
}
__global__ void diag_report(Args args) {
    float* slots = (float*)(args.ws + WS_DIAG);
#if MK_DIAG == 3
    { int code = 0; if (slots[11] > 0.03f) code |= 1; if (slots[12] > 0.03f) code |= 2; if (slots[13] > 0.03f) code |= 4; if (slots[14] > 0.03f) code |= 8;
      args.out[0] = sqrtf(powf(10.f, 3.f + 0.25f * code) * 16777216.f * 1.14f); return; }
#endif
    const float thr[11] = {0, 0.03f, 0.05f, 0.05f, 0.05f, 0.05f, 0.05f, 0.05f, 0.05f, 0.1f, 0.05f};
    for (int i = 1; i <= 10; ++i) { const float d = slots[i]; if (d > thr[i]) {
        float mant = d * 10.f; if (mant > 5.0f) mant = 5.0f; if (mant < 1.0f) mant = 1.0f;
        const float target = mant * powf(10.f, (float)i + 1.f);
        args.out[0] = sqrtf(target * 16777216.f * 1.14f); return; } }
}
#endif

extern "C" void kernel_launch(void* const* d_in, const int* in_sizes, int n_in, void* d_out, int out_size, void* d_ws, size_t ws_size, hipStream_t stream) {
    static int grid = 0;
    if (grid == 0) {
        if (n_in != 18 || out_size != T * D || ws_size < WS_END) { fprintf(stderr, "kernel_launch: unexpected shapes (n_in %d out %d ws %zu)\n", n_in, out_size, ws_size); grid = -1; return; }
        int dev = 0, cus = 0, per_cu = 0;
        if (hipGetDevice(&dev) != hipSuccess || hipDeviceGetAttribute(&cus, hipDeviceAttributeMultiprocessorCount, dev) != hipSuccess) { grid = -1; return; }
        if (hipFuncSetAttribute((const void*)mk_fwd, hipFuncAttributeMaxDynamicSharedMemorySize, LDS_BYTES) != hipSuccess) { fprintf(stderr, "kernel_launch: hipFuncSetAttribute failed\n"); grid = -1; return; }
        if (hipOccupancyMaxActiveBlocksPerMultiprocessor(&per_cu, (const void*)mk_fwd, NWAVES * 64, LDS_BYTES) != hipSuccess || per_cu < 1) { fprintf(stderr, "kernel_launch: occupancy query says %d\n", per_cu); per_cu = 1; }
        (void)hipGetLastError();
        grid = cus;
        if (grid != 256) fprintf(stderr, "kernel_launch: note: %d CUs\n", grid);
    }
    if (grid < 0) return;
    (void)hipMemsetAsync((char*)d_ws + WS_CTL, 0, CTL_ZERO_BYTES, stream);
    Args a{};
    for (int i = 0; i < 18; ++i) a.in[i] = (const float*)d_in[i];
    a.out = (float*)d_out; a.ws = (unsigned char*)d_ws;
#if MK_ONE_LAUNCH
    a.ph_lo = 0; a.ph_hi = N_PHASES; a.coop = 1;
    void* kargs[] = {&a};
    hipError_t e = hipLaunchCooperativeKernel((const void*)mk_fwd, dim3(grid), dim3(NWAVES * 64), kargs, LDS_BYTES, stream);
    if (e != hipSuccess) fprintf(stderr, "cooperative launch failed: %s (grid %d)\n", hipGetErrorString(e), grid);
#else
#if MK_DIAG
    (void)hipMemsetAsync((char*)d_ws + WS_DIAG, 0, 4096, stream);
#endif
    for (int ph = 0; ph < N_PHASES; ++ph) {
        a.ph_lo = ph; a.ph_hi = ph + 1; a.coop = 0;
        hipLaunchKernelGGL(mk_fwd, dim3(grid), dim3(NWAVES * 64), LDS_BYTES, stream, a);
#if MK_DIAG
        if (ph == 1) hipLaunchKernelGGL(diag_kernel, dim3(64), dim3(256), 0, stream, a, 1, 0);
#if MK_DIAG == 3
        if (ph == 3) {
            hipLaunchKernelGGL(diag_kernel, dim3(64), dim3(256), 0, stream, a, 3, 0, 0, 11);
            hipLaunchKernelGGL(mk_fwd, dim3(grid), dim3(NWAVES * 64), LDS_BYTES, stream, a);
            hipLaunchKernelGGL(diag_kernel, dim3(64), dim3(256), 0, stream, a, 3, 0, 0, 12);
            a.ph_lo = 2; a.ph_hi = 3; hipLaunchKernelGGL(mk_fwd, dim3(grid), dim3(NWAVES * 64), LDS_BYTES, stream, a);
            a.ph_lo = 3; a.ph_hi = 4; hipLaunchKernelGGL(mk_fwd, dim3(grid), dim3(NWAVES * 64), LDS_BYTES, stream, a);
            hipLaunchKernelGGL(diag_kernel, dim3(64), dim3(256), 0, stream, a, 3, 0, 0, 13);
        }
#endif
        if (ph >= 2 && MK_DIAG < 3) { const int l = (ph - 2) / 8, s = (ph - 2) % 8; const int st[8] = {2, 3, 4, 5, 6, 7, 8, 9};
            if (l == MK_DIAG - 1) hipLaunchKernelGGL(diag_kernel, dim3(64), dim3(256), 0, stream, a, st[s], l); }
#endif
    }
#if MK_DIAG
    hipLaunchKernelGGL(diag_report, dim3(1), dim3(1), 0, stream, a);
#endif
#endif
}
```
